# Optimizing an MI355X kernel written in HIP

```python
import jax
import jax.numpy as jnp
from jax import lax
import numpy as np


D_MODEL = 1024
BATCH = 4
SEQ = 8192
DEPTH = 2

DEEPNORM_ALPHA = (2.0 * DEPTH) ** 0.25
DEEPNORM_BETA = (8.0 * DEPTH) ** -0.25
LN_EPS = 1e-5
RMS_EPS = 1e-6

A_HEADS = 4
A_DK = 128
A_DV = 128
A_FDIM = A_HEADS * A_DK
A_WIDTH = A_HEADS * A_DV
A_CHUNK = 64

B_WINDOWS = (2, 4, 8, 16)
B_GROUPS = len(B_WINDOWS)
B_GROUP_DIM = 128
B_WIDTH = B_GROUPS * B_GROUP_DIM

EVEN_SPLITS = (A_FDIM, 2 * A_FDIM, 2 * A_FDIM + A_WIDTH, 2 * A_FDIM + 2 * A_WIDTH)
EVEN_IN_COLS = 2 * A_FDIM + 2 * A_WIDTH + B_WIDTH
EVEN_MIX_WIDTH = A_WIDTH + B_WIDTH

C_HEADS = 16
C_HEAD_DIM = 64
C_WIDTH = C_HEADS * C_HEAD_DIM
C_QBLOCK = 128
ODD_IN_COLS = 3 * C_WIDTH

N_EXPERTS = 32
TOP_K = 4
D_FF = D_MODEL
SWIGLU_ALPHA = 1.702
SWIGLU_LIMIT = 7.0

kernel_name = 'hybrid_hgrn2_pool_stickbreak_moe_deepnorm'


def layer_norm(x, w, b):
    xf = x.astype(jnp.float32)
    mu = jnp.mean(xf, axis=-1, keepdims=True)
    var = jnp.mean(jnp.square(xf - mu), axis=-1, keepdims=True)
    return (xf - mu) * lax.rsqrt(var + LN_EPS) * w.astype(jnp.float32) + b.astype(jnp.float32)


def hgrn2_lower_bound(lb_logits, layer):
    p = jax.nn.softmax(lb_logits.astype(jnp.float32), axis=0)
    return jnp.cumsum(p, axis=0)[layer]


def hgrn2_recurrence(q, f_logit, i, g, lb, norm_w):
    f32 = jnp.float32
    bsz, seq, _ = q.shape
    zf = f_logit.astype(f32)
    lb = lb.astype(f32)
    log_f = jnp.log(lb + (1.0 - lb) * jax.nn.sigmoid(zf))
    k = (1.0 - lb) * jax.nn.sigmoid(-zf)
    n_chunks = seq // A_CHUNK

    def to_chunks(t, d):
        t = t.astype(f32).reshape(bsz, n_chunks, A_CHUNK, A_HEADS, d)
        return t.transpose(1, 0, 3, 2, 4)

    qc, kc, lfc = to_chunks(q, A_DK), to_chunks(k, A_DK), to_chunks(log_f, A_DK)
    vc = to_chunks(i, A_DV)
    causal = jnp.tril(jnp.ones((A_CHUNK, A_CHUNK), dtype=bool))[:, :, None]

    def step(state, inp):
        qb, kb, vb, lfb = inp
        cum = jnp.cumsum(lfb, axis=2)
        diff = cum[:, :, :, None, :] - cum[:, :, None, :, :]
        decay = jnp.exp(jnp.where(causal, diff, -jnp.inf))
        scores = jnp.einsum('bhtk,bhsk,bhtsk->bhts', qb, kb, decay)
        out = (jnp.einsum('bhts,bhsv->bhtv', scores, vb)
               + jnp.einsum('bhtk,bhkv->bhtv', qb * jnp.exp(cum), state))
        last = cum[:, :, -1:, :]
        new_state = (jnp.exp(last[:, :, 0, :, None]) * state
                     + jnp.einsum('bhsk,bhsv->bhkv', kb * jnp.exp(last - cum), vb))
        return new_state, out

    state0 = jnp.zeros((bsz, A_HEADS, A_DK, A_DV), f32)
    _, o = lax.scan(step, state0, (qc, kc, vc, lfc))
    o = o.transpose(1, 0, 3, 2, 4).reshape(bsz, seq, A_HEADS, A_DV)
    o = o * lax.rsqrt(jnp.mean(jnp.square(o), axis=-1, keepdims=True) + RMS_EPS) * norm_w.astype(f32)
    gate = jax.nn.silu(g.astype(f32)).reshape(bsz, seq, A_HEADS, A_DV)
    return (o * gate).reshape(bsz, seq, A_WIDTH)


def multiscale_pool(v, w_pool, pool_scale):
    f32 = jnp.float32
    bsz, seq, _ = v.shape
    vg = v.astype(f32).reshape(bsz, seq, B_GROUPS, B_GROUP_DIM)
    pos = jnp.arange(1, seq + 1, dtype=f32)
    outs = []
    for gidx, win in enumerate(B_WINDOWS):
        xg = vg[:, :, gidx, :]
        cs = jnp.cumsum(jnp.pad(xg, ((0, 0), (win, 0), (0, 0))), axis=1)
        window_sum = cs[:, win:] - cs[:, :seq]
        count = jnp.minimum(pos, float(win))[None, :, None]
        outs.append(window_sum / count - xg)
    pooled = jnp.stack(outs, axis=2)
    mixed = jnp.einsum('bsgc,gcd->bsgd', pooled, w_pool.astype(f32)).reshape(bsz, seq, B_WIDTH)
    return mixed * pool_scale.astype(f32)


def recurrent_pool_mixer(x, lb_logits, layer, w_in, a_norm_w, w_pool, pool_scale, w_o):
    proj = x @ w_in
    q_a, f_a, i_a, g_a, v_b = jnp.split(proj, EVEN_SPLITS, axis=-1)
    lb = hgrn2_lower_bound(lb_logits, layer)
    a_out = hgrn2_recurrence(q_a, f_a, i_a, g_a, lb, a_norm_w)
    b_out = multiscale_pool(v_b, w_pool, pool_scale)
    return jnp.concatenate([a_out, b_out], axis=-1) @ w_o


def split_heads(t, n_heads):
    bsz, seq, width = t.shape
    return t.reshape(bsz, seq, n_heads, width // n_heads).transpose(0, 2, 1, 3)


def stick_breaking_attention(q, k, v):
    f32 = jnp.float32
    seq = q.shape[2]
    scale = C_HEAD_DIM ** -0.5
    outs = []
    for blk in range(seq // C_QBLOCK):
        q0 = blk * C_QBLOCK
        kv_len = q0 + C_QBLOCK
        qb = q[:, :, q0:kv_len]
        kb = k[:, :, :kv_len]
        vb = v[:, :, :kv_len].astype(f32)
        z = jnp.einsum('bhqd,bhkd->bhqk', qb, kb).astype(f32) * scale
        q_pos = q0 + jnp.arange(C_QBLOCK)
        k_pos = jnp.arange(kv_len)
        strict = k_pos[None, :] < q_pos[:, None]
        log_beta = jax.nn.log_sigmoid(z)
        log_one_minus = jnp.where(strict, log_beta - z, 0.0)
        later = lax.cumsum(log_one_minus, axis=3, reverse=True) - log_one_minus
        weights = jnp.where(strict, jnp.exp(log_beta + later), 0.0)
        outs.append(jnp.einsum('bhqk,bhkd->bhqd', weights, vb))
    return jnp.concatenate(outs, axis=2)


def stick_breaking_mixer(x, w_in, w_o):
    bsz, seq, _ = x.shape
    proj = x @ w_in
    q, k, v = jnp.split(proj, 3, axis=-1)
    o = stick_breaking_attention(split_heads(q, C_HEADS), split_heads(k, C_HEADS), split_heads(v, C_HEADS))
    o = o.transpose(0, 2, 1, 3).reshape(bsz, seq, C_WIDTH)
    return o @ w_o


def clamped_swiglu(h):
    x_glu = jnp.minimum(h[..., ::2], SWIGLU_LIMIT)
    x_lin = jnp.clip(h[..., 1::2], -SWIGLU_LIMIT, SWIGLU_LIMIT)
    return x_glu * jax.nn.sigmoid(SWIGLU_ALPHA * x_glu) * (x_lin + 1.0)


def moe_ffn(x, w_router, b_router, w1, b1, w2, b2):
    f32 = jnp.float32
    bsz, seq, d = x.shape
    xf = x.reshape(bsz * seq, d)
    logits = (xf @ w_router + b_router).astype(f32)
    top_vals, top_idx = lax.top_k(logits, TOP_K)
    gates = jax.nn.softmax(top_vals, axis=-1)
    combine = jnp.einsum('tk,tke->te', gates, jax.nn.one_hot(top_idx, N_EXPERTS, dtype=f32))
    y = jnp.zeros((bsz * seq, d), f32)
    for e in range(N_EXPERTS):
        h = clamped_swiglu(xf @ w1[e] + b1[e])
        y = y + combine[:, e:e + 1] * (h @ w2[e] + b2[e])
    return y.reshape(bsz, seq, d)


def setup_inputs(seed: int = 0) -> dict:
    key = jax.random.key(seed)
    keys = iter(jax.random.split(key, 40))
    d = D_MODEL

    def nrm(shape, scale):
        return jax.random.normal(next(keys), shape, jnp.float32) * scale

    inp = {}
    inp['x'] = nrm((BATCH, SEQ, d), 1.0)
    inp['hgrn_lb_logits'] = nrm((DEPTH + 1, A_FDIM), 0.5)

    def add_ln(prefix, name):
        inp[prefix + name + '_w'] = 1.0 + nrm((d,), 0.05)
        inp[prefix + name + '_b'] = nrm((d,), 0.02)

    def add_moe(prefix):
        inp[prefix + 'w_router'] = nrm((d, N_EXPERTS), d ** -0.5)
        inp[prefix + 'b_router'] = nrm((N_EXPERTS,), 0.01)
        inp[prefix + 'w1'] = nrm((N_EXPERTS, d, 2 * D_FF), d ** -0.5)
        inp[prefix + 'b1'] = nrm((N_EXPERTS, 2 * D_FF), 0.02)
        inp[prefix + 'w2'] = nrm((N_EXPERTS, D_FF, d), D_FF ** -0.5 * DEEPNORM_BETA)
        inp[prefix + 'b2'] = nrm((N_EXPERTS, d), 0.02)

    for layer in range(DEPTH):
        p = 'l%d_' % layer
        if layer % 2 == 0:
            inp[p + 'w_in'] = nrm((d, EVEN_IN_COLS), d ** -0.5)
            inp[p + 'a_norm_w'] = 1.0 + nrm((A_DV,), 0.05)
            inp[p + 'w_pool'] = nrm((B_GROUPS, B_GROUP_DIM, B_GROUP_DIM), B_GROUP_DIM ** -0.5)
            inp[p + 'pool_scale'] = 1.0 + nrm((B_WIDTH,), 0.1)
            inp[p + 'w_o'] = nrm((EVEN_MIX_WIDTH, d), EVEN_MIX_WIDTH ** -0.5 * DEEPNORM_BETA)
        else:
            inp[p + 'w_in'] = nrm((d, ODD_IN_COLS), d ** -0.5)
            inp[p + 'w_o'] = nrm((C_WIDTH, d), C_WIDTH ** -0.5 * DEEPNORM_BETA)
        add_ln(p, 'ln1')
        add_moe(p)
        add_ln(p, 'ln2')
    return inp


def reference(x, hgrn_lb_logits,
              l0_w_in, l0_a_norm_w, l0_w_pool, l0_pool_scale, l0_w_o, l0_ln1_w, l0_ln1_b,
              l0_w_router, l0_b_router, l0_w1, l0_b1, l0_w2, l0_b2, l0_ln2_w, l0_ln2_b,
              l1_w_in, l1_w_o, l1_ln1_w, l1_ln1_b,
              l1_w_router, l1_b_router, l1_w1, l1_b1, l1_w2, l1_b2, l1_ln2_w, l1_ln2_b):
    out_dtype = x.dtype
    mixer_params = ((l0_w_in, l0_a_norm_w, l0_w_pool, l0_pool_scale, l0_w_o),
                    (l1_w_in, l1_w_o))
    ln1_params = ((l0_ln1_w, l0_ln1_b), (l1_ln1_w, l1_ln1_b))
    moe_params = ((l0_w_router, l0_b_router, l0_w1, l0_b1, l0_w2, l0_b2),
                  (l1_w_router, l1_b_router, l1_w1, l1_b1, l1_w2, l1_b2))
    ln2_params = ((l0_ln2_w, l0_ln2_b), (l1_ln2_w, l1_ln2_b))
    for layer in range(DEPTH):
        if layer % 2 == 0:
            h = recurrent_pool_mixer(x, hgrn_lb_logits, layer, *mixer_params[layer])
        else:
            h = stick_breaking_mixer(x, *mixer_params[layer])
        x = layer_norm(DEEPNORM_ALPHA * x.astype(jnp.float32) + h, *ln1_params[layer]).astype(out_dtype)
        h = moe_ffn(x, *moe_params[layer])
        x = layer_norm(DEEPNORM_ALPHA * x.astype(jnp.float32) + h, *ln2_params[layer]).astype(out_dtype)
    return x
```

```cpp
#include <hip/hip_runtime.h>
#include <cstdio>
#include <cstdint>

#ifndef MK_PER_PHASE
#define MK_PER_PHASE 0
#endif

#define LAS __attribute__((address_space(3)))
#define GAS __attribute__((address_space(1)))
typedef unsigned short bf16_t;
typedef short bf16x8 __attribute__((ext_vector_type(8)));
typedef short s16x4 __attribute__((ext_vector_type(4)));
typedef float f32x2 __attribute__((ext_vector_type(2)));
typedef float f32x4 __attribute__((ext_vector_type(4)));
typedef float f32x16 __attribute__((ext_vector_type(16)));
typedef unsigned u32x2 __attribute__((ext_vector_type(2)));
typedef unsigned u32x4 __attribute__((ext_vector_type(4)));
typedef __bf16 bf16x2_t __attribute__((ext_vector_type(2)));
typedef int i32x4 __attribute__((ext_vector_type(4)));
typedef int i32x8 __attribute__((ext_vector_type(8)));

constexpr int BATCH = 4, SEQ = 8192, T = BATCH * SEQ, D = 1024;
constexpr int NE = 32;
constexpr float ALPHA = 1.41421356237309515f;
constexpr float LN_EPS = 1e-5f, RMS_EPS = 1e-6f;
constexpr float LOG2E = 1.4426950408889634f;
constexpr float QSCALE = 0.125f * LOG2E;
constexpr float ATT_THR = 7.5231638e-37f;

__device__ __forceinline__ unsigned pk2(float lo, float hi) { f32x2 v = {lo, hi}; bf16x2_t b = __builtin_convertvector(v, bf16x2_t); return __builtin_bit_cast(unsigned, b); }
__device__ __forceinline__ float bflo(unsigned u) { return __uint_as_float(u << 16); }
__device__ __forceinline__ float bfhi(unsigned u) { return __uint_as_float(u & 0xffff0000u); }
__device__ __forceinline__ float bf2f(bf16_t h) { return __uint_as_float(((unsigned)h) << 16); }
__device__ __forceinline__ float clamp448(float x) { return __builtin_amdgcn_fmed3f(x, -448.0f, 448.0f); }
__device__ __forceinline__ unsigned pk4_fp8_nc(float a, float b, float c, float d) { int p = 0; p = __builtin_amdgcn_cvt_pk_fp8_f32(a, b, p, false); p = __builtin_amdgcn_cvt_pk_fp8_f32(c, d, p, true); return (unsigned)p; }
__device__ __forceinline__ unsigned pk4_fp8(float a, float b, float c, float d) { int p = 0; p = __builtin_amdgcn_cvt_pk_fp8_f32(clamp448(a), clamp448(b), p, false); p = __builtin_amdgcn_cvt_pk_fp8_f32(clamp448(c), clamp448(d), p, true); return (unsigned)p; }
__device__ __forceinline__ float fexp2(float x) { return __builtin_amdgcn_exp2f(x); }
__device__ __forceinline__ float flog2(float x) { return __builtin_amdgcn_logf(x); }
__device__ __forceinline__ float frcp(float x) { return __builtin_amdgcn_rcpf(x); }

__device__ __forceinline__ int lane_id_asm() { int l; asm volatile("v_mbcnt_lo_u32_b32 %0, -1, 0\n\tv_mbcnt_hi_u32_b32 %0, -1, %0" : "=v"(l)); return l; }

namespace pg8 {
constexpr int BM = 256, BK = 64, HALF = 128, HTB = HALF * BK * 2, STAGE_BYTES = 8 * HTB, NXCD = 8, WGM = 8;
constexpr int AUX_OFF = STAGE_BYTES + 2048 + 512 + 256;
__host__ __device__ __forceinline__ int lds_byte(int r, int c) { const int st = (r >> 4) * 2 + (c >> 5), rr = r & 15, cc = c & 31, ob = rr * 64 + cc * 2; return st * 1024 + (ob ^ (((ob >> 9) & 1) << 5)); }
__host__ __device__ __forceinline__ void stage_rc(int b, int& R, int& C) { const int st = b / 1024, sb = b % 1024, swz = sb ^ (((sb >> 9) & 1) << 5); R = (st >> 1) * 16 + swz / 64; C = (st & 1) * 32 + (swz % 64) / 2; }
__host__ __device__ __forceinline__ int perm32(int rho) { const int n = rho >> 4, i = rho & 15; return 8 * (i >> 2) + 4 * n + (i & 3); }

struct Unit { int pm, pn, e, mt, valid; };
struct Gemm { const bf16_t* A; const bf16_t* Bt; int K; int brows; };

__device__ __forceinline__ void tile_of(int L, int nM, int nN, int& pm, int& pn) {
    const int nwg = nM * nN;
    int wgid = L; { const int q = nwg / NXCD, r = nwg % NXCD, xcd = wgid % NXCD, off = wgid / NXCD; wgid = (xcd < r ? xcd * (q + 1) : r * (q + 1) + (xcd - r) * q) + off; }
    const int nig = WGM * nN, gid = wgid / nig, fm = gid * WGM, gsz = (nM - fm) < WGM ? (nM - fm) : WGM;
    pm = fm + ((wgid % nig) % gsz); pn = (wgid % nig) / gsz;
}
struct StaticOrder {
    int nM, nN, nwg, G, c;
    __device__ __forceinline__ void init(int M, int N, int G_, int c_) { nM = M / BM; nN = N / BM; nwg = nM * nN; G = G_; c = c_; }
    __device__ __forceinline__ bool next(int i, Unit& u) const {
        const long L = (long)i * G + c; if (L >= nwg) return false;
        tile_of((int)L, nM, nN, u.pm, u.pn); u.e = 0; u.mt = u.pm; u.valid = 256; return true;
    }
};
struct MoeOrder {
    const LAS int* tab; int nM, nN, nwg, G, c;
    __device__ __forceinline__ void init(const LAS int* tab_, int nN_, int G_, int c_) { tab = tab_; nM = tab_[32]; nN = nN_; nwg = nM * nN; G = G_; c = c_; }
    __device__ __forceinline__ bool next(int i, Unit& u) const {
        const long L = (long)i * G + c; if (L >= nwg) return false;
        tile_of((int)L, nM, nN, u.pm, u.pn);
        int e = 0;
#pragma unroll
        for (int j = 1; j < 32; ++j) e += (u.pm >= tab[j]) ? 1 : 0;
        u.e = e; u.mt = u.pm - tab[e]; const int rem = tab[33 + e] - u.mt * 256; u.valid = rem < 256 ? rem : 256; return true;
    }
};

__device__ __forceinline__ unsigned cvt_pk_bf16(float lo, float hi) { return pk2(lo, hi); }

struct EpiPlain {
    static constexpr bool PERM = true; static constexpr int NAUX = 0;
    bf16_t* O; int ldc; int split_cols; size_t split_stride; float scale0;
    __device__ __forceinline__ void operator()(const f32x4 (&acc)[2][2][4][2], const Unit& u, int wr, int wc, int fr, int fq, const LAS float* aux) const {
        asm volatile("" : "+v"(fr), "+v"(fq));
        const int row0 = u.pm * BM + wr * 64 + fr; int colt = u.pn * BM; bf16_t* base = O;
        float sc = 1.f; if (split_cols) { const int t = colt / split_cols; base += (size_t)t * split_stride; colt -= t * split_cols; if (t == 0) sc = scale0; }
        const int col0 = colt + wc * 32 + 8 * fq;
#pragma unroll
        for (int ai = 0; ai < 2; ++ai)
#pragma unroll
            for (int m = 0; m < 4; ++m) { bf16_t* rowp = base + (size_t)(row0 + ai * HALF + m * 16) * ldc + col0;
#pragma unroll
                for (int bj = 0; bj < 2; ++bj) { f32x4 v0 = acc[ai][bj][m][0] * sc, v1 = acc[ai][bj][m][1] * sc;
                    u32x4 w; w.x = cvt_pk_bf16(v0[0], v0[1]); w.y = cvt_pk_bf16(v0[2], v0[3]); w.z = cvt_pk_bf16(v1[0], v1[1]); w.w = cvt_pk_bf16(v1[2], v1[3]);
                    *(u32x4*)(rowp + bj * HALF) = w; } }
    }
};
struct EpiQK {
    static constexpr bool PERM = true; static constexpr int NAUX = 0;
    bf16_t* Q; bf16_t* KF; float scale;
    __device__ __forceinline__ void operator()(const f32x4 (&acc)[2][2][4][2], const Unit& u, int wr, int wc, int fr, int fq, const LAS float* aux) const {
        asm volatile("" : "+v"(fr), "+v"(fq));
        const int row0 = u.pm * BM + wr * 64 + fr; const int colt = u.pn * BM; const bool isk = colt >= 1024;
        const int col0 = (isk ? colt - 1024 : colt) + wc * 32 + 8 * fq;
        const float sc = isk ? 1.f : scale;
#pragma unroll
        for (int ai = 0; ai < 2; ++ai)
#pragma unroll
            for (int m = 0; m < 4; ++m) { const int t = row0 + ai * HALF + m * 16;
#pragma unroll
                for (int bj = 0; bj < 2; ++bj) { const f32x4 v0 = acc[ai][bj][m][0] * sc, v1 = acc[ai][bj][m][1] * sc; const int c = col0 + bj * HALF;
                    u32x4 w; w.x = cvt_pk_bf16(v0[0], v0[1]); w.y = cvt_pk_bf16(v0[2], v0[3]); w.z = cvt_pk_bf16(v1[0], v1[1]); w.w = cvt_pk_bf16(v1[2], v1[3]);
                    bf16_t* p;
                    if (isk) { const int b = t >> 13, tt = t & 8191, h = c >> 6, d8 = (c & 63) >> 3;
                        p = KF + ((((size_t)(b * 16 + h) * 256 + (tt >> 5)) * 4 + (d8 >> 1)) * 64 + (d8 & 1) * 32 + (tt & 31)) * 8; }
                    else p = Q + (size_t)t * 1024 + c;
                    *(u32x4*)p = w; } }
    }
};
struct EpiVF {
    static constexpr bool PERM = true; static constexpr int NAUX = 0;
    bf16_t* VF;
    __device__ __forceinline__ void operator()(const f32x4 (&acc)[2][2][4][2], const Unit& u, int wr, int wc, int fr, int fq, const LAS float* aux) const {
        asm volatile("" : "+v"(fr), "+v"(fq));
        const int row0 = u.pm * BM + wr * 64 + fr; const int col0 = u.pn * BM + wc * 32 + 8 * fq;
#pragma unroll
        for (int ai = 0; ai < 2; ++ai)
#pragma unroll
            for (int m = 0; m < 4; ++m) { const int dg = row0 + ai * HALF + m * 16; const int h = dg >> 6, dd = dg & 63;
#pragma unroll
                for (int bj = 0; bj < 2; ++bj) { const f32x4 v0 = acc[ai][bj][m][0], v1 = acc[ai][bj][m][1]; const int t = col0 + bj * HALF;
                    const int b = t >> 13, tt = t & 8191, t32 = tt & 31;
                    bf16_t* p = VF + (((((size_t)(b * 16 + h) * 256 + (tt >> 5)) * 2 + (dd >> 5)) * 2 + (t32 >> 4)) * 64 + (dd & 31)) * 8 + ((t32 >> 3) & 1) * 4;
                    u32x2 w0, w1; w0.x = cvt_pk_bf16(v0[0], v0[1]); w0.y = cvt_pk_bf16(v0[2], v0[3]); w1.x = cvt_pk_bf16(v1[0], v1[1]); w1.y = cvt_pk_bf16(v1[2], v1[3]);
                    *(u32x2*)p = w0; *(u32x2*)(p + 32 * 8) = w1; } }
    }
};
__device__ __forceinline__ float swiglu1(float xg, float xl) {
    const float g = fminf(xg, 7.0f), l = __builtin_amdgcn_fmed3f(xl, -7.0f, 7.0f);
    const float s = frcp(1.0f + fexp2(-1.702f * LOG2E * g));
    return g * s * (l + 1.0f);
}
struct EpiSwiglu {
    static constexpr bool PERM = true; static constexpr int NAUX = 0;
    bf16_t* O; const float* b1;
    __device__ __forceinline__ void operator()(const f32x4 (&acc)[2][2][4][2], const Unit& u, int wr, int wc, int fr, int fq, const LAS float* aux) const {
        asm volatile("" : "+v"(fr), "+v"(fq));
        const int row0 = u.pm * BM + wr * 64 + fr; const int col0 = u.pn * BM + wc * 32 + 8 * fq;
        const float* bp = b1 + (size_t)u.e * 2048 + col0;
        f32x4 bv[2][2];
#pragma unroll
        for (int bj = 0; bj < 2; ++bj)
#pragma unroll
            for (int n = 0; n < 2; ++n) bv[bj][n] = *(const f32x4*)(bp + bj * HALF + 4 * n);
#pragma unroll
        for (int ai = 0; ai < 2; ++ai)
#pragma unroll
            for (int m = 0; m < 4; ++m) { bf16_t* rowp = O + (size_t)(row0 + ai * HALF + m * 16) * 1024 + (col0 >> 1);
#pragma unroll
                for (int bj = 0; bj < 2; ++bj) { const f32x4 v0 = acc[ai][bj][m][0] + bv[bj][0], v1 = acc[ai][bj][m][1] + bv[bj][1];
                    u32x2 w; w.x = cvt_pk_bf16(swiglu1(v0[0], v0[1]), swiglu1(v0[2], v0[3])); w.y = cvt_pk_bf16(swiglu1(v1[0], v1[1]), swiglu1(v1[2], v1[3]));
                    *(u32x2*)(rowp + bj * (HALF / 2)) = w; } }
    }
};
struct EpiSwiglu8 {
    static constexpr bool PERM = true; static constexpr int NAUX = 1;
    __device__ __forceinline__ const float* aux_src(const Unit& u, int) const { return b1 + (size_t)u.e * 2048 + u.pn * BM; }
    unsigned char* O; const float* b1;
    __device__ __forceinline__ void operator()(const f32x4 (&acc)[2][2][4][2], const Unit& u, int wr, int wc, int fr, int fq, const LAS float* aux) const {
        asm volatile("" : "+v"(fr), "+v"(fq));
        const int row0 = u.pm * BM + wr * 64 + fr; const int col0 = u.pn * BM + wc * 32 + 8 * fq;
        f32x4 bv[2][2];
#pragma unroll
        for (int bj = 0; bj < 2; ++bj)
#pragma unroll
            for (int n = 0; n < 2; ++n) bv[bj][n] = *(const LAS f32x4*)(aux + wc * 32 + 8 * fq + bj * HALF + 4 * n);
#pragma unroll
        for (int ai = 0; ai < 2; ++ai)
#pragma unroll
            for (int m = 0; m < 4; ++m) {
                f32x2 g[4], l[4], t[4];
#pragma unroll
                for (int bj = 0; bj < 2; ++bj)
#pragma unroll
                    for (int n = 0; n < 2; ++n) { const f32x4 v = acc[ai][bj][m][n] + bv[bj][n]; const int o = bj * 2 + n;
                        g[o] = (f32x2){fminf(v[0], 7.0f), fminf(v[2], 7.0f)}; l[o] = (f32x2){__builtin_amdgcn_fmed3f(v[1], -7.0f, 7.0f), __builtin_amdgcn_fmed3f(v[3], -7.0f, 7.0f)} + 1.0f; }
#pragma unroll
                for (int i = 0; i < 4; ++i) { const f32x2 a = g[i] * (-1.702f * LOG2E); t[i] = (f32x2){fexp2(a.x), fexp2(a.y)}; }
                __builtin_amdgcn_sched_barrier(0);
#pragma unroll
                for (int i = 0; i < 4; ++i) { const f32x2 d = t[i] + 1.0f; t[i] = (f32x2){frcp(d.x), frcp(d.y)}; }
                __builtin_amdgcn_sched_barrier(0);
#pragma unroll
                for (int i = 0; i < 4; ++i) t[i] = (g[i] * t[i]) * l[i];
                unsigned char* rowp = O + (size_t)(row0 + ai * HALF + m * 16) * 1024 + (col0 >> 1);
                *(unsigned*)rowp = pk4_fp8_nc(t[0].x, t[0].y, t[1].x, t[1].y); *(unsigned*)(rowp + HALF / 2) = pk4_fp8_nc(t[2].x, t[2].y, t[3].x, t[3].y);
            }
    }
};
struct EpiDown {
    static constexpr bool PERM = true; static constexpr int NAUX = 0;
    bf16_t* O; const float* b2; const float* gatel;
    __device__ __forceinline__ void operator()(const f32x4 (&acc)[2][2][4][2], const Unit& u, int wr, int wc, int fr, int fq, const LAS float* aux) const {
        asm volatile("" : "+v"(fr), "+v"(fq));
        const int rl0 = wr * 64 + fr; const int col0 = u.pn * BM + wc * 32 + 8 * fq;
        const float* bp = b2 + (size_t)u.e * 1024 + col0; const float* gp = gatel + (size_t)u.e * T + u.mt * 256 + rl0;
        f32x4 bv[2][2];
#pragma unroll
        for (int bj = 0; bj < 2; ++bj)
#pragma unroll
            for (int n = 0; n < 2; ++n) bv[bj][n] = *(const f32x4*)(bp + bj * HALF + 4 * n);
#pragma unroll
        for (int ai = 0; ai < 2; ++ai)
#pragma unroll
            for (int m = 0; m < 4; ++m) { const float gt = gp[ai * HALF + m * 16]; bf16_t* rowp = O + (size_t)(u.pm * BM + rl0 + ai * HALF + m * 16) * 1024 + col0;
#pragma unroll
                for (int bj = 0; bj < 2; ++bj) { const f32x4 v0 = (acc[ai][bj][m][0] + bv[bj][0]) * gt, v1 = (acc[ai][bj][m][1] + bv[bj][1]) * gt;
                    u32x4 w; w.x = cvt_pk_bf16(v0[0], v0[1]); w.y = cvt_pk_bf16(v0[2], v0[3]); w.z = cvt_pk_bf16(v1[0], v1[1]); w.w = cvt_pk_bf16(v1[2], v1[3]);
                    *(u32x4*)(rowp + bj * HALF) = w; } }
    }
};

struct EpiDown8 {
    static constexpr bool PERM = true; static constexpr int NAUX = 2;
    __device__ __forceinline__ const float* aux_src(const Unit& u, int k) const { return k == 0 ? b2 + (size_t)u.e * 1024 + u.pn * BM : gatel + (size_t)u.e * T + u.mt * 256; }
    unsigned char* O; const float* b2; const float* gatel;
    __device__ __forceinline__ void operator()(const f32x4 (&acc)[2][2][4][2], const Unit& u, int wr, int wc, int fr, int fq, const LAS float* aux) const {
        asm volatile("" : "+v"(fr), "+v"(fq));
        const int rl0 = wr * 64 + fr; const int col0 = u.pn * BM + wc * 32 + 8 * fq;
        const LAS float* gp = aux + 256 + rl0;
        f32x4 bv[2][2];
#pragma unroll
        for (int bj = 0; bj < 2; ++bj)
#pragma unroll
            for (int n = 0; n < 2; ++n) bv[bj][n] = *(const LAS f32x4*)(aux + wc * 32 + 8 * fq + bj * HALF + 4 * n);
#pragma unroll
        for (int ai = 0; ai < 2; ++ai)
#pragma unroll
            for (int m = 0; m < 4; ++m) { const float gt = gp[ai * HALF + m * 16] * 16.0f; unsigned char* rowp = O + (size_t)(u.pm * BM + rl0 + ai * HALF + m * 16) * 1024 + col0;
#pragma unroll
                for (int bj = 0; bj < 2; ++bj) { const f32x4 v0 = (acc[ai][bj][m][0] + bv[bj][0]) * gt, v1 = (acc[ai][bj][m][1] + bv[bj][1]) * gt;
                    u32x2 w; w.x = pk4_fp8(v0[0], v0[1], v0[2], v0[3]); w.y = pk4_fp8(v1[0], v1[1], v1[2], v1[3]);
                    *(u32x2*)(rowp + bj * HALF) = w; } }
    }
};

template <class Epi, class Sched, int GATHER, int F8 = 0>
__device__ __forceinline__ void gemm_phase(LAS unsigned char* lds, const Gemm g, const Sched& S, const Epi& E, const int* tokl, LAS unsigned* rowtab, const int tid) {
    const int wid = __builtin_amdgcn_readfirstlane(tid >> 6), lane = tid & 63, wr = wid >> 2, wc = wid & 3, fr = lane & 15, fq = lane >> 4;
    const int K = g.K, nt = K / BK;
    unsigned voffA[2], voffB[2];
#pragma unroll
    for (int i = 0; i < 2; ++i) { int R, C; stage_rc(tid * 16 + i * 8192, R, C); const int Rb = Epi::PERM ? ((R & ~31) + perm32(R & 31)) : R;
        voffA[i] = (unsigned)(R * K + C) * 2u; voffB[i] = (unsigned)(Rb * K + C) * 2u; }
    const size_t kstep = (size_t)(BK * 2);
    const size_t hstep = (size_t)HALF * K * 2;
    const size_t tstep = 2 * hstep;
    const unsigned ldsw = (unsigned)wid * 1024u;
    const int aoff = lds_byte(wr * 64 + fr, fq * 8), boff = lds_byte(wc * 32 + fr, fq * 8);
    unsigned vC[2][2];
#define PG8_SA(b, h) (((b) * 2 + (h)) * HTB)
#define PG8_SB(b, h) ((4 + (b) * 2 + (h)) * HTB)
#define PG8_GLDS(gp, bufoff, i_) __builtin_amdgcn_global_load_lds((const unsigned*)(gp), (LAS unsigned*)(lds + (bufoff) + ldsw + (i_) * 8192), 16, 0, 0)
#define PG8_STAGE_B(bufoff, gbase) do { _Pragma("unroll") for (int _i = 0; _i < 2; ++_i) PG8_GLDS((const char*)(gbase) + voffB[_i], bufoff, _i); } while (0)
#define PG8_STAGE_A(bufoff, gbase, h, nx) do { _Pragma("unroll") for (int _i = 0; _i < 2; ++_i) { \
        if constexpr (GATHER) { PG8_GLDS((const char*)(gbase) + vC[h][_i], bufoff, _i); } \
        else PG8_GLDS((const char*)(gbase) + (h) * hstep + voffA[_i], bufoff, _i); } } while (0)
#define PG8_LDA(dst, b, h) do { _Pragma("unroll") for (int m = 0; m < 4; ++m) _Pragma("unroll") for (int k = 0; k < 2; ++k) dst[m][k] = *(const LAS bf16x8*)(lds + PG8_SA(b, h) + aoff + m * 2048 + k * 1024); } while (0)
#define PG8_LDB(dst, b, h) do { _Pragma("unroll") for (int n = 0; n < 2; ++n) _Pragma("unroll") for (int k = 0; k < 2; ++k) dst[n][k] = *(const LAS bf16x8*)(lds + PG8_SB(b, h) + boff + n * 2048 + k * 1024); } while (0)
#define PG8_MMA(ai, bj, At, Bt) do { __builtin_amdgcn_s_setprio(1); _Pragma("unroll") for (int m = 0; m < 4; ++m) _Pragma("unroll") for (int n = 0; n < 2; ++n) { \
        if constexpr (F8 != 0) {   \
            const i32x4 _b0 = __builtin_bit_cast(i32x4, Bt[n][0]), _b1 = __builtin_bit_cast(i32x4, Bt[n][1]), _a0 = __builtin_bit_cast(i32x4, At[m][0]), _a1 = __builtin_bit_cast(i32x4, At[m][1]); \
            const i32x8 _bb = __builtin_shufflevector(_b0, _b1, 0, 1, 2, 3, 4, 5, 6, 7), _aa = __builtin_shufflevector(_a0, _a1, 0, 1, 2, 3, 4, 5, 6, 7); \
            acc[ai][bj][m][n] = __builtin_amdgcn_mfma_scale_f32_16x16x128_f8f6f4(_bb, _aa, acc[ai][bj][m][n], 0, 0, 0, (int)(F8 * 0x01010101u), 0, 0x7f7f7f7f); \
        } else { _Pragma("unroll") for (int k = 0; k < 2; ++k) acc[ai][bj][m][n] = __builtin_amdgcn_mfma_f32_16x16x32_bf16(Bt[n][k], At[m][k], acc[ai][bj][m][n], 0, 0, 0); } } \
        __builtin_amdgcn_s_setprio(0); } while (0)
#define PG8_WAIT_V(n) asm volatile("s_waitcnt vmcnt(" #n ")" ::: "memory")
#define PG8_WAIT_L(n) asm volatile("s_waitcnt lgkmcnt(" #n ")" ::: "memory")
#define PG8_BAR __builtin_amdgcn_s_barrier()
#define PG8_SCHED __builtin_amdgcn_sched_barrier(0)
#define PG8_ROWDMA(u_, slot_) do { if (GATHER == 1 && wid < 4) __builtin_amdgcn_global_load_lds((const unsigned*)(tokl + (size_t)(u_).e * T + (u_).mt * 256 + wid * 64 + lane), (LAS unsigned*)(rowtab + (slot_) * 256 + wid * 64), 4, 0, 0); } while (0)
#define PG8_ROWOFF(dst, u_, slot_) do { _Pragma("unroll") for (int _i = 0; _i < 2; ++_i) { int _R, _C; stage_rc(tid * 16 + _i * 8192, _R, _C); _Pragma("unroll") for (int _h = 0; _h < 2; ++_h) { const int _r = _h * HALF + _R; \
        unsigned _t; if constexpr (GATHER == 1) { _t = rowtab[(slot_) * 256 + _r]; _t = (_r < (u_).valid) ? _t : 0u; } else _t = (unsigned)((u_).pm * 256 + _r); \
        dst[_h][_i] = _t * (unsigned)(K * 2) + (unsigned)_C * 2u; } } } while (0)
    Unit cur, nxt; int ui = 0;
    if (!S.next(0, cur)) return;
    f32x4 acc[2][2][4][2];
#pragma unroll
    for (int a = 0; a < 2; ++a)
#pragma unroll
        for (int b = 0; b < 2; ++b)
#pragma unroll
            for (int m = 0; m < 4; ++m)
#pragma unroll
                for (int n = 0; n < 2; ++n) acc[a][b][m][n] = (f32x4){0.f, 0.f, 0.f, 0.f};
    bf16x8 At[4][2], B0[2][2], B1[2][2];
    const char* cA = GATHER ? (const char*)g.A : (const char*)g.A + (size_t)cur.pm * tstep;
    const char* cB = (const char*)g.Bt + ((size_t)cur.e * g.brows + (size_t)cur.pn * BM) * K * 2;
    if constexpr (GATHER != 0) {
        PG8_ROWDMA(cur, 0); PG8_WAIT_V(0); __syncthreads();
        PG8_ROWOFF(vC, cur, 0);
        PG8_WAIT_L(0);
    }
    PG8_STAGE_B(PG8_SB(0, 0), cB); PG8_STAGE_B(PG8_SB(0, 1), cB + hstep); PG8_STAGE_A(PG8_SA(0, 0), cA, 0, false); PG8_STAGE_A(PG8_SA(0, 1), cA, 1, false);
    if (wr == 1) PG8_BAR;
    PG8_WAIT_V(2); PG8_BAR;
    PG8_STAGE_B(PG8_SB(1, 0), cB + kstep); PG8_STAGE_A(PG8_SA(1, 0), cA + kstep, 0, false); PG8_STAGE_B(PG8_SB(1, 1), cB + hstep + kstep);
    PG8_WAIT_V(6); PG8_BAR;
    for (;;) {
        if constexpr (Epi::NAUX > 0) { if (wid < Epi::NAUX) __builtin_amdgcn_global_load_lds((const unsigned*)(E.aux_src(cur, wid) + lane * 4), (LAS unsigned*)(lds + AUX_OFF + (ui & 1) * 2048 + wid * 1024), 16, 0, 0); }
        const bool has_next = S.next(ui + 1, nxt);
        if constexpr (GATHER) { if (has_next) PG8_ROWDMA(nxt, (ui + 1) & 1); }
        const char* nA = has_next ? (GATHER ? (const char*)g.A : (const char*)g.A + (size_t)nxt.pm * tstep) : cA;
        const char* nB = has_next ? (const char*)g.Bt + ((size_t)nxt.e * g.brows + (size_t)nxt.pn * BM) * K * 2 : cB;
#pragma unroll 1
        for (int t = 0; t < nt; t += 2) {
            const bool last = (t == nt - 2);
            const char* a1 = cA + (size_t)(t + 1) * kstep;
            const char* a2 = last ? nA : cA + (size_t)(t + 2) * kstep; const char* b2 = last ? nB : cB + (size_t)(t + 2) * kstep;
            const char* a3 = a2 + kstep; const char* b3 = b2 + kstep;
            PG8_LDB(B0, 0, 0); PG8_LDB(B1, 0, 1); PG8_SCHED; PG8_LDA(At, 0, 0); PG8_STAGE_A(PG8_SA(1, 1), a1, 1, false);
            if constexpr (GATHER) { if (last && has_next) { PG8_ROWOFF(vC, nxt, (ui + 1) & 1); } }
            PG8_WAIT_V(8); PG8_WAIT_L(0); PG8_BAR; PG8_MMA(0, 0, At, B0); PG8_MMA(0, 1, At, B1); PG8_BAR; PG8_SCHED;
            PG8_LDA(At, 0, 1); PG8_STAGE_B(PG8_SB(0, 0), b2); PG8_STAGE_B(PG8_SB(0, 1), b2 + hstep); PG8_STAGE_A(PG8_SA(0, 0), a2, 0, last);
            PG8_WAIT_V(8); PG8_WAIT_L(0); PG8_BAR; PG8_MMA(1, 0, At, B0); PG8_MMA(1, 1, At, B1); PG8_BAR; PG8_SCHED;
            PG8_LDB(B0, 1, 0); PG8_LDB(B1, 1, 1); PG8_SCHED; PG8_LDA(At, 1, 0); PG8_STAGE_A(PG8_SA(0, 1), a2, 1, last);
            PG8_WAIT_V(8); PG8_WAIT_L(0); PG8_BAR; PG8_MMA(0, 0, At, B0); PG8_MMA(0, 1, At, B1); PG8_BAR; PG8_SCHED;
            PG8_LDA(At, 1, 1); PG8_STAGE_B(PG8_SB(1, 0), b3); PG8_STAGE_B(PG8_SB(1, 1), b3 + hstep); PG8_STAGE_A(PG8_SA(1, 0), a3, 0, last);
            PG8_WAIT_V(8); PG8_WAIT_L(0); PG8_BAR; PG8_MMA(1, 0, At, B0); PG8_MMA(1, 1, At, B1); PG8_BAR; PG8_SCHED;
        }
        if (wr == 0) PG8_BAR;
        E(acc, cur, wr, wc, fr, fq, (const LAS float*)(lds + AUX_OFF + (ui & 1) * 2048));
#if defined(PROBE_EPI2)
        E(acc, cur, wr, wc, fr, fq, (const LAS float*)(lds + AUX_OFF + (ui & 1) * 2048));
#endif
        if (!has_next) break;
#pragma unroll
        for (int a = 0; a < 2; ++a)
#pragma unroll
            for (int b = 0; b < 2; ++b)
#pragma unroll
                for (int m = 0; m < 4; ++m)
#pragma unroll
                    for (int n = 0; n < 2; ++n) acc[a][b][m][n] = (f32x4){0.f, 0.f, 0.f, 0.f};
        cur = nxt; cA = nA; cB = nB; ++ui;
        if (wr == 1) PG8_BAR;
    }
    PG8_WAIT_V(0);
    PG8_BAR;
#undef PG8_SA
#undef PG8_SB
#undef PG8_GLDS
#undef PG8_STAGE_A
#undef PG8_STAGE_B
#undef PG8_LDA
#undef PG8_LDB
#undef PG8_MMA
#undef PG8_WAIT_V
#undef PG8_WAIT_L
#undef PG8_BAR
#undef PG8_SCHED
#undef PG8_ROWDMA
#undef PG8_ROWOFF
}
}

constexpr size_t MiB = 1u << 20;
constexpr size_t WS_CTL = 0, CTL_ZERO_BYTES = 128 * 1024;
constexpr size_t WS_TOKL = 1 * MiB, WS_GATEL = 5 * MiB, WS_TINFO = 9 * MiB;
constexpr size_t WS_WIN0T = 10 * MiB, WS_WO0T = 15 * MiB, WS_WIN1T = 17 * MiB, WS_WO1T = 23 * MiB;
constexpr size_t WS_W1T = 26 * MiB, WS_W2T = 154 * MiB, WS_XB = 218 * MiB;
constexpr size_t WS_SA = 282 * MiB, WS_SB = 554 * MiB, WS_XB8 = 826 * MiB, WS_END = 858 * MiB;
constexpr int CW_BAR = 4096, CW_CNT = 16384;

constexpr int RING_BYTES = 131072;
constexpr int ROWTAB_OFF = RING_BYTES;
constexpr int MOETAB_OFF = ROWTAB_OFF + 2048;
constexpr int MISC_OFF = MOETAB_OFF + 512;
constexpr int LDS_BYTES = 147456;
static_assert(pg8::AUX_OFF == MISC_OFF + 256 && pg8::AUX_OFF + 4096 <= LDS_BYTES, "LDS map");

#define XB_TMO      128
#define XB_XCNT(j)  (256  + 64 * (j))
#define XB_XSUB(j)  (1280 + 64 * (j))
#define XB_XGEN(j)  (2304 + 64 * (j))
#define XB_TOP      3328
#define XB_TOPGEN   3392
#define XCD_BAR_WORDS 3456
#define XB_SPIN_CAP (1u << 20)
__device__ __forceinline__ unsigned xb_ld(unsigned* p)              { return __hip_atomic_load(p, __ATOMIC_RELAXED, __HIP_MEMORY_SCOPE_AGENT); }
__device__ __forceinline__ unsigned xb_add(unsigned* p, unsigned v) { return __hip_atomic_fetch_add(p, v, __ATOMIC_RELAXED, __HIP_MEMORY_SCOPE_AGENT); }
__device__ __forceinline__ unsigned xb_xcc_id() { return (unsigned)__builtin_amdgcn_s_getreg((3 << 11) | 20) & 0xFu; }
#define XB_SPIN(cond, bar) do { unsigned _sp = 0; while (cond) { __builtin_amdgcn_s_sleep(1); \
    if ((++_sp & 255u) == 0u) { if (xb_ld(&(bar)[XB_TMO])) break; if (_sp > XB_SPIN_CAP) { atomicAdd(&(bar)[XB_TMO], 1u); break; } } } } while (0)
struct XcdBarrier { unsigned* bar; unsigned x; volatile LAS unsigned* st; int wave; };
__device__ __forceinline__ XcdBarrier xcd_barrier_post(unsigned* bar, volatile LAS unsigned* st) {
    XcdBarrier b; b.bar = bar; b.x = xb_xcc_id(); b.st = st; b.wave = __builtin_amdgcn_readfirstlane(threadIdx.x >> 6);
    if (threadIdx.x == 0) (void)xb_add(&bar[XB_XCNT(b.x)], 1u);
    return b;
}
__device__ __forceinline__ void xcd_barrier_complete(unsigned* bar, unsigned x, unsigned& nloc, unsigned& nx) {
    const unsigned G = gridDim.x * gridDim.y * gridDim.z;
    unsigned sum, cnt, mine, sp = 0u;
    for (;;) {
        sum = 0u; cnt = 0u; mine = 0u;
#pragma unroll
        for (unsigned j = 0; j < 16; ++j) { const unsigned c = xb_ld(&bar[XB_XCNT(j)]); sum += c; cnt += (c > 0u) ? 1u : 0u; mine = (j == x) ? c : mine; }
        if (sum == G) break;
        __builtin_amdgcn_s_sleep(1);
        if ((++sp & 255u) == 0u) { if (xb_ld(&bar[XB_TMO])) break; if (sp > XB_SPIN_CAP) { atomicAdd(&bar[XB_TMO], 1u); break; } }
    }
    nloc = mine > 0u ? mine : 1u; nx = cnt > 0u ? cnt : 1u;
}
__device__ __forceinline__ void xcd_barrier(const XcdBarrier& b) {
    asm volatile("s_waitcnt vmcnt(0)" ::: "memory");
    __syncthreads();
    if (b.wave == 0 && lane_id_asm() == 0) {
        unsigned* bar = b.bar;
        __builtin_amdgcn_s_waitcnt(0);
        unsigned nloc = b.st[0], nx = b.st[1];
        if (nloc == 0u) { xcd_barrier_complete(bar, b.x, nloc, nx); b.st[0] = nloc; b.st[1] = nx; }
        const unsigned old = xb_add(&bar[XB_XSUB(b.x)], 1u);
        const unsigned gen = old / nloc;
        if (old + 1u == (gen + 1u) * nloc) {
            __builtin_amdgcn_fence(__ATOMIC_RELEASE, "agent");
            asm volatile("s_waitcnt vmcnt(0)" ::: "memory");
            const unsigned og = xb_add(&bar[XB_TOP], 1u);
            const unsigned tg = og / nx;
            if (og + 1u == (tg + 1u) * nx) xb_add(&bar[XB_TOPGEN], 1u);
            else XB_SPIN(xb_ld(&bar[XB_TOPGEN]) == tg, bar);
            __builtin_amdgcn_fence(__ATOMIC_ACQUIRE, "agent");
            xb_add(&bar[XB_XGEN(b.x)], 1u);
            asm volatile("s_waitcnt vmcnt(0)" ::: "memory");
        } else {
            XB_SPIN(xb_ld(&bar[XB_XGEN(b.x)]) == gen, bar);
            __builtin_amdgcn_fence(__ATOMIC_ACQUIRE, "agent");
            asm volatile("s_waitcnt vmcnt(0)" ::: "memory");
        }
    }
    __syncthreads();
}

#define LDS_WAIT() asm volatile("s_waitcnt lgkmcnt(0)" ::: "memory")
#define LDS_BARRIER() do { asm volatile("s_waitcnt lgkmcnt(0)" ::: "memory"); __builtin_amdgcn_s_barrier(); asm volatile("" ::: "memory"); } while (0)
__device__ __forceinline__ float wave_sum(float v) {
#pragma unroll
    for (int o = 1; o < 64; o <<= 1) v += __shfl_xor(v, o);
    return v;
}
__device__ __forceinline__ void transpose_item(const float* W, int ldw, bf16_t* WT, int ldt, int k0, int n0, int dst_row0, LAS float* scr, int lane, int rstride = 1) {
#pragma unroll 8
    for (int i = 0; i < 32; ++i) { const int kk = 2 * i + (lane >> 5); scr[kk * 33 + (lane & 31)] = W[(size_t)(k0 + kk) * ldw + n0 + (lane & 31)]; }
    LDS_WAIT(); asm volatile("" ::: "memory");
    const int c = lane & 7;
#pragma unroll
    for (int j = 0; j < 4; ++j) { const int n = (lane >> 3) + 8 * j; const LAS float* s = scr + (8 * c) * 33 + n;
        u32x4 o; o.x = pk2(s[0 * 33], s[1 * 33]); o.y = pk2(s[2 * 33], s[3 * 33]); o.z = pk2(s[4 * 33], s[5 * 33]); o.w = pk2(s[6 * 33], s[7 * 33]);
        *(u32x4*)(WT + (size_t)(dst_row0 + n * rstride) * ldt + k0 + 8 * c) = o; }
    LDS_WAIT(); asm volatile("" ::: "memory");
}
constexpr int W1_SH = 6, W2_SH = 7;
__device__ __forceinline__ void conv_moe_wg(const float* w1, const float* w2, unsigned char* W1T, unsigned char* W2T, LAS float* buf, int bx, int G, int tid, int j0, int j1) {
    constexpr int I1 = 8 * 16, I2 = 8 * 8, NIT = NE * (I1 + I2);
    const int lrow = tid >> 5, lcol = (tid & 31) * 4;
    f32x4 ra[8], rb[8];
#define CM_SRC(it_, src_, ldw_) const float* src_; int ldw_; { if ((it_) < NE * I1) { const int e_ = (it_) >> 7, q_ = (it_) & 127, kb_ = q_ >> 4, nb_ = q_ & 15; ldw_ = 2048; src_ = w1 + (size_t)e_ * 1024 * 2048 + (size_t)(128 * kb_) * 2048 + 128 * nb_; } \
        else { const int j_ = (it_) - NE * I1, e_ = j_ >> 6, q_ = j_ & 63, kb_ = q_ >> 3, nb_ = q_ & 7; ldw_ = 1024; src_ = w2 + (size_t)e_ * 1024 * 1024 + (size_t)(128 * kb_) * 1024 + 128 * nb_; } }
#define CM_LOAD(R_, it_) do { CM_SRC(it_, sp_, lw_); _Pragma("unroll") for (int i = 0; i < 8; ++i) R_[i] = __builtin_nontemporal_load((const f32x4*)(sp_ + (size_t)(lrow + 16 * i) * lw_ + lcol)); } while (0)
#define CM_ITEM(R_, it_) do { \
        _Pragma("unroll") for (int i = 0; i < 8; ++i) *(LAS f32x4*)(buf + (lrow + 16 * i) * 132 + (lcol ^ (8 * (i & 3)))) = R_[i];     \
        __syncthreads(); \
        if ((it_) + 2 * G < itend) CM_LOAD(R_, (it_) + 2 * G); \
        unsigned char* dst; float sc; \
        if ((it_) < NE * I1) { const int e = (it_) >> 7, q = (it_) & 127, kb = q >> 4, nb = q & 15; dst = W1T + (size_t)e * 2048 * 1024 + (size_t)(128 * nb) * 1024 + 128 * kb; sc = (float)(1 << W1_SH); } \
        else { const int j = (it_) - NE * I1, e = j >> 6, q = j & 63, kb = q >> 3, nb = q & 7; dst = W2T + (size_t)e * 1024 * 1024 + (size_t)(128 * nb) * 1024 + 128 * kb; sc = (float)(1 << W2_SH); } \
        const int c = tid & 7; \
        _Pragma("unroll") for (int p = 0; p < 2; ++p) { const int nn = (tid >> 3) + 64 * p; const LAS float* sp = buf + (16 * c) * 132 + (nn ^ (8 * (c & 3))); \
            u32x4 o; \
            o.x = pk4_fp8(sp[0 * 132] * sc, sp[1 * 132] * sc, sp[2 * 132] * sc, sp[3 * 132] * sc); o.y = pk4_fp8(sp[4 * 132] * sc, sp[5 * 132] * sc, sp[6 * 132] * sc, sp[7 * 132] * sc); \
            o.z = pk4_fp8(sp[8 * 132] * sc, sp[9 * 132] * sc, sp[10 * 132] * sc, sp[11 * 132] * sc); o.w = pk4_fp8(sp[12 * 132] * sc, sp[13 * 132] * sc, sp[14 * 132] * sc, sp[15 * 132] * sc); \
            *(u32x4*)(dst + (size_t)nn * 1024 + 16 * c) = o; } \
        __syncthreads(); } while (0)
    int it = bx + j0 * G; const int itend = (bx + j1 * G) < NIT ? (bx + j1 * G) : NIT;
    __syncthreads();
    if (it < itend) CM_LOAD(ra, it);
    if (it + G < itend) CM_LOAD(rb, it + G);
    for (; it < itend; it += 2 * G) {
        CM_ITEM(ra, it);
        if (it + G < itend) CM_ITEM(rb, it + G);
    }
#undef CM_ITEM
#undef CM_SRC
#undef CM_LOAD
}
__device__ __forceinline__ void ln_row(f32x4 (&v)[4], const float* w, const float* b, int lane) {
    float s = 0.f;
#pragma unroll
    for (int j = 0; j < 4; ++j) s += (v[j].x + v[j].y) + (v[j].z + v[j].w);
    const float mean = wave_sum(s) * (1.f / D); float s2 = 0.f;
#pragma unroll
    for (int j = 0; j < 4; ++j) { v[j] = v[j] - mean; s2 += (v[j].x * v[j].x + v[j].y * v[j].y) + (v[j].z * v[j].z + v[j].w * v[j].w); }
    const float rstd = 1.f / sqrtf(wave_sum(s2) * (1.f / D) + LN_EPS);
#pragma unroll
    for (int j = 0; j < 4; ++j) { const f32x4 ww = *(const f32x4*)(w + 4 * lane + 256 * j), bb = *(const f32x4*)(b + 4 * lane + 256 * j); v[j] = v[j] * rstd * ww + bb; }
}
__device__ __forceinline__ void moe_table(const unsigned* cnt, LAS int* tab, int tid) {
    if (tid < 32) tab[33 + tid] = (int)__hip_atomic_load(cnt + tid, __ATOMIC_RELAXED, __HIP_MEMORY_SCOPE_AGENT);
    __syncthreads();
    if (tid == 0) { int p = 0; for (int e = 0; e < 32; ++e) { tab[e] = p; p += (tab[33 + e] + 255) >> 8; } tab[32] = p; }
    __syncthreads();
}

constexpr int HG_KUT = 0, HG_DD = 18432, HG_QH = 20480, HG_KD = 37888, HG_OB = 55296, HG_RED = 89088;
template <int MODE>
__device__ __forceinline__ void hgrn_unit(LAS unsigned char* lds, int unit, const bf16_t* PROJ, const bf16_t* IT, float* SLOC, float* DTOT, const float* lbl, const float* anw, bf16_t* AO, int tid, int wave, int lane) {
    const int bh = unit >> 5, sc = unit & 31, b = bh >> 2, h = bh & 3;
    const int t0 = sc * 256;
    const int si = tid >> 7, dk = tid & 127;
    const int g = lane >> 4, c16 = lane & 15;
    float lb;
    { const float l0 = lbl[h * 128 + dk], l1 = lbl[512 + h * 128 + dk], l2 = lbl[1024 + h * 128 + dk]; const float m = fmaxf(l0, fmaxf(l1, l2));
      const float e0 = __expf(l0 - m), e1 = __expf(l1 - m), e2 = __expf(l2 - m); lb = e0 / (e0 + e1 + e2); }
    const float oml = 1.0f - lb;
    f32x4 S[8];
#pragma unroll
    for (int tau = 0; tau < 8; ++tau) {
        if (MODE == 1) {
#pragma unroll
            for (int r = 0; r < 4; ++r) S[tau][r] = SLOC[(size_t)unit * 16384 + (16 * tau + 4 * g + r) * 128 + 16 * wave + c16];
        } else S[tau] = (f32x4){0.f, 0.f, 0.f, 0.f};
    }
    float lsum = 1.f;
    unsigned qz[16]; u32x2 vfn[4];
    const unsigned rlo = (unsigned)(16 * si * 2048 + 2 * dk);
    { const bf16_t* sb = PROJ + ((size_t)b * SEQ + t0) * 2048 + h * 256;
#pragma unroll
      for (int j = 0; j < 16; ++j) qz[j] = *(const unsigned*)(sb + (size_t)j * 2048 + rlo);
      const bf16_t* vp = IT + (size_t)(h * 128 + 16 * wave + c16) * T + (size_t)b * SEQ + t0 + 4 * g;
#pragma unroll
      for (int i = 0; i < 4; ++i) vfn[i] = *(const u32x2*)(vp + 16 * i); }
#pragma unroll 1
    for (int c4 = 0; c4 < 4; ++c4) {
        const int tc = t0 + 64 * c4;
        u32x2 vf[4];
#pragma unroll
        for (int i = 0; i < 4; ++i) vf[i] = vfn[i];
        {
            float cp = 1.f, kdf[16];
#pragma unroll
            for (int j = 0; j < 16; ++j) {
                const float z = bfhi(qz[j]);
                const float s = frcp(1.0f + fexp2(-LOG2E * z));
                const float f = lb + oml * s, kk = oml * (1.0f - s);
                cp *= f; kdf[j] = kk * frcp(cp);
                if (MODE == 1) {
                    const float q = bflo(qz[j]);
                    const unsigned qh = pk2(q * cp, 0.f), kd = pk2(kdf[j], 0.f);
                    *(LAS bf16_t*)(lds + HG_QH + (16 * si + j) * 272 + dk * 2) = (bf16_t)(qh & 0xffffu);
                    *(LAS bf16_t*)(lds + HG_KD + (16 * si + j) * 272 + dk * 2) = (bf16_t)(kd & 0xffffu);
                }
            }
            if (c4 < 3) {
                const bf16_t* sb = PROJ + ((size_t)b * SEQ + tc + 64) * 2048 + h * 256;
#pragma unroll
                for (int j = 0; j < 16; ++j) qz[j] = *(const unsigned*)(sb + (size_t)j * 2048 + rlo);
                const bf16_t* vp = IT + (size_t)(h * 128 + 16 * wave + c16) * T + (size_t)b * SEQ + tc + 64 + 4 * g;
#pragma unroll
                for (int i = 0; i < 4; ++i) vfn[i] = *(const u32x2*)(vp + 16 * i);
            }
            const float dl = cp; lsum *= dl;
            u32x4 w0, w1;
            w0.x = pk2(kdf[0] * dl, kdf[1] * dl); w0.y = pk2(kdf[2] * dl, kdf[3] * dl); w0.z = pk2(kdf[4] * dl, kdf[5] * dl); w0.w = pk2(kdf[6] * dl, kdf[7] * dl);
            w1.x = pk2(kdf[8] * dl, kdf[9] * dl); w1.y = pk2(kdf[10] * dl, kdf[11] * dl); w1.z = pk2(kdf[12] * dl, kdf[13] * dl); w1.w = pk2(kdf[14] * dl, kdf[15] * dl);
            *(LAS u32x4*)(lds + HG_KUT + dk * 144 + si * 32) = w0;
            *(LAS u32x4*)(lds + HG_KUT + dk * 144 + si * 32 + 16) = w1;
            *(LAS float*)(lds + HG_DD + (si * 128 + dk) * 4) = dl;
        }
        LDS_BARRIER();
#pragma unroll
        for (int i = 0; i < 4; ++i) {
            bf16x8 vb; { const s16x4 t4 = __builtin_bit_cast(s16x4, vf[i]); vb = (bf16x8){t4[0], t4[1], t4[2], t4[3], 0, 0, 0, 0}; }
            if (MODE == 1) {
                f32x4 X = (f32x4){0.f, 0.f, 0.f, 0.f};
#pragma unroll
                for (int m = 0; m < 4; ++m) {
                    const bf16x8 a = *(const LAS bf16x8*)(lds + HG_KD + (16 * i + c16) * 272 + (32 * m + 8 * g) * 2);
                    const bf16x8 bq = *(const LAS bf16x8*)(lds + HG_QH + (16 * i + c16) * 272 + (32 * m + 8 * g) * 2);
                    X = __builtin_amdgcn_mfma_f32_16x16x32_bf16(a, bq, X, 0, 0, 0);
                }
#pragma unroll
                for (int r = 0; r < 4; ++r) X[r] = (4 * g + r <= c16) ? X[r] : 0.f;
                bf16x8 xa; { u32x2 p; p.x = pk2(X[0], X[1]); p.y = pk2(X[2], X[3]); const s16x4 t4 = __builtin_bit_cast(s16x4, p); xa = (bf16x8){t4[0], t4[1], t4[2], t4[3], 0, 0, 0, 0}; }
                f32x4 O = (f32x4){0.f, 0.f, 0.f, 0.f};
                O = __builtin_amdgcn_mfma_f32_16x16x32_bf16(xa, vb, O, 0, 0, 0);
#pragma unroll
                for (int m = 0; m < 4; ++m) {
                    u32x4 bs; bs.x = pk2(S[2 * m][0], S[2 * m][1]); bs.y = pk2(S[2 * m][2], S[2 * m][3]); bs.z = pk2(S[2 * m + 1][0], S[2 * m + 1][1]); bs.w = pk2(S[2 * m + 1][2], S[2 * m + 1][3]);
                    const u32x2 q0 = *(const LAS u32x2*)(lds + HG_QH + (16 * i + c16) * 272 + (32 * m + 4 * g) * 2);
                    const u32x2 q1 = *(const LAS u32x2*)(lds + HG_QH + (16 * i + c16) * 272 + (32 * m + 16 + 4 * g) * 2);
                    u32x4 aq; aq.x = q0.x; aq.y = q0.y; aq.z = q1.x; aq.w = q1.y;
                    O = __builtin_amdgcn_mfma_f32_16x16x32_bf16(__builtin_bit_cast(bf16x8, aq), __builtin_bit_cast(bf16x8, bs), O, 0, 0, 0);
                }
#pragma unroll
                for (int r = 0; r < 4; ++r) *(LAS float*)(lds + HG_OB + ((16 * i + 4 * g + r) * 132 + 16 * wave + c16) * 4) = O[r];
            }
#pragma unroll
            for (int tau = 0; tau < 8; ++tau) {
                const f32x4 dd = *(const LAS f32x4*)(lds + HG_DD + (i * 128 + 16 * tau + 4 * g) * 4);
                S[tau] = S[tau] * dd;
                const u32x2 k2 = *(const LAS u32x2*)(lds + HG_KUT + (16 * tau + c16) * 144 + (16 * i + 4 * g) * 2);
                u32x4 ak; ak.x = k2.x; ak.y = k2.y; ak.z = 0u; ak.w = 0u;
                S[tau] = __builtin_amdgcn_mfma_f32_16x16x32_bf16(__builtin_bit_cast(bf16x8, ak), vb, S[tau], 0, 0, 0);
            }
        }
        LDS_BARRIER();
        if (MODE == 1) {
            const int tl = tid >> 3, part = tid & 7;
            float o[16]; float ssq = 0.f;
#pragma unroll
            for (int q4 = 0; q4 < 4; ++q4) { const f32x4 v = *(const LAS f32x4*)(lds + HG_OB + (tl * 132 + 16 * part + 4 * q4) * 4);
                o[4 * q4] = v.x; o[4 * q4 + 1] = v.y; o[4 * q4 + 2] = v.z; o[4 * q4 + 3] = v.w; ssq += (v.x * v.x + v.y * v.y) + (v.z * v.z + v.w * v.w); }
            ssq += __shfl_xor(ssq, 1); ssq += __shfl_xor(ssq, 2); ssq += __shfl_xor(ssq, 4);
            const float rr = 1.0f / sqrtf(ssq * (1.0f / 128.0f) + RMS_EPS);
            const size_t row = (size_t)b * SEQ + tc + tl;
            const u32x4 g0 = *(const u32x4*)(PROJ + row * 2048 + 1024 + h * 128 + 16 * part), g1 = *(const u32x4*)(PROJ + row * 2048 + 1024 + h * 128 + 16 * part + 8);
            float gv[16];
            gv[0] = bflo(g0.x); gv[1] = bfhi(g0.x); gv[2] = bflo(g0.y); gv[3] = bfhi(g0.y); gv[4] = bflo(g0.z); gv[5] = bfhi(g0.z); gv[6] = bflo(g0.w); gv[7] = bfhi(g0.w);
            gv[8] = bflo(g1.x); gv[9] = bfhi(g1.x); gv[10] = bflo(g1.y); gv[11] = bfhi(g1.y); gv[12] = bflo(g1.z); gv[13] = bfhi(g1.z); gv[14] = bflo(g1.w); gv[15] = bfhi(g1.w);
            float r16[16];
#pragma unroll
            for (int j = 0; j < 16; ++j) { const float gg = gv[j]; const float sg = gg * frcp(1.0f + fexp2(-LOG2E * gg)); r16[j] = o[j] * rr * anw[16 * part + j] * sg; }
            u32x4 o0, o1;
            o0.x = pk2(r16[0], r16[1]); o0.y = pk2(r16[2], r16[3]); o0.z = pk2(r16[4], r16[5]); o0.w = pk2(r16[6], r16[7]);
            o1.x = pk2(r16[8], r16[9]); o1.y = pk2(r16[10], r16[11]); o1.z = pk2(r16[12], r16[13]); o1.w = pk2(r16[14], r16[15]);
            *(u32x4*)(AO + row * 1024 + h * 128 + 16 * part) = o0; *(u32x4*)(AO + row * 1024 + h * 128 + 16 * part + 8) = o1;
        }
    }
    if (MODE == 0) {
#pragma unroll
        for (int tau = 0; tau < 8; ++tau)
#pragma unroll
            for (int r = 0; r < 4; ++r) SLOC[(size_t)unit * 16384 + (16 * tau + 4 * g + r) * 128 + 16 * wave + c16] = S[tau][r];
        *(LAS float*)(lds + HG_RED + (si * 128 + dk) * 4) = lsum;
        __syncthreads();
        if (tid < 128) { const float tot = (*(LAS float*)(lds + HG_RED + tid * 4) * *(LAS float*)(lds + HG_RED + (128 + tid) * 4)) * (*(LAS float*)(lds + HG_RED + (256 + tid) * 4) * *(LAS float*)(lds + HG_RED + (384 + tid) * 4));
            DTOT[(size_t)unit * 128 + tid] = tot; }
    }
    __syncthreads();
}

__device__ __forceinline__ void pool_task(int task, const bf16_t* PROJ, bf16_t* AO, int tid) {
    const int b = task >> 6, blk = task & 63;
    const int co = tid & 63, ts = tid >> 6;
    const int W = 2 << (co >> 4);
    const int tb = blk * 128 + 16 * ts;
    const bf16_t* xp = PROJ + (size_t)b * SEQ * 2048 + 1536 + 8 * co;
    float s[8];
#pragma unroll
    for (int c = 0; c < 8; ++c) s[c] = 0.f;
    for (int r = 1; r < W; ++r) { const int t = tb - r; if (t >= 0) { const u32x4 v = *(const u32x4*)(xp + (size_t)t * 2048);
        s[0] += bflo(v.x); s[1] += bfhi(v.x); s[2] += bflo(v.y); s[3] += bfhi(v.y); s[4] += bflo(v.z); s[5] += bfhi(v.z); s[6] += bflo(v.w); s[7] += bfhi(v.w); } }
    for (int j = 0; j < 16; ++j) {
        const int t = tb + j;
        const u32x4 v = *(const u32x4*)(xp + (size_t)t * 2048);
        float x[8]; x[0] = bflo(v.x); x[1] = bfhi(v.x); x[2] = bflo(v.y); x[3] = bfhi(v.y); x[4] = bflo(v.z); x[5] = bfhi(v.z); x[6] = bflo(v.w); x[7] = bfhi(v.w);
        const float cnt = (float)((t + 1) < W ? (t + 1) : W);
        float o[8];
#pragma unroll
        for (int c = 0; c < 8; ++c) { s[c] += x[c]; o[c] = s[c] / cnt - x[c]; }
        u32x4 w; w.x = pk2(o[0], o[1]); w.y = pk2(o[2], o[3]); w.z = pk2(o[4], o[5]); w.w = pk2(o[6], o[7]);
        *(u32x4*)(AO + ((size_t)b * SEQ + t) * 1024 + 512 + 8 * co) = w;
        const int tr = t - W + 1;
        if (tr >= 0) { const u32x4 u = *(const u32x4*)(xp + (size_t)tr * 2048);
            s[0] -= bflo(u.x); s[1] -= bfhi(u.x); s[2] -= bflo(u.y); s[3] -= bfhi(u.y); s[4] -= bflo(u.z); s[5] -= bfhi(u.z); s[6] -= bflo(u.w); s[7] -= bfhi(u.w); }
    }
}

constexpr int RT_YS = 1028;
constexpr int RT_Y = 0, RT_PART = 66048, RT_LOG = 82432, RT_SELE = 99328, RT_SELG = 101376, RT_SELR = 103424, RT_HIST = 105472, RT_BASE = 105600;
__device__ __forceinline__ void wave_sum4(float& a, float& b, float& c, float& d) {
#pragma unroll
    for (int o = 1; o < 64; o <<= 1) { const float ta = __shfl_xor(a, o), tb = __shfl_xor(b, o), tc = __shfl_xor(c, o), td = __shfl_xor(d, o); a += ta; b += tb; c += tc; d += td; }
}
__device__ __forceinline__ void split_hl(const float (&x)[8], u32x4& hi, u32x4& lo) {
    unsigned h[4], l[4];
#pragma unroll
    for (int i = 0; i < 4; ++i) { h[i] = pk2(x[2 * i], x[2 * i + 1]); l[i] = pk2(x[2 * i] - bflo(h[i]), x[2 * i + 1] - bfhi(h[i])); }
    hi = (u32x4){h[0], h[1], h[2], h[3]}; lo = (u32x4){l[0], l[1], l[2], l[3]};
}
__device__ __forceinline__ void router_load_w(const float* wr, u32x4 (&wreg)[16], int wave, int lane) {
    const float* wp = wr + (size_t)(128 * wave + 8 * (lane >> 4)) * 32 + (lane & 15);
#pragma unroll
    for (int kk = 0; kk < 4; ++kk)
#pragma unroll
        for (int tl = 0; tl < 2; ++tl) { float x[8];
#pragma unroll
            for (int j = 0; j < 8; ++j) x[j] = wp[(32 * kk + j) * 32 + 16 * tl];
            split_hl(x, wreg[(kk * 2 + tl) * 2], wreg[(kk * 2 + tl) * 2 + 1]); }
}
template <bool XF32>
__device__ __forceinline__ void router_block(LAS unsigned char* lds, int blk, const float* X32, const bf16_t* XB, bf16_t* XBo, unsigned char* XB8, const bf16_t* H, const float* lnw, const float* lnb,
                                             const u32x4 (&wreg)[16], const float* br, unsigned* cnt, int* tokl, float* gatel, int* tinfo, int tid, int wave, int lane) {
    const int c16 = lane & 15, g = lane >> 4;
    if (tid < 32) *(LAS unsigned*)(lds + RT_HIST + tid * 4) = 0u;
    u32x2 hq[2][4]; f32x4 xq[2][4]; u32x2 xh[2][4];
    const unsigned lo4 = 4u * (unsigned)lane;
#define RT_LOAD(bt_) do { _Pragma("unroll") for (int k = 0; k < 2; ++k) { const size_t t_ = (size_t)blk * 128 + 16 * (bt_) + 2 * wave + k; \
        const bf16_t* hb_ = H + t_ * 1024; const float* xb_ = X32 + t_ * 1024; const bf16_t* xh_ = XB + t_ * 1024; _Pragma("unroll") for (int j = 0; j < 4; ++j) { \
        hq[k][j] = *(const u32x2*)(hb_ + 256 * j + lo4); \
        if constexpr (XF32) xq[k][j] = *(const f32x4*)(xb_ + 256 * j + lo4); else xh[k][j] = *(const u32x2*)(xh_ + 256 * j + lo4); } } } while (0)
    RT_LOAD(0);
    LDS_BARRIER();
#pragma unroll 1
    for (int bt = 0; bt < 8; ++bt) {
        f32x4 v[2][4]; float s1[2], s2[2];
#pragma unroll
        for (int k = 0; k < 2; ++k) { s1[k] = 0.f; s2[k] = 0.f;
#pragma unroll
            for (int j = 0; j < 4; ++j) {
                f32x4 xr; if constexpr (XF32) xr = xq[k][j]; else xr = (f32x4){bflo(xh[k][j].x), bfhi(xh[k][j].x), bflo(xh[k][j].y), bfhi(xh[k][j].y)};
                const f32x4 t4 = xr * ALPHA + (f32x4){bflo(hq[k][j].x), bfhi(hq[k][j].x), bflo(hq[k][j].y), bfhi(hq[k][j].y)};
                v[k][j] = t4; s1[k] += (t4.x + t4.y) + (t4.z + t4.w); s2[k] += (t4.x * t4.x + t4.y * t4.y) + (t4.z * t4.z + t4.w * t4.w); } }
        if (bt < 7) RT_LOAD(bt + 1);
        wave_sum4(s1[0], s2[0], s1[1], s2[1]);
#pragma unroll
        for (int k = 0; k < 2; ++k) {
            const int tl = 2 * wave + k; const size_t t = (size_t)blk * 128 + 16 * bt + tl;
            const float mean = s1[k] * (1.f / D); const float var = fmaxf(s2[k] * (1.f / D) - mean * mean, 0.f); const float rstd = 1.f / sqrtf(var + LN_EPS);
            bf16_t* xo_ = XBo + t * 1024; unsigned char* x8_ = XB8 + t * 1024;
#pragma unroll
            for (int j = 0; j < 4; ++j) { const f32x4 ww = *(const f32x4*)(lnw + 256 * j + lo4), bb = *(const f32x4*)(lnb + 256 * j + lo4);
                const f32x4 y = (v[k][j] - mean) * rstd * ww + bb;
                u32x2 o; o.x = pk2(y.x, y.y); o.y = pk2(y.z, y.w); *(u32x2*)(xo_ + 256 * j + lo4) = o;
                *(unsigned*)(x8_ + 256 * j + lo4) = pk4_fp8(y.x, y.y, y.z, y.w);
                *(LAS f32x4*)(lds + RT_Y + (tl * RT_YS + 4 * lane + 256 * j) * 4) = y; }
        }
        LDS_BARRIER();
        {
            f32x4 a0 = (f32x4){0.f, 0.f, 0.f, 0.f}, a1 = a0;
            const LAS float* yp = (const LAS float*)(lds + RT_Y) + c16 * RT_YS + 128 * wave + 8 * g; asm volatile("" : "+v"(yp));
#pragma unroll
            for (int kk = 0; kk < 4; ++kk) {
                const f32x4 ya = *(const LAS f32x4*)(yp + 32 * kk), yb = *(const LAS f32x4*)(yp + 32 * kk + 4);
                const float x[8] = {ya.x, ya.y, ya.z, ya.w, yb.x, yb.y, yb.z, yb.w};
                u32x4 yh, yl; split_hl(x, yh, yl);
                const bf16x8 ah = __builtin_bit_cast(bf16x8, yh), al = __builtin_bit_cast(bf16x8, yl);
#pragma unroll
                for (int tl = 0; tl < 2; ++tl) { const bf16x8 wh = __builtin_bit_cast(bf16x8, wreg[(kk * 2 + tl) * 2]), wl = __builtin_bit_cast(bf16x8, wreg[(kk * 2 + tl) * 2 + 1]);
                    f32x4 acc = tl ? a1 : a0;
                    acc = __builtin_amdgcn_mfma_f32_16x16x32_bf16(al, wh, acc, 0, 0, 0); acc = __builtin_amdgcn_mfma_f32_16x16x32_bf16(ah, wl, acc, 0, 0, 0); acc = __builtin_amdgcn_mfma_f32_16x16x32_bf16(ah, wh, acc, 0, 0, 0);
                    if (tl) a1 = acc; else a0 = acc; }
            }
            LAS float* pp = (LAS float*)(lds + RT_PART) + (wave * 16 + 4 * g) * 32 + c16;
#pragma unroll
            for (int r = 0; r < 4; ++r) { pp[r * 32] = a0[r]; pp[r * 32 + 16] = a1[r]; }
        }
        LDS_BARRIER();
        {
            const int tk = tid >> 5, e = tid & 31;
            float lg = br[e];
            const LAS float* pp = (const LAS float*)(lds + RT_PART) + tk * 32 + e; asm volatile("" : "+v"(pp));
#pragma unroll
            for (int w = 0; w < 8; ++w) lg += pp[w * 512];
            *(LAS float*)(lds + RT_LOG + ((16 * bt + tk) * 33 + e) * 4) = lg;
        }
    }
#undef RT_LOAD
    LDS_BARRIER();
    if (tid < 128) {
        const LAS float* lp = (const LAS float*)(lds + RT_LOG) + tid * 33;
        float v0 = -INFINITY, v1 = -INFINITY, v2 = -INFINITY, v3 = -INFINITY; int i0 = 0, i1 = 0, i2 = 0, i3 = 0;
#pragma unroll
        for (int e = 0; e < 32; ++e) { const float x = lp[e];
            const bool g0 = x > v0, g1 = x > v1, g2 = x > v2, g3 = x > v3;
            v3 = g2 ? v2 : (g3 ? x : v3); i3 = g2 ? i2 : (g3 ? e : i3);
            v2 = g1 ? v1 : (g2 ? x : v2); i2 = g1 ? i1 : (g2 ? e : i2);
            v1 = g0 ? v0 : (g1 ? x : v1); i1 = g0 ? i0 : (g1 ? e : i1);
            v0 = g0 ? x : v0; i0 = g0 ? e : i0; }
        const float e1 = __expf(v1 - v0), e2 = __expf(v2 - v0), e3 = __expf(v3 - v0);
        const float inv = 1.0f / (1.0f + e1 + e2 + e3);
        const int mi[4] = {i0, i1, i2, i3}; const float gt[4] = {inv, e1 * inv, e2 * inv, e3 * inv};
#pragma unroll
        for (int k = 0; k < 4; ++k) {
            const unsigned lr = __hip_atomic_fetch_add((LAS unsigned*)(lds + RT_HIST + mi[k] * 4), 1u, __ATOMIC_RELAXED, __HIP_MEMORY_SCOPE_WORKGROUP);
            const int sidx = tid * 4 + k;
            *(LAS int*)(lds + RT_SELE + sidx * 4) = mi[k]; *(LAS float*)(lds + RT_SELG + sidx * 4) = gt[k]; *(LAS unsigned*)(lds + RT_SELR + sidx * 4) = lr;
        }
    }
    LDS_BARRIER();
    if (tid < 32) { const unsigned hc = *(LAS unsigned*)(lds + RT_HIST + tid * 4);
        *(LAS unsigned*)(lds + RT_BASE + tid * 4) = __hip_atomic_fetch_add(cnt + tid, hc, __ATOMIC_RELAXED, __HIP_MEMORY_SCOPE_AGENT); }
    __syncthreads();
    {
        const int me = *(LAS int*)(lds + RT_SELE + tid * 4); const float gt = *(LAS float*)(lds + RT_SELG + tid * 4);
        const unsigned rank = *(LAS unsigned*)(lds + RT_BASE + me * 4) + *(LAS unsigned*)(lds + RT_SELR + tid * 4);
        const int tok = blk * 128 + (tid >> 2);
        tokl[(size_t)me * T + rank] = tok; gatel[(size_t)me * T + rank] = gt; tinfo[(size_t)tok * 4 + (tid & 3)] = (me << 16) | (int)rank;
    }
    __syncthreads();
}

__device__ __forceinline__ void combine_rows2(size_t t0, size_t t1, const unsigned char* Y, const int* tinfo, const LAS int* tab, const bf16_t* XB, bf16_t* XBo, float* OUT32, const f32x4 (&lw)[4], const f32x4 (&lb)[4], int lane) {
    f32x4 v[2][4]; float s1[2], s2[2];
#pragma unroll
    for (int k2 = 0; k2 < 2; ++k2) {
        const size_t t = k2 ? t1 : t0;
        const u32x4 x0 = *(const u32x4*)(XB + t * 1024 + 16 * lane), x1 = *(const u32x4*)(XB + t * 1024 + 16 * lane + 8);
        const u32x4 inf4 = *(const u32x4*)(tinfo + t * 4);
        v[k2][0] = (f32x4){bflo(x0.x), bfhi(x0.x), bflo(x0.y), bfhi(x0.y)} * ALPHA; v[k2][1] = (f32x4){bflo(x0.z), bfhi(x0.z), bflo(x0.w), bfhi(x0.w)} * ALPHA;
        v[k2][2] = (f32x4){bflo(x1.x), bfhi(x1.x), bflo(x1.y), bfhi(x1.y)} * ALPHA; v[k2][3] = (f32x4){bflo(x1.z), bfhi(x1.z), bflo(x1.w), bfhi(x1.w)} * ALPHA;
        u32x4 yy[4];
#pragma unroll
        for (int k = 0; k < 4; ++k) { const unsigned inf = k == 0 ? inf4.x : k == 1 ? inf4.y : k == 2 ? inf4.z : inf4.w; const int ee = (int)(inf >> 16), rk = (int)(inf & 0xffffu);
            const size_t slot = (size_t)tab[ee] * 256 + rk; yy[k] = *(const u32x4*)(Y + slot * 1024 + 16 * lane); }
#pragma unroll
        for (int k = 0; k < 4; ++k) {
#pragma unroll
            for (int j = 0; j < 4; ++j) { const int w = (int)(j == 0 ? yy[k].x : j == 1 ? yy[k].y : j == 2 ? yy[k].z : yy[k].w);
                const f32x2 lo2 = __builtin_amdgcn_cvt_pk_f32_fp8(w, false), hi2 = __builtin_amdgcn_cvt_pk_f32_fp8(w, true);
                v[k2][j] = v[k2][j] + (f32x4){lo2.x, lo2.y, hi2.x, hi2.y} * 0.0625f; } }
        float a = 0.f, q = 0.f;
#pragma unroll
        for (int j = 0; j < 4; ++j) { const f32x4 u = v[k2][j]; a += (u.x + u.y) + (u.z + u.w); q += (u.x * u.x + u.y * u.y) + (u.z * u.z + u.w * u.w); }
        s1[k2] = a; s2[k2] = q;
    }
    wave_sum4(s1[0], s2[0], s1[1], s2[1]);
#pragma unroll
    for (int k2 = 0; k2 < 2; ++k2) {
        const size_t t = k2 ? t1 : t0;
        const float mean = s1[k2] * (1.f / D); const float var = fmaxf(s2[k2] * (1.f / D) - mean * mean, 0.f); const float rstd = 1.f / sqrtf(var + LN_EPS);
        f32x4 y[4];
#pragma unroll
        for (int j = 0; j < 4; ++j) y[j] = (v[k2][j] - mean) * rstd * lw[j] + lb[j];
        if (OUT32) {
#pragma unroll
            for (int j = 0; j < 4; ++j) *(f32x4*)(OUT32 + t * 1024 + 16 * lane + 4 * j) = y[j];
        } else {
            u32x4 o0, o1; o0.x = pk2(y[0].x, y[0].y); o0.y = pk2(y[0].z, y[0].w); o0.z = pk2(y[1].x, y[1].y); o0.w = pk2(y[1].z, y[1].w);
            o1.x = pk2(y[2].x, y[2].y); o1.y = pk2(y[2].z, y[2].w); o1.z = pk2(y[3].x, y[3].y); o1.w = pk2(y[3].z, y[3].w);
            *(u32x4*)(XBo + t * 1024 + 16 * lane) = o0; *(u32x4*)(XBo + t * 1024 + 16 * lane + 8) = o1;
        }
    }
}

__device__ __forceinline__ int crow(int r, int hi) { return (r & 3) + 8 * (r >> 2) + 4 * hi; }
__device__ __forceinline__ void attn_phase(const bf16_t* QB, const bf16_t* KB, const bf16_t* VT, bf16_t* AO, int gw, int ngw, int lane) {
    const int r32 = lane & 31, hi = lane >> 5;
    for (int task = gw; task < BATCH * 16 * (SEQ / 32); task += ngw) {
        const int qt = task & 255, bh = task >> 8, b = bh >> 4, h = bh & 15;
        const size_t rowb = (size_t)b * SEQ; const int q0 = qt * 32;
        bf16x8 qf[4];
        { const bf16_t* qp = QB + (rowb + q0 + r32) * 1024 + h * 64 + hi * 8;
#pragma unroll
          for (int s = 0; s < 4; ++s) qf[s] = *(const bf16x8*)(qp + 16 * s); }
        f32x16 o0, o1;
#pragma unroll
        for (int r = 0; r < 16; ++r) { o0[r] = 0.f; o1[r] = 0.f; }
        float carry = 1.f;
        const bf16_t* kbase = KB + (size_t)bh * 256 * 4 * 64 * 8 + lane * 8;
        const bf16_t* vbase = VT + (size_t)bh * 256 * 4 * 64 * 8 + lane * 8;
        bf16x8 kn[4];
#pragma unroll
        for (int s = 0; s < 4; ++s) kn[s] = *(const bf16x8*)(kbase + (size_t)qt * 2048 + s * 512);
        for (int kt = qt; kt >= 0; --kt) {
            bf16x8 kf[4];
#pragma unroll
            for (int s = 0; s < 4; ++s) kf[s] = kn[s];
            bf16x8 va[2][2];
#pragma unroll
            for (int dt = 0; dt < 2; ++dt)
#pragma unroll
                for (int sp = 0; sp < 2; ++sp) va[dt][sp] = *(const bf16x8*)(vbase + (size_t)kt * 2048 + (dt * 2 + sp) * 512);
            { const int kp = kt > 0 ? kt - 1 : 0;
#pragma unroll
              for (int s = 0; s < 4; ++s) kn[s] = *(const bf16x8*)(kbase + (size_t)kp * 2048 + s * 512); }
            f32x16 st;
#pragma unroll
            for (int r = 0; r < 16; ++r) st[r] = 0.f;
#pragma unroll
            for (int s = 0; s < 4; ++s) st = __builtin_amdgcn_mfma_f32_32x32x16_bf16(kf[s], qf[s], st, 0, 0, 0);
            const bool diag = (kt == qt);
            float R[16], Bt[16];
#pragma unroll
            for (int r = 0; r < 16; r += 2) {
                const f32x2 e = (f32x2){fexp2(st[r]), fexp2(st[r + 1])};
                const f32x2 d = e + 1.0f;
                f32x2 rr = (f32x2){frcp(d.x), frcp(d.y)};
                if (diag) { rr.x = (crow(r, hi) < r32) ? rr.x : 1.0f; rr.y = (crow(r + 1, hi) < r32) ? rr.y : 1.0f; }
                const f32x2 bt = 1.0f - rr;
                R[r] = rr.x; R[r + 1] = rr.y; Bt[r] = bt.x; Bt[r + 1] = bt.y;
            }
            float own[4], pg[4];
#pragma unroll
            for (int rg = 0; rg < 4; ++rg) { own[rg] = (R[4 * rg] * R[4 * rg + 1]) * (R[4 * rg + 2] * R[4 * rg + 3]); pg[rg] = __shfl_xor(own[rg], 32); }
            float aft[4];
            { float run = 1.f;
#pragma unroll
              for (int rg = 3; rg >= 0; --rg) { aft[rg] = (hi == 0) ? run * pg[rg] : run; run *= own[rg] * pg[rg]; }
              float w[16];
#pragma unroll
              for (int rg = 0; rg < 4; ++rg) { float lat = carry * aft[rg];
#pragma unroll
                  for (int p = 3; p >= 0; --p) { w[4 * rg + p] = Bt[4 * rg + p] * lat; lat *= R[4 * rg + p]; } }
              carry *= run;
              u32x4 p0, p1;
              p0.x = pk2(w[0], w[1]); p0.y = pk2(w[2], w[3]); p0.z = pk2(w[4], w[5]); p0.w = pk2(w[6], w[7]);
              p1.x = pk2(w[8], w[9]); p1.y = pk2(w[10], w[11]); p1.z = pk2(w[12], w[13]); p1.w = pk2(w[14], w[15]);
              const bf16x8 pf0 = __builtin_bit_cast(bf16x8, p0), pf1 = __builtin_bit_cast(bf16x8, p1);
              o0 = __builtin_amdgcn_mfma_f32_32x32x16_bf16(va[0][0], pf0, o0, 0, 0, 0); o0 = __builtin_amdgcn_mfma_f32_32x32x16_bf16(va[0][1], pf1, o0, 0, 0, 0);
              o1 = __builtin_amdgcn_mfma_f32_32x32x16_bf16(va[1][0], pf0, o1, 0, 0, 0); o1 = __builtin_amdgcn_mfma_f32_32x32x16_bf16(va[1][1], pf1, o1, 0, 0, 0);
            }
            if (__all(carry < ATT_THR)) break;
        }
        bf16_t* op = AO + (rowb + q0 + r32) * 1024 + h * 64 + 4 * hi;
#pragma unroll
        for (int rg = 0; rg < 4; ++rg) {
            u32x2 w; w.x = pk2(o0[4 * rg], o0[4 * rg + 1]); w.y = pk2(o0[4 * rg + 2], o0[4 * rg + 3]); *(u32x2*)(op + 8 * rg) = w;
            w.x = pk2(o1[4 * rg], o1[4 * rg + 1]); w.y = pk2(o1[4 * rg + 2], o1[4 * rg + 3]); *(u32x2*)(op + 32 + 8 * rg) = w;
        }
    }
}

constexpr int NWAVES = 8;
constexpr int NPHASE = 17;
struct Args { const float* in[29]; float* out; unsigned char* ws; int ph_lo, ph_hi; };

#ifndef PH_MASK
#define PH_MASK 0xfff
#endif
#define EN(b) ((PH_MASK >> (b)) & 1)
#ifndef REP_MASK
#define REP_MASK 0
#endif
#define RP(b) ((REP_MASK >> (b)) & 1)
#define PHASE(b, k, ...) if (EN(b) && IN(k)) { PH_IDS; { __VA_ARGS__ } if (RP(b)) { __VA_ARGS__ } }
#define IN(k) (lo <= (k) && (k) < hi)
#if MK_PER_PHASE
#define SEAM(k) do { } while (0)
#else
#define SEAM(k) do { if (IN(k) && IN((k) + 1)) xcd_barrier(bar); } while (0)
#endif
#define PH_IDS const int lane = lane_id_asm(); const int wave = wave0; const int tid = wave * 64 + lane; const int G = gridDim.x, bx = blockIdx.x; const int gw = bx * NWAVES + wave, NGW = G * NWAVES; (void)tid; (void)lane; (void)gw; (void)NGW; (void)G; (void)bx
#define WSP(T_, off) ((T_*)(args.ws + (off)))

template <int LAYER>
__device__ __forceinline__ void layer_tail(const Args& args, LAS unsigned char* lds, const XcdBarrier& bar, int lo, int hi, const int wave0) {
    constexpr int PB = LAYER == 0 ? 5 : 12;
    LAS int* moetab = (LAS int*)(lds + MOETAB_OFF);
    LAS unsigned* rowtab = (LAS unsigned*)(lds + ROWTAB_OFF);
    PHASE(5, PB,
        pg8::Gemm g{WSP(bf16_t, WS_SB), WSP(bf16_t, LAYER ? WS_WO1T : WS_WO0T), 1024, 0}; pg8::StaticOrder S; S.init(T, 1024, G, bx); pg8::EpiPlain E{WSP(bf16_t, WS_SB + 64 * MiB), 1024, 0, 0, 1.f};
        pg8::gemm_phase<pg8::EpiPlain, pg8::StaticOrder, 0>(lds, g, S, E, nullptr, rowtab, tid);)
    SEAM(PB);
    if (RP(6) && EN(6) && IN(PB + 1)) { PH_IDS;
        unsigned* cnt = WSP(unsigned, WS_CTL) + CW_CNT + 128 + LAYER * 64;
        u32x4 wreg[16]; router_load_w(args.in[LAYER ? 21 : 9], wreg, wave, lane);
        for (int blk = bx; blk < T / 128; blk += G)
            router_block<LAYER == 0>(lds, blk, LAYER ? nullptr : args.in[0], WSP(bf16_t, WS_XB), WSP(bf16_t, WS_END), WSP(unsigned char, WS_END + 64 * MiB), WSP(bf16_t, WS_SB + 64 * MiB), args.in[LAYER ? 19 : 7], args.in[LAYER ? 20 : 8], wreg, args.in[LAYER ? 22 : 10],
                         cnt, WSP(int, WS_END + 96 * MiB), WSP(float, WS_END + 100 * MiB), WSP(int, WS_END + 104 * MiB), tid, wave, lane); }
    if (EN(6) && IN(PB + 1)) { PH_IDS;
        unsigned* cnt = WSP(unsigned, WS_CTL) + CW_CNT + LAYER * 64;
        u32x4 wreg[16]; router_load_w(args.in[LAYER ? 21 : 9], wreg, wave, lane);
        for (int blk = bx; blk < T / 128; blk += G)
            router_block<LAYER == 0>(lds, blk, LAYER ? nullptr : args.in[0], WSP(bf16_t, WS_XB), WSP(bf16_t, WS_XB), WSP(unsigned char, WS_XB8), WSP(bf16_t, WS_SB + 64 * MiB), args.in[LAYER ? 19 : 7], args.in[LAYER ? 20 : 8], wreg, args.in[LAYER ? 22 : 10],
                         cnt, WSP(int, WS_TOKL), WSP(float, WS_GATEL), WSP(int, WS_TINFO), tid, wave, lane); }
    SEAM(PB + 1);
    PHASE(7, PB + 2,
        moe_table(WSP(unsigned, WS_CTL) + CW_CNT + LAYER * 64, moetab, tid);
        pg8::Gemm g{WSP(bf16_t, WS_XB8), WSP(bf16_t, WS_W1T), 512, 2048}; pg8::MoeOrder S; S.init(moetab, 8, G, bx); pg8::EpiSwiglu8 E{WSP(unsigned char, WS_SA), args.in[LAYER ? 24 : 12]};
        pg8::gemm_phase<pg8::EpiSwiglu8, pg8::MoeOrder, 1, 127 - W1_SH>(lds, g, S, E, WSP(int, WS_TOKL), rowtab, tid);)
    SEAM(PB + 2);
    PHASE(8, PB + 3,
        moe_table(WSP(unsigned, WS_CTL) + CW_CNT + LAYER * 64, moetab, tid);
        pg8::Gemm g{WSP(bf16_t, WS_SA), WSP(bf16_t, WS_W2T), 512, 1024}; pg8::MoeOrder S; S.init(moetab, 4, G, bx); pg8::EpiDown8 E{WSP(unsigned char, WS_SB), args.in[LAYER ? 26 : 14], WSP(float, WS_GATEL)};
        pg8::gemm_phase<pg8::EpiDown8, pg8::MoeOrder, 2, 127 - W2_SH>(lds, g, S, E, nullptr, rowtab, tid);)
    SEAM(PB + 3);
    if (EN(9) && IN(PB + 4)) { PH_IDS;
        moe_table(WSP(unsigned, WS_CTL) + CW_CNT + LAYER * 64, moetab, tid);
        f32x4 lw[4], lb[4];
#pragma unroll
        for (int j = 0; j < 4; ++j) { lw[j] = *(const f32x4*)(args.in[LAYER ? 27 : 15] + 16 * lane + 4 * j); lb[j] = *(const f32x4*)(args.in[LAYER ? 28 : 16] + 16 * lane + 4 * j); }
        if (RP(9)) { for (int t = gw; t < T; t += 2 * NGW) combine_rows2((size_t)t, (size_t)(t + NGW), WSP(unsigned char, WS_SB), WSP(int, WS_TINFO), moetab, WSP(bf16_t, WS_XB), WSP(bf16_t, WS_END), LAYER ? (float*)WSP(float, WS_END) : nullptr, lw, lb, lane); }
        for (int t = gw; t < T; t += 2 * NGW) combine_rows2((size_t)t, (size_t)(t + NGW), WSP(unsigned char, WS_SB), WSP(int, WS_TINFO), moetab, WSP(bf16_t, WS_XB), WSP(bf16_t, WS_XB), LAYER ? args.out : nullptr, lw, lb, lane);
    }
    if (LAYER == 0) SEAM(PB + 4);
}

__global__ void __launch_bounds__(NWAVES * 64, 2) mk_fwd(Args args) {
    extern __shared__ __attribute__((aligned(16))) unsigned char lds_raw[];
    LAS unsigned char* lds = (LAS unsigned char*)lds_raw;
    volatile LAS unsigned* MISC = (volatile LAS unsigned*)(lds + MISC_OFF);
    LAS unsigned* rowtab = (LAS unsigned*)(lds + ROWTAB_OFF);
    if (threadIdx.x < 32) MISC[threadIdx.x] = 0u;
    __syncthreads();
    const int wave0 = __builtin_amdgcn_readfirstlane(threadIdx.x >> 6);
    XcdBarrier bar; bar.bar = WSP(unsigned, WS_CTL) + CW_BAR; bar.x = 0; bar.st = nullptr; bar.wave = wave0;
#if !MK_PER_PHASE
    bar = xcd_barrier_post(WSP(unsigned, WS_CTL) + CW_BAR, MISC + 8);
#endif
    const int lo = args.ph_lo, hi = args.ph_hi;

    PHASE(0, 0,
        const float* x_in = args.in[0]; const float* w_in0 = args.in[2]; const float* wpool = args.in[4]; const float* pscale = args.in[5]; const float* w_o0 = args.in[6];
        const float* w_in1 = args.in[17]; const float* w_o1 = args.in[18];
        bf16_t* WIN0T = WSP(bf16_t, WS_WIN0T); bf16_t* WO0T = WSP(bf16_t, WS_WO0T); bf16_t* WIN1T = WSP(bf16_t, WS_WIN1T); bf16_t* WO1T = WSP(bf16_t, WS_WO1T); bf16_t* XB = WSP(bf16_t, WS_XB);
        LAS float* scr = (LAS float*)(lds + wave * 16384);
        constexpr int I_IN0 = 16 * 80, I_O0 = 8 * 32, I_IN1 = 16 * 96, I_O1 = 16 * 32, NIT = I_IN0 + I_O0 + I_IN1 + I_O1;
        for (int it = gw; it < NIT; it += NGW) {
            int r = it;
            if (r < I_IN0) { const int kb = r / 80, nb = r % 80, n0 = 32 * nb;
                const int dr = n0 < 512 ? 2 * n0 : (n0 < 1024 ? 2 * (n0 - 512) + 1 : (n0 < 1536 ? n0 + 1024 : n0 - 512));
                transpose_item(w_in0, 2560, WIN0T, 1024, 64 * kb, n0, dr, scr, lane, n0 < 1024 ? 2 : 1); continue; } r -= I_IN0;
            if (r < I_O0) { const int kb = r / 32, nb = r % 32; transpose_item(w_o0, 1024, WO0T, 1024, 64 * kb, 32 * nb, 32 * nb, scr, lane); continue; } r -= I_O0;
            if (r < I_IN1) { const int kb = r / 96, nb = r % 96; transpose_item(w_in1, 3072, WIN1T, 1024, 64 * kb, 32 * nb, 32 * nb, scr, lane); continue; } r -= I_IN1;
            { const int kb = r / 32, nb = r % 32; transpose_item(w_o1, 1024, WO1T, 1024, 64 * kb, 32 * nb, 32 * nb, scr, lane); }
        }
        for (int idx = bx * 512 + tid; idx < 512 * 1024; idx += G * 512) {
            const int n = idx & 1023, gc = idx >> 10, gg = gc >> 7;
            const float* wp = wpool + (size_t)gc * 128; const float* ps = pscale + 128 * gg; const float* wo = w_o0 + (size_t)(512 + 128 * gg) * 1024 + n;
            float a = 0.f;
_Pragma("unroll 8")
            for (int d = 0; d < 128; ++d) a += wp[d] * ps[d] * wo[(size_t)d * 1024];
            WO0T[(size_t)n * 1024 + 512 + gc] = (bf16_t)(pk2(a, 0.f) & 0xffffu);
        }
        for (size_t i = (size_t)bx * 512 + tid; i < (size_t)T * D / 8; i += (size_t)G * 512) {
            const f32x4 a = *(const f32x4*)(x_in + i * 8), b2 = *(const f32x4*)(x_in + i * 8 + 4);
            u32x4 o; o.x = pk2(a.x, a.y); o.y = pk2(a.z, a.w); o.z = pk2(b2.x, b2.y); o.w = pk2(b2.z, b2.w);
            *(u32x4*)(XB + i * 8) = o;
        })
    SEAM(0);
    PHASE(1, 1,
        { pg8::Gemm g{WSP(bf16_t, WS_XB), WSP(bf16_t, WS_WIN0T), 1024, 0}; pg8::StaticOrder S; S.init(T, 2048, G, bx); pg8::EpiPlain E{WSP(bf16_t, WS_SA), 2048, 0, 0, 1.f};
          pg8::gemm_phase<pg8::EpiPlain, pg8::StaticOrder, 0>(lds, g, S, E, nullptr, rowtab, tid); }
        { pg8::Gemm g{WSP(bf16_t, WS_WIN0T) + (size_t)2048 * 1024, WSP(bf16_t, WS_XB), 1024, 0}; pg8::StaticOrder S; S.init(512, T, G, bx); pg8::EpiPlain E{WSP(bf16_t, WS_SA + 128 * MiB), T, 0, 0, 1.f};
          pg8::gemm_phase<pg8::EpiPlain, pg8::StaticOrder, 0>(lds, g, S, E, nullptr, rowtab, tid); })
    SEAM(1);
#define HG_UNIT0(u_) hgrn_unit<0>(lds, u_, WSP(bf16_t, WS_SA), WSP(bf16_t, WS_SA + 128 * MiB), WSP(float, WS_SB + 128 * MiB), WSP(float, WS_SB + 160 * MiB), args.in[1], args.in[3], WSP(bf16_t, WS_SB), tid, wave, lane)
#define HG_UNIT1(u_) hgrn_unit<1>(lds, u_, WSP(bf16_t, WS_SA), WSP(bf16_t, WS_SA + 128 * MiB), WSP(float, WS_SB + 128 * MiB), WSP(float, WS_SB + 160 * MiB), args.in[1], args.in[3], WSP(bf16_t, WS_SB), tid, wave, lane)
#define CONV0(q0_, q1_) conv_moe_wg(args.in[11], args.in[13], WSP(unsigned char, WS_W1T), WSP(unsigned char, WS_W2T), (LAS float*)lds, bx, G, tid, (q0_) * cq, (q1_) * cq)
    PHASE(2, 2,
        const bool cfirst = (bx & 1) != 0; const int cq = ((NE * 192 + G - 1) / G + 3) / 4;
        if (cfirst) CONV0(0, 1);
        if (bx < 512) HG_UNIT0(bx);
        if (cfirst) CONV0(1, 2); else CONV0(0, 1);
        for (int u = bx + G; u < 512; u += G) HG_UNIT0(u);
        if (!cfirst) CONV0(1, 2);
        for (int task = bx; task < 256; task += G) pool_task(task, WSP(bf16_t, WS_SA), WSP(bf16_t, WS_SB), tid);)
    SEAM(2);
    PHASE(3, 3,
        float* SLOC = WSP(float, WS_SB + 128 * MiB); const float* DTOT = WSP(float, WS_SB + 160 * MiB);
        for (int ch = bx * 512 + tid; ch < 16 * 16384; ch += G * 512) {
            const int bh = ch >> 14, el = ch & 16383, dk = el >> 7;
            float* sp = SLOC + (size_t)bh * 32 * 16384 + el; const float* dp = DTOT + (size_t)bh * 32 * 128 + dk;
            float loc[32], dd[32];
_Pragma("unroll")
            for (int sc = 0; sc < 32; ++sc) { loc[sc] = sp[(size_t)sc * 16384]; dd[sc] = dp[sc * 128]; }
            float S = 0.f;
_Pragma("unroll")
            for (int sc = 0; sc < 32; ++sc) { sp[(size_t)sc * 16384] = S; S = dd[sc] * S + loc[sc]; }
        })
    SEAM(3);
    PHASE(4, 4,
        const bool cfirst = (bx & 1) != 0; const int cq = ((NE * 192 + G - 1) / G + 3) / 4;
        if (cfirst) CONV0(2, 3);
        if (bx < 512) HG_UNIT1(bx);
        if (cfirst) CONV0(3, 4); else CONV0(2, 3);
        for (int u = bx + G; u < 512; u += G) HG_UNIT1(u);
        if (!cfirst) CONV0(3, 4);
        )
#undef CONV0
#undef HG_UNIT0
#undef HG_UNIT1
    SEAM(4);
    layer_tail<0>(args, lds, bar, lo, hi, wave0);
    PHASE(10, 10,
        { pg8::Gemm g{WSP(bf16_t, WS_XB), WSP(bf16_t, WS_WIN1T), 1024, 0}; pg8::StaticOrder S; S.init(T, 2048, G, bx); pg8::EpiQK E{WSP(bf16_t, WS_SA), WSP(bf16_t, WS_SA + 64 * MiB), QSCALE};
          pg8::gemm_phase<pg8::EpiQK, pg8::StaticOrder, 0>(lds, g, S, E, nullptr, rowtab, tid); }
        { pg8::Gemm g{WSP(bf16_t, WS_WIN1T) + (size_t)2048 * 1024, WSP(bf16_t, WS_XB), 1024, 0}; pg8::StaticOrder S; S.init(1024, T, G, bx); pg8::EpiVF E{WSP(bf16_t, WS_SA + 128 * MiB)};
          pg8::gemm_phase<pg8::EpiVF, pg8::StaticOrder, 0>(lds, g, S, E, nullptr, rowtab, tid); })
    SEAM(10);
    PHASE(11, 11,
        const bool cfirst = (bx & 1) != 0;
        if (cfirst) conv_moe_wg(args.in[23], args.in[25], WSP(unsigned char, WS_W1T), WSP(unsigned char, WS_W2T), (LAS float*)lds, bx, G, tid, 0, (NE * 192 + G - 1) / G);
        attn_phase(WSP(bf16_t, WS_SA), WSP(bf16_t, WS_SA + 64 * MiB), WSP(bf16_t, WS_SA + 128 * MiB), WSP(bf16_t, WS_SB), gw, NGW, lane);
        if (!cfirst) conv_moe_wg(args.in[23], args.in[25], WSP(unsigned char, WS_W1T), WSP(unsigned char, WS_W2T), (LAS float*)lds, bx, G, tid, 0, (NE * 192 + G - 1) / G);)
    SEAM(11);
    layer_tail<1>(args, lds, bar, lo, hi, wave0);
}
#undef IN
#undef SEAM

extern "C" void kernel_launch(void* const* d_in, const int* in_sizes, int n_in, void* d_out, int out_size, void* d_ws, size_t ws_size, hipStream_t stream) {
    static int grid = 0;
    if (grid == 0) {
        if (n_in != 29 || in_sizes[0] != T * D || out_size != T * D || ws_size < WS_END) { fprintf(stderr, "kernel_launch: unexpected shapes (n_in %d, in0 %d, out %d, ws %zu)\n", n_in, n_in > 0 ? in_sizes[0] : -1, out_size, ws_size); grid = -1; return; }
        int dev = 0, cus = 0, per_cu = 0;
        if (hipGetDevice(&dev) != hipSuccess || hipDeviceGetAttribute(&cus, hipDeviceAttributeMultiprocessorCount, dev) != hipSuccess) { grid = -1; return; }
        if (hipFuncSetAttribute((const void*)mk_fwd, hipFuncAttributeMaxDynamicSharedMemorySize, LDS_BYTES) != hipSuccess) { fprintf(stderr, "kernel_launch: hipFuncSetAttribute failed\n"); grid = -1; return; }
        if (hipOccupancyMaxActiveBlocksPerMultiprocessor(&per_cu, (const void*)mk_fwd, NWAVES * 64, LDS_BYTES) != hipSuccess || per_cu < 1) { fprintf(stderr, "kernel_launch: occupancy query says %d\n", per_cu); }
        (void)hipGetLastError();
        grid = cus;
    }
    if (grid < 0) return;
    if (hipMemsetAsync((char*)d_ws + WS_CTL, 0, CTL_ZERO_BYTES, stream) != hipSuccess) return;
    Args a{};
    for (int i = 0; i < 29; ++i) a.in[i] = (const float*)d_in[i];
    a.out = (float*)d_out; a.ws = (unsigned char*)d_ws;
#if MK_PER_PHASE
    for (int p = 0; p < NPHASE; ++p) { a.ph_lo = p; a.ph_hi = p + 1; hipLaunchKernelGGL(mk_fwd, dim3(grid), dim3(NWAVES * 64), LDS_BYTES, stream, a); }
#else
    a.ph_lo = 0; a.ph_hi = NPHASE;
    hipLaunchKernelGGL(mk_fwd, dim3(grid), dim3(NWAVES * 64), LDS_BYTES, stream, a);
#endif
}
```

```cpp
#include <hip/hip_runtime.h>
#include <cstdio>
#include <cstdint>

#ifndef MK_PER_PHASE
#define MK_PER_PHASE 0
#endif

#define LAS __attribute__((address_space(3)))
#define GAS __attribute__((address_space(1)))
typedef unsigned short bf16_t;
typedef short bf16x8 __attribute__((ext_vector_type(8)));
typedef short s16x4 __attribute__((ext_vector_type(4)));
typedef float f32x2 __attribute__((ext_vector_type(2)));
typedef float f32x4 __attribute__((ext_vector_type(4)));
typedef float f32x16 __attribute__((ext_vector_type(16)));
typedef unsigned u32x2 __attribute__((ext_vector_type(2)));
typedef unsigned u32x4 __attribute__((ext_vector_type(4)));
typedef __bf16 bf16x2_t __attribute__((ext_vector_type(2)));
typedef int i32x4 __attribute__((ext_vector_type(4)));
typedef int i32x8 __attribute__((ext_vector_type(8)));

constexpr int BATCH = 4, SEQ = 8192, T = BATCH * SEQ, D = 1024;
constexpr int NE = 32;
constexpr float ALPHA = 1.41421356237309515f;
constexpr float LN_EPS = 1e-5f, RMS_EPS = 1e-6f;
constexpr float LOG2E = 1.4426950408889634f;
constexpr float QSCALE = 0.125f * LOG2E;
constexpr float ATT_THR = 7.5231638e-37f;

__device__ __forceinline__ unsigned pk2(float lo, float hi) { f32x2 v = {lo, hi}; bf16x2_t b = __builtin_convertvector(v, bf16x2_t); return __builtin_bit_cast(unsigned, b); }
__device__ __forceinline__ float bflo(unsigned u) { return __uint_as_float(u << 16); }
__device__ __forceinline__ float bfhi(unsigned u) { return __uint_as_float(u & 0xffff0000u); }
__device__ __forceinline__ float bf2f(bf16_t h) { return __uint_as_float(((unsigned)h) << 16); }
__device__ __forceinline__ float clamp448(float x) { return __builtin_amdgcn_fmed3f(x, -448.0f, 448.0f); }
__device__ __forceinline__ unsigned pk4_fp8_nc(float a, float b, float c, float d) { int p = 0; p = __builtin_amdgcn_cvt_pk_fp8_f32(a, b, p, false); p = __builtin_amdgcn_cvt_pk_fp8_f32(c, d, p, true); return (unsigned)p; }
__device__ __forceinline__ unsigned pk4_fp8(float a, float b, float c, float d) { int p = 0; p = __builtin_amdgcn_cvt_pk_fp8_f32(clamp448(a), clamp448(b), p, false); p = __builtin_amdgcn_cvt_pk_fp8_f32(clamp448(c), clamp448(d), p, true); return (unsigned)p; }
__device__ __forceinline__ float fexp2(float x) { return __builtin_amdgcn_exp2f(x); }
__device__ __forceinline__ float flog2(float x) { return __builtin_amdgcn_logf(x); }
__device__ __forceinline__ float frcp(float x) { return __builtin_amdgcn_rcpf(x); }

__device__ __forceinline__ int lane_id_asm() { int l; asm volatile("v_mbcnt_lo_u32_b32 %0, -1, 0\n\tv_mbcnt_hi_u32_b32 %0, -1, %0" : "=v"(l)); return l; }

#define LDPIN16(dst_, p_) asm volatile("global_load_dwordx4 %0, %1, off" : "+v"(dst_) : "v"(p_) : "memory")
#define LDPIN8(dst_, p_)  asm volatile("global_load_dwordx2 %0, %1, off" : "+v"(dst_) : "v"(p_) : "memory")

namespace pg8 {
constexpr int BM = 256, BK = 64, HALF = 128, HTB = HALF * BK * 2, STAGE_BYTES = 8 * HTB, NXCD = 8, WGM = 8;
constexpr int AUX_OFF = STAGE_BYTES + 2048 + 512 + 256;
__host__ __device__ __forceinline__ int lds_byte(int r, int c) { const int st = (r >> 4) * 2 + (c >> 5), rr = r & 15, cc = c & 31, ob = rr * 64 + cc * 2; return st * 1024 + (ob ^ (((ob >> 9) & 1) << 5)); }
__host__ __device__ __forceinline__ void stage_rc(int b, int& R, int& C) { const int st = b / 1024, sb = b % 1024, swz = sb ^ (((sb >> 9) & 1) << 5); R = (st >> 1) * 16 + swz / 64; C = (st & 1) * 32 + (swz % 64) / 2; }
__host__ __device__ __forceinline__ int perm32(int rho) { const int n = rho >> 4, i = rho & 15; return 8 * (i >> 2) + 4 * n + (i & 3); }

struct Unit { int pm, pn, e, mt, valid; };
struct Gemm { const bf16_t* A; const bf16_t* Bt; int K; int brows; };

__device__ __forceinline__ void tile_of(int L, int nM, int nN, int& pm, int& pn) {
    const int nwg = nM * nN;
    int wgid = L; { const int q = nwg / NXCD, r = nwg % NXCD, xcd = wgid % NXCD, off = wgid / NXCD; wgid = (xcd < r ? xcd * (q + 1) : r * (q + 1) + (xcd - r) * q) + off; }
    const int nig = WGM * nN, gid = wgid / nig, fm = gid * WGM, gsz = (nM - fm) < WGM ? (nM - fm) : WGM;
    pm = fm + ((wgid % nig) % gsz); pn = (wgid % nig) / gsz;
}
struct StaticOrder {
    int nM, nN, nwg, G, c;
    __device__ __forceinline__ void init(int M, int N, int G_, int c_) { nM = M / BM; nN = N / BM; nwg = nM * nN; G = G_; c = c_; }
    __device__ __forceinline__ bool next(int i, Unit& u) const {
        const long L = (long)i * G + c; if (L >= nwg) return false;
        tile_of((int)L, nM, nN, u.pm, u.pn); u.e = 0; u.mt = u.pm; u.valid = 256; return true;
    }
};
struct MoeOrder {
    const LAS int* tab; int nM, nN, nwg, G, c;
    __device__ __forceinline__ void init(const LAS int* tab_, int nN_, int G_, int c_) { tab = tab_; nM = tab_[32]; nN = nN_; nwg = nM * nN; G = G_; c = c_; }
    __device__ __forceinline__ bool next(int i, Unit& u) const {
        const long L = (long)i * G + c; if (L >= nwg) return false;
        tile_of((int)L, nM, nN, u.pm, u.pn);
        int e = 0;
#pragma unroll
        for (int j = 1; j < 32; ++j) e += (u.pm >= tab[j]) ? 1 : 0;
        u.e = e; u.mt = u.pm - tab[e]; const int rem = tab[33 + e] - u.mt * 256; u.valid = rem < 256 ? rem : 256; return true;
    }
};

__device__ __forceinline__ unsigned cvt_pk_bf16(float lo, float hi) { return pk2(lo, hi); }

struct EpiPlain {
    static constexpr bool PERM = true; static constexpr int NAUX = 0;
    bf16_t* O; int ldc; int split_cols; size_t split_stride; float scale0;
    __device__ __forceinline__ void operator()(const f32x4 (&acc)[2][2][4][2], const Unit& u, int wr, int wc, int fr, int fq, const LAS float* aux) const {
        asm volatile("" : "+v"(fr), "+v"(fq));
        const int row0 = u.pm * BM + wr * 64 + fr; int colt = u.pn * BM; bf16_t* base = O;
        float sc = 1.f; if (split_cols) { const int t = colt / split_cols; base += (size_t)t * split_stride; colt -= t * split_cols; if (t == 0) sc = scale0; }
        const int col0 = colt + wc * 32 + 8 * fq;
#pragma unroll
        for (int ai = 0; ai < 2; ++ai)
#pragma unroll
            for (int m = 0; m < 4; ++m) { bf16_t* rowp = base + (size_t)(row0 + ai * HALF + m * 16) * ldc + col0;
#pragma unroll
                for (int bj = 0; bj < 2; ++bj) { f32x4 v0 = acc[ai][bj][m][0] * sc, v1 = acc[ai][bj][m][1] * sc;
                    u32x4 w; w.x = cvt_pk_bf16(v0[0], v0[1]); w.y = cvt_pk_bf16(v0[2], v0[3]); w.z = cvt_pk_bf16(v1[0], v1[1]); w.w = cvt_pk_bf16(v1[2], v1[3]);
                    *(u32x4*)(rowp + bj * HALF) = w; } }
    }
};
struct EpiQK {
    static constexpr bool PERM = true; static constexpr int NAUX = 0;
    bf16_t* Q; bf16_t* KF; float scale;
    __device__ __forceinline__ void operator()(const f32x4 (&acc)[2][2][4][2], const Unit& u, int wr, int wc, int fr, int fq, const LAS float* aux) const {
        asm volatile("" : "+v"(fr), "+v"(fq));
        const int row0 = u.pm * BM + wr * 64 + fr; const int colt = u.pn * BM; const bool isk = colt >= 1024;
        const int col0 = (isk ? colt - 1024 : colt) + wc * 32 + 8 * fq;
        const float sc = isk ? 1.f : scale;
#pragma unroll
        for (int ai = 0; ai < 2; ++ai)
#pragma unroll
            for (int m = 0; m < 4; ++m) { const int t = row0 + ai * HALF + m * 16;
#pragma unroll
                for (int bj = 0; bj < 2; ++bj) { const f32x4 v0 = acc[ai][bj][m][0] * sc, v1 = acc[ai][bj][m][1] * sc; const int c = col0 + bj * HALF;
                    u32x4 w; w.x = cvt_pk_bf16(v0[0], v0[1]); w.y = cvt_pk_bf16(v0[2], v0[3]); w.z = cvt_pk_bf16(v1[0], v1[1]); w.w = cvt_pk_bf16(v1[2], v1[3]);
                    bf16_t* p;
                    if (isk) { const int b = t >> 13, tt = t & 8191, h = c >> 6, d8 = (c & 63) >> 3;
                        p = KF + ((((size_t)(b * 16 + h) * 256 + (tt >> 5)) * 4 + (d8 >> 1)) * 64 + (d8 & 1) * 32 + (tt & 31)) * 8; }
                    else p = Q + (size_t)t * 1024 + c;
                    *(u32x4*)p = w; } }
    }
};
struct EpiVF {
    static constexpr bool PERM = true; static constexpr int NAUX = 0;
    bf16_t* VF;
    __device__ __forceinline__ void operator()(const f32x4 (&acc)[2][2][4][2], const Unit& u, int wr, int wc, int fr, int fq, const LAS float* aux) const {
        asm volatile("" : "+v"(fr), "+v"(fq));
        const int row0 = u.pm * BM + wr * 64 + fr; const int col0 = u.pn * BM + wc * 32 + 8 * fq;
#pragma unroll
        for (int ai = 0; ai < 2; ++ai)
#pragma unroll
            for (int m = 0; m < 4; ++m) { const int dg = row0 + ai * HALF + m * 16; const int h = dg >> 6, dd = dg & 63;
#pragma unroll
                for (int bj = 0; bj < 2; ++bj) { const f32x4 v0 = acc[ai][bj][m][0], v1 = acc[ai][bj][m][1]; const int t = col0 + bj * HALF;
                    const int b = t >> 13, tt = t & 8191, t32 = tt & 31;
                    bf16_t* p = VF + (((((size_t)(b * 16 + h) * 256 + (tt >> 5)) * 2 + (dd >> 5)) * 2 + (t32 >> 4)) * 64 + (dd & 31)) * 8 + ((t32 >> 3) & 1) * 4;
                    u32x2 w0, w1; w0.x = cvt_pk_bf16(v0[0], v0[1]); w0.y = cvt_pk_bf16(v0[2], v0[3]); w1.x = cvt_pk_bf16(v1[0], v1[1]); w1.y = cvt_pk_bf16(v1[2], v1[3]);
                    *(u32x2*)p = w0; *(u32x2*)(p + 32 * 8) = w1; } }
    }
};
__device__ __forceinline__ float swiglu1(float xg, float xl) {
    const float g = fminf(xg, 7.0f), l = __builtin_amdgcn_fmed3f(xl, -7.0f, 7.0f);
    const float s = frcp(1.0f + fexp2(-1.702f * LOG2E * g));
    return g * s * (l + 1.0f);
}
struct EpiSwiglu {
    static constexpr bool PERM = true; static constexpr int NAUX = 0;
    bf16_t* O; const float* b1;
    __device__ __forceinline__ void operator()(const f32x4 (&acc)[2][2][4][2], const Unit& u, int wr, int wc, int fr, int fq, const LAS float* aux) const {
        asm volatile("" : "+v"(fr), "+v"(fq));
        const int row0 = u.pm * BM + wr * 64 + fr; const int col0 = u.pn * BM + wc * 32 + 8 * fq;
        const float* bp = b1 + (size_t)u.e * 2048 + col0;
        f32x4 bv[2][2];
#pragma unroll
        for (int bj = 0; bj < 2; ++bj)
#pragma unroll
            for (int n = 0; n < 2; ++n) bv[bj][n] = *(const f32x4*)(bp + bj * HALF + 4 * n);
#pragma unroll
        for (int ai = 0; ai < 2; ++ai)
#pragma unroll
            for (int m = 0; m < 4; ++m) { bf16_t* rowp = O + (size_t)(row0 + ai * HALF + m * 16) * 1024 + (col0 >> 1);
#pragma unroll
                for (int bj = 0; bj < 2; ++bj) { const f32x4 v0 = acc[ai][bj][m][0] + bv[bj][0], v1 = acc[ai][bj][m][1] + bv[bj][1];
                    u32x2 w; w.x = cvt_pk_bf16(swiglu1(v0[0], v0[1]), swiglu1(v0[2], v0[3])); w.y = cvt_pk_bf16(swiglu1(v1[0], v1[1]), swiglu1(v1[2], v1[3]));
                    *(u32x2*)(rowp + bj * (HALF / 2)) = w; } }
    }
};
struct EpiSwiglu8 {
    static constexpr bool PERM = true; static constexpr int NAUX = 1;
    __device__ __forceinline__ const float* aux_src(const Unit& u, int) const { return b1 + (size_t)u.e * 2048 + u.pn * BM; }
    unsigned char* O; const float* b1;
    __device__ __forceinline__ void operator()(const f32x4 (&acc)[2][2][4][2], const Unit& u, int wr, int wc, int fr, int fq, const LAS float* aux) const {
        asm volatile("" : "+v"(fr), "+v"(fq));
        const int row0 = u.pm * BM + wr * 64 + fr; const int col0 = u.pn * BM + wc * 32 + 8 * fq;
        f32x4 bv[2][2];
#pragma unroll
        for (int bj = 0; bj < 2; ++bj)
#pragma unroll
            for (int n = 0; n < 2; ++n) bv[bj][n] = *(const LAS f32x4*)(aux + wc * 32 + 8 * fq + bj * HALF + 4 * n);
#pragma unroll
        for (int ai = 0; ai < 2; ++ai)
#pragma unroll
            for (int m = 0; m < 4; ++m) {
                f32x2 g[4], l[4], t[4];
#pragma unroll
                for (int bj = 0; bj < 2; ++bj)
#pragma unroll
                    for (int n = 0; n < 2; ++n) { const f32x4 v = acc[ai][bj][m][n] + bv[bj][n]; const int o = bj * 2 + n;
                        g[o] = (f32x2){fminf(v[0], 7.0f), fminf(v[2], 7.0f)}; l[o] = (f32x2){__builtin_amdgcn_fmed3f(v[1], -7.0f, 7.0f), __builtin_amdgcn_fmed3f(v[3], -7.0f, 7.0f)} + 1.0f; }
#pragma unroll
                for (int i = 0; i < 4; ++i) { const f32x2 a = g[i] * (-1.702f * LOG2E); t[i] = (f32x2){fexp2(a.x), fexp2(a.y)}; }
                __builtin_amdgcn_sched_barrier(0);
#pragma unroll
                for (int i = 0; i < 4; ++i) { const f32x2 d = t[i] + 1.0f; t[i] = (f32x2){frcp(d.x), frcp(d.y)}; }
                __builtin_amdgcn_sched_barrier(0);
#pragma unroll
                for (int i = 0; i < 4; ++i) t[i] = (g[i] * t[i]) * l[i];
                unsigned char* rowp = O + (size_t)(row0 + ai * HALF + m * 16) * 1024 + (col0 >> 1);
                *(unsigned*)rowp = pk4_fp8_nc(t[0].x, t[0].y, t[1].x, t[1].y); *(unsigned*)(rowp + HALF / 2) = pk4_fp8_nc(t[2].x, t[2].y, t[3].x, t[3].y);
            }
    }
};
struct EpiDown {
    static constexpr bool PERM = true; static constexpr int NAUX = 0;
    bf16_t* O; const float* b2; const float* gatel;
    __device__ __forceinline__ void operator()(const f32x4 (&acc)[2][2][4][2], const Unit& u, int wr, int wc, int fr, int fq, const LAS float* aux) const {
        asm volatile("" : "+v"(fr), "+v"(fq));
        const int rl0 = wr * 64 + fr; const int col0 = u.pn * BM + wc * 32 + 8 * fq;
        const float* bp = b2 + (size_t)u.e * 1024 + col0; const float* gp = gatel + (size_t)u.e * T + u.mt * 256 + rl0;
        f32x4 bv[2][2];
#pragma unroll
        for (int bj = 0; bj < 2; ++bj)
#pragma unroll
            for (int n = 0; n < 2; ++n) bv[bj][n] = *(const f32x4*)(bp + bj * HALF + 4 * n);
#pragma unroll
        for (int ai = 0; ai < 2; ++ai)
#pragma unroll
            for (int m = 0; m < 4; ++m) { const float gt = gp[ai * HALF + m * 16]; bf16_t* rowp = O + (size_t)(u.pm * BM + rl0 + ai * HALF + m * 16) * 1024 + col0;
#pragma unroll
                for (int bj = 0; bj < 2; ++bj) { const f32x4 v0 = (acc[ai][bj][m][0] + bv[bj][0]) * gt, v1 = (acc[ai][bj][m][1] + bv[bj][1]) * gt;
                    u32x4 w; w.x = cvt_pk_bf16(v0[0], v0[1]); w.y = cvt_pk_bf16(v0[2], v0[3]); w.z = cvt_pk_bf16(v1[0], v1[1]); w.w = cvt_pk_bf16(v1[2], v1[3]);
                    *(u32x4*)(rowp + bj * HALF) = w; } }
    }
};

struct EpiDown8 {
    static constexpr bool PERM = true; static constexpr int NAUX = 2;
    __device__ __forceinline__ const float* aux_src(const Unit& u, int k) const { return k == 0 ? b2 + (size_t)u.e * 1024 + u.pn * BM : gatel + (size_t)u.e * T + u.mt * 256; }
    unsigned char* O; const float* b2; const float* gatel;
    __device__ __forceinline__ void operator()(const f32x4 (&acc)[2][2][4][2], const Unit& u, int wr, int wc, int fr, int fq, const LAS float* aux) const {
        asm volatile("" : "+v"(fr), "+v"(fq));
        const int rl0 = wr * 64 + fr; const int col0 = u.pn * BM + wc * 32 + 8 * fq;
        const LAS float* gp = aux + 256 + rl0;
        f32x4 bv[2][2];
#pragma unroll
        for (int bj = 0; bj < 2; ++bj)
#pragma unroll
            for (int n = 0; n < 2; ++n) bv[bj][n] = *(const LAS f32x4*)(aux + wc * 32 + 8 * fq + bj * HALF + 4 * n);
#pragma unroll
        for (int ai = 0; ai < 2; ++ai)
#pragma unroll
            for (int m = 0; m < 4; ++m) { const float gt = gp[ai * HALF + m * 16] * 16.0f; unsigned char* rowp = O + (size_t)(u.pm * BM + rl0 + ai * HALF + m * 16) * 1024 + col0;
#pragma unroll
                for (int bj = 0; bj < 2; ++bj) { const f32x4 v0 = (acc[ai][bj][m][0] + bv[bj][0]) * gt, v1 = (acc[ai][bj][m][1] + bv[bj][1]) * gt;
                    u32x2 w; w.x = pk4_fp8(v0[0], v0[1], v0[2], v0[3]); w.y = pk4_fp8(v1[0], v1[1], v1[2], v1[3]);
                    *(u32x2*)(rowp + bj * HALF) = w; } }
    }
};

template <class Epi, class Sched, int GATHER, int F8 = 0>
__device__ __forceinline__ void gemm_phase(LAS unsigned char* lds, const Gemm g, const Sched& S, const Epi& E, const int* tokl, LAS unsigned* rowtab, const int tid) {
    const int wid = __builtin_amdgcn_readfirstlane(tid >> 6), lane = tid & 63, wr = wid >> 2, wc = wid & 3, fr = lane & 15, fq = lane >> 4;
    const int K = g.K, nt = K / BK;
    unsigned voffA[2], voffB[2];
#pragma unroll
    for (int i = 0; i < 2; ++i) { int R, C; stage_rc(tid * 16 + i * 8192, R, C); const int Rb = Epi::PERM ? ((R & ~31) + perm32(R & 31)) : R;
        voffA[i] = (unsigned)(R * K + C) * 2u; voffB[i] = (unsigned)(Rb * K + C) * 2u; }
    const size_t kstep = (size_t)(BK * 2);
    const size_t hstep = (size_t)HALF * K * 2;
    const size_t tstep = 2 * hstep;
    const unsigned ldsw = (unsigned)wid * 1024u;
    const int aoff = lds_byte(wr * 64 + fr, fq * 8), boff = lds_byte(wc * 32 + fr, fq * 8);
    unsigned vC[2][2];
#define PG8_SA(b, h) (((b) * 2 + (h)) * HTB)
#define PG8_SB(b, h) ((4 + (b) * 2 + (h)) * HTB)
#define PG8_GLDS(gp, bufoff, i_) __builtin_amdgcn_global_load_lds((const unsigned*)(gp), (LAS unsigned*)(lds + (bufoff) + ldsw + (i_) * 8192), 16, 0, 0)
#define PG8_STAGE_B(bufoff, gbase) do { _Pragma("unroll") for (int _i = 0; _i < 2; ++_i) PG8_GLDS((const char*)(gbase) + voffB[_i], bufoff, _i); } while (0)
#define PG8_STAGE_A(bufoff, gbase, h, nx) do { _Pragma("unroll") for (int _i = 0; _i < 2; ++_i) { \
        if constexpr (GATHER) { PG8_GLDS((const char*)(gbase) + vC[h][_i], bufoff, _i); } \
        else PG8_GLDS((const char*)(gbase) + (h) * hstep + voffA[_i], bufoff, _i); } } while (0)
#define PG8_LDA(dst, b, h) do { _Pragma("unroll") for (int m = 0; m < 4; ++m) _Pragma("unroll") for (int k = 0; k < 2; ++k) dst[m][k] = *(const LAS bf16x8*)(lds + PG8_SA(b, h) + aoff + m * 2048 + k * 1024); } while (0)
#define PG8_LDB(dst, b, h) do { _Pragma("unroll") for (int n = 0; n < 2; ++n) _Pragma("unroll") for (int k = 0; k < 2; ++k) dst[n][k] = *(const LAS bf16x8*)(lds + PG8_SB(b, h) + boff + n * 2048 + k * 1024); } while (0)
#define PG8_MMA(ai, bj, At, Bt) do { __builtin_amdgcn_s_setprio(1); _Pragma("unroll") for (int m = 0; m < 4; ++m) _Pragma("unroll") for (int n = 0; n < 2; ++n) { \
        if constexpr (F8 != 0) {   \
            const i32x4 _b0 = __builtin_bit_cast(i32x4, Bt[n][0]), _b1 = __builtin_bit_cast(i32x4, Bt[n][1]), _a0 = __builtin_bit_cast(i32x4, At[m][0]), _a1 = __builtin_bit_cast(i32x4, At[m][1]); \
            const i32x8 _bb = __builtin_shufflevector(_b0, _b1, 0, 1, 2, 3, 4, 5, 6, 7), _aa = __builtin_shufflevector(_a0, _a1, 0, 1, 2, 3, 4, 5, 6, 7); \
            acc[ai][bj][m][n] = __builtin_amdgcn_mfma_scale_f32_16x16x128_f8f6f4(_bb, _aa, acc[ai][bj][m][n], 0, 0, 0, (int)(F8 * 0x01010101u), 0, 0x7f7f7f7f); \
        } else { _Pragma("unroll") for (int k = 0; k < 2; ++k) acc[ai][bj][m][n] = __builtin_amdgcn_mfma_f32_16x16x32_bf16(Bt[n][k], At[m][k], acc[ai][bj][m][n], 0, 0, 0); } } \
        __builtin_amdgcn_s_setprio(0); } while (0)
#define PG8_WAIT_V(n) asm volatile("s_waitcnt vmcnt(" #n ")" ::: "memory")
#define PG8_WAIT_L(n) asm volatile("s_waitcnt lgkmcnt(" #n ")" ::: "memory")
#define PG8_BAR __builtin_amdgcn_s_barrier()
#define PG8_SCHED __builtin_amdgcn_sched_barrier(0)
#define PG8_ROWDMA(u_, slot_) do { if (GATHER == 1 && wid < 4) __builtin_amdgcn_global_load_lds((const unsigned*)(tokl + (size_t)(u_).e * T + (u_).mt * 256 + wid * 64 + lane), (LAS unsigned*)(rowtab + (slot_) * 256 + wid * 64), 4, 0, 0); } while (0)
#define PG8_ROWOFF(dst, u_, slot_) do { _Pragma("unroll") for (int _i = 0; _i < 2; ++_i) { int _R, _C; stage_rc(tid * 16 + _i * 8192, _R, _C); _Pragma("unroll") for (int _h = 0; _h < 2; ++_h) { const int _r = _h * HALF + _R; \
        unsigned _t; if constexpr (GATHER == 1) { _t = rowtab[(slot_) * 256 + _r]; _t = (_r < (u_).valid) ? _t : 0u; } else _t = (unsigned)((u_).pm * 256 + _r); \
        dst[_h][_i] = _t * (unsigned)(K * 2) + (unsigned)_C * 2u; } } } while (0)
    Unit cur, nxt; int ui = 0;
    if (!S.next(0, cur)) return;
    f32x4 acc[2][2][4][2];
#pragma unroll
    for (int a = 0; a < 2; ++a)
#pragma unroll
        for (int b = 0; b < 2; ++b)
#pragma unroll
            for (int m = 0; m < 4; ++m)
#pragma unroll
                for (int n = 0; n < 2; ++n) acc[a][b][m][n] = (f32x4){0.f, 0.f, 0.f, 0.f};
    bf16x8 At[4][2], B0[2][2], B1[2][2];
    const char* cA = GATHER ? (const char*)g.A : (const char*)g.A + (size_t)cur.pm * tstep;
    const char* cB = (const char*)g.Bt + ((size_t)cur.e * g.brows + (size_t)cur.pn * BM) * K * 2;
    if constexpr (GATHER != 0) {
        PG8_ROWDMA(cur, 0); PG8_WAIT_V(0); __syncthreads();
        PG8_ROWOFF(vC, cur, 0);
        PG8_WAIT_L(0);
    }
    PG8_STAGE_B(PG8_SB(0, 0), cB); PG8_STAGE_B(PG8_SB(0, 1), cB + hstep); PG8_STAGE_A(PG8_SA(0, 0), cA, 0, false); PG8_STAGE_A(PG8_SA(0, 1), cA, 1, false);
    if (wr == 1) PG8_BAR;
    PG8_WAIT_V(2); PG8_BAR;
    PG8_STAGE_B(PG8_SB(1, 0), cB + kstep); PG8_STAGE_A(PG8_SA(1, 0), cA + kstep, 0, false); PG8_STAGE_B(PG8_SB(1, 1), cB + hstep + kstep);
    PG8_WAIT_V(6); PG8_BAR;
    for (;;) {
        if constexpr (Epi::NAUX > 0) { if (wid < Epi::NAUX) __builtin_amdgcn_global_load_lds((const unsigned*)(E.aux_src(cur, wid) + lane * 4), (LAS unsigned*)(lds + AUX_OFF + (ui & 1) * 2048 + wid * 1024), 16, 0, 0); }
        const bool has_next = S.next(ui + 1, nxt);
        if constexpr (GATHER) { if (has_next) PG8_ROWDMA(nxt, (ui + 1) & 1); }
        const char* nA = has_next ? (GATHER ? (const char*)g.A : (const char*)g.A + (size_t)nxt.pm * tstep) : cA;
        const char* nB = has_next ? (const char*)g.Bt + ((size_t)nxt.e * g.brows + (size_t)nxt.pn * BM) * K * 2 : cB;
#pragma unroll 1
        for (int t = 0; t < nt; t += 2) {
            const bool last = (t == nt - 2);
            const char* a1 = cA + (size_t)(t + 1) * kstep;
            const char* a2 = last ? nA : cA + (size_t)(t + 2) * kstep; const char* b2 = last ? nB : cB + (size_t)(t + 2) * kstep;
            const char* a3 = a2 + kstep; const char* b3 = b2 + kstep;
            PG8_LDB(B0, 0, 0); PG8_LDB(B1, 0, 1); PG8_SCHED; PG8_LDA(At, 0, 0); PG8_STAGE_A(PG8_SA(1, 1), a1, 1, false);
            if constexpr (GATHER) { if (last && has_next) { PG8_ROWOFF(vC, nxt, (ui + 1) & 1); } }
            PG8_WAIT_V(8); PG8_WAIT_L(0); PG8_BAR; PG8_MMA(0, 0, At, B0); PG8_MMA(0, 1, At, B1); PG8_BAR; PG8_SCHED;
            PG8_LDA(At, 0, 1); PG8_STAGE_B(PG8_SB(0, 0), b2); PG8_STAGE_B(PG8_SB(0, 1), b2 + hstep); PG8_STAGE_A(PG8_SA(0, 0), a2, 0, last);
            PG8_WAIT_V(8); PG8_WAIT_L(0); PG8_BAR; PG8_MMA(1, 0, At, B0); PG8_MMA(1, 1, At, B1); PG8_BAR; PG8_SCHED;
            PG8_LDB(B0, 1, 0); PG8_LDB(B1, 1, 1); PG8_SCHED; PG8_LDA(At, 1, 0); PG8_STAGE_A(PG8_SA(0, 1), a2, 1, last);
            PG8_WAIT_V(8); PG8_WAIT_L(0); PG8_BAR; PG8_MMA(0, 0, At, B0); PG8_MMA(0, 1, At, B1); PG8_BAR; PG8_SCHED;
            PG8_LDA(At, 1, 1); PG8_STAGE_B(PG8_SB(1, 0), b3); PG8_STAGE_B(PG8_SB(1, 1), b3 + hstep); PG8_STAGE_A(PG8_SA(1, 0), a3, 0, last);
            PG8_WAIT_V(8); PG8_WAIT_L(0); PG8_BAR; PG8_MMA(1, 0, At, B0); PG8_MMA(1, 1, At, B1); PG8_BAR; PG8_SCHED;
        }
        if (wr == 0) PG8_BAR;
        E(acc, cur, wr, wc, fr, fq, (const LAS float*)(lds + AUX_OFF + (ui & 1) * 2048));
#if defined(PROBE_EPI2)
        E(acc, cur, wr, wc, fr, fq, (const LAS float*)(lds + AUX_OFF + (ui & 1) * 2048));
#endif
        if (!has_next) break;
#pragma unroll
        for (int a = 0; a < 2; ++a)
#pragma unroll
            for (int b = 0; b < 2; ++b)
#pragma unroll
                for (int m = 0; m < 4; ++m)
#pragma unroll
                    for (int n = 0; n < 2; ++n) acc[a][b][m][n] = (f32x4){0.f, 0.f, 0.f, 0.f};
        cur = nxt; cA = nA; cB = nB; ++ui;
        if (wr == 1) PG8_BAR;
    }
    PG8_WAIT_V(0);
    PG8_BAR;
#undef PG8_SA
#undef PG8_SB
#undef PG8_GLDS
#undef PG8_STAGE_A
#undef PG8_STAGE_B
#undef PG8_LDA
#undef PG8_LDB
#undef PG8_MMA
#undef PG8_WAIT_V
#undef PG8_WAIT_L
#undef PG8_BAR
#undef PG8_SCHED
#undef PG8_ROWDMA
#undef PG8_ROWOFF
}
}

constexpr size_t MiB = 1u << 20;
constexpr size_t WS_CTL = 0, CTL_ZERO_BYTES = 128 * 1024;
constexpr size_t WS_TOKL = 1 * MiB, WS_GATEL = 5 * MiB, WS_TINFO = 9 * MiB;
constexpr size_t WS_WIN0T = 10 * MiB, WS_WO0T = 15 * MiB, WS_WIN1T = 17 * MiB, WS_WO1T = 23 * MiB;
constexpr size_t WS_W1T = 26 * MiB, WS_W2T = 154 * MiB, WS_XB = 218 * MiB;
constexpr size_t WS_SA = 282 * MiB, WS_SB = 554 * MiB, WS_XB8 = 826 * MiB, WS_END = 858 * MiB;
constexpr int CW_BAR = 4096, CW_CNT = 16384;

constexpr int RING_BYTES = 131072;
constexpr int ROWTAB_OFF = RING_BYTES;
constexpr int MOETAB_OFF = ROWTAB_OFF + 2048;
constexpr int MISC_OFF = MOETAB_OFF + 512;
constexpr int LDS_BYTES = 147456;
static_assert(pg8::AUX_OFF == MISC_OFF + 256 && pg8::AUX_OFF + 4096 <= LDS_BYTES, "LDS map");

#define XB_TMO      128
#define XB_XCNT(j)  (256  + 64 * (j))
#define XB_XSUB(j)  (1280 + 64 * (j))
#define XB_XGEN(j)  (2304 + 64 * (j))
#define XB_TOP      3328
#define XB_TOPGEN   3392
#define XCD_BAR_WORDS 3456
#define XB_SPIN_CAP (1u << 20)
__device__ __forceinline__ unsigned xb_ld(unsigned* p)              { return __hip_atomic_load(p, __ATOMIC_RELAXED, __HIP_MEMORY_SCOPE_AGENT); }
__device__ __forceinline__ unsigned xb_add(unsigned* p, unsigned v) { return __hip_atomic_fetch_add(p, v, __ATOMIC_RELAXED, __HIP_MEMORY_SCOPE_AGENT); }
__device__ __forceinline__ unsigned xb_xcc_id() { return (unsigned)__builtin_amdgcn_s_getreg((3 << 11) | 20) & 0xFu; }
#define XB_SPIN(cond, bar) do { unsigned _sp = 0; while (cond) { __builtin_amdgcn_s_sleep(1); \
    if ((++_sp & 255u) == 0u) { if (xb_ld(&(bar)[XB_TMO])) break; if (_sp > XB_SPIN_CAP) { atomicAdd(&(bar)[XB_TMO], 1u); break; } } } } while (0)
struct XcdBarrier { unsigned* bar; unsigned x; volatile LAS unsigned* st; int wave; };
__device__ __forceinline__ XcdBarrier xcd_barrier_post(unsigned* bar, volatile LAS unsigned* st) {
    XcdBarrier b; b.bar = bar; b.x = xb_xcc_id(); b.st = st; b.wave = __builtin_amdgcn_readfirstlane(threadIdx.x >> 6);
    if (threadIdx.x == 0) (void)xb_add(&bar[XB_XCNT(b.x)], 1u);
    return b;
}
__device__ __forceinline__ void xcd_barrier_complete(unsigned* bar, unsigned x, unsigned& nloc, unsigned& nx) {
    const unsigned G = gridDim.x * gridDim.y * gridDim.z;
    unsigned sum, cnt, mine, sp = 0u;
    for (;;) {
        sum = 0u; cnt = 0u; mine = 0u;
#pragma unroll
        for (unsigned j = 0; j < 16; ++j) { const unsigned c = xb_ld(&bar[XB_XCNT(j)]); sum += c; cnt += (c > 0u) ? 1u : 0u; mine = (j == x) ? c : mine; }
        if (sum == G) break;
        __builtin_amdgcn_s_sleep(1);
        if ((++sp & 255u) == 0u) { if (xb_ld(&bar[XB_TMO])) break; if (sp > XB_SPIN_CAP) { atomicAdd(&bar[XB_TMO], 1u); break; } }
    }
    nloc = mine > 0u ? mine : 1u; nx = cnt > 0u ? cnt : 1u;
}
__device__ __forceinline__ void xcd_barrier(const XcdBarrier& b) {
    asm volatile("s_waitcnt vmcnt(0)" ::: "memory");
    __syncthreads();
    if (b.wave == 0 && lane_id_asm() == 0) {
        unsigned* bar = b.bar;
        __builtin_amdgcn_s_waitcnt(0);
        unsigned nloc = b.st[0], nx = b.st[1];
        if (nloc == 0u) { xcd_barrier_complete(bar, b.x, nloc, nx); b.st[0] = nloc; b.st[1] = nx; }
        const unsigned old = xb_add(&bar[XB_XSUB(b.x)], 1u);
        const unsigned gen = old / nloc;
        if (old + 1u == (gen + 1u) * nloc) {
            __builtin_amdgcn_fence(__ATOMIC_RELEASE, "agent");
            asm volatile("s_waitcnt vmcnt(0)" ::: "memory");
            const unsigned og = xb_add(&bar[XB_TOP], 1u);
            const unsigned tg = og / nx;
            if (og + 1u == (tg + 1u) * nx) xb_add(&bar[XB_TOPGEN], 1u);
            else XB_SPIN(xb_ld(&bar[XB_TOPGEN]) == tg, bar);
            __builtin_amdgcn_fence(__ATOMIC_ACQUIRE, "agent");
            xb_add(&bar[XB_XGEN(b.x)], 1u);
            asm volatile("s_waitcnt vmcnt(0)" ::: "memory");
        } else {
            XB_SPIN(xb_ld(&bar[XB_XGEN(b.x)]) == gen, bar);
            __builtin_amdgcn_fence(__ATOMIC_ACQUIRE, "agent");
            asm volatile("s_waitcnt vmcnt(0)" ::: "memory");
        }
    }
    __syncthreads();
}

#define LDS_WAIT() asm volatile("s_waitcnt lgkmcnt(0)" ::: "memory")
#define LDS_BARRIER() do { asm volatile("s_waitcnt lgkmcnt(0)" ::: "memory"); __builtin_amdgcn_s_barrier(); asm volatile("" ::: "memory"); } while (0)
__device__ __forceinline__ float wave_sum(float v) {
#pragma unroll
    for (int o = 1; o < 64; o <<= 1) v += __shfl_xor(v, o);
    return v;
}
__device__ __forceinline__ void transpose_item(const float* W, int ldw, bf16_t* WT, int ldt, int k0, int n0, int dst_row0, LAS float* scr, int lane, int rstride = 1) {
#pragma unroll 8
    for (int i = 0; i < 32; ++i) { const int kk = 2 * i + (lane >> 5); scr[kk * 33 + (lane & 31)] = W[(size_t)(k0 + kk) * ldw + n0 + (lane & 31)]; }
    LDS_WAIT(); asm volatile("" ::: "memory");
    const int c = lane & 7;
#pragma unroll
    for (int j = 0; j < 4; ++j) { const int n = (lane >> 3) + 8 * j; const LAS float* s = scr + (8 * c) * 33 + n;
        u32x4 o; o.x = pk2(s[0 * 33], s[1 * 33]); o.y = pk2(s[2 * 33], s[3 * 33]); o.z = pk2(s[4 * 33], s[5 * 33]); o.w = pk2(s[6 * 33], s[7 * 33]);
        *(u32x4*)(WT + (size_t)(dst_row0 + n * rstride) * ldt + k0 + 8 * c) = o; }
    LDS_WAIT(); asm volatile("" ::: "memory");
}
constexpr int W1_SH = 6, W2_SH = 7;
__device__ __forceinline__ void conv_moe_wg(const float* w1, const float* w2, unsigned char* W1T, unsigned char* W2T, LAS float* buf, int bx, int G, int tid, int j0, int j1) {
    constexpr int I1 = 8 * 16, I2 = 8 * 8, NIT = NE * (I1 + I2);
    const int lrow = tid >> 5, lcol = (tid & 31) * 4;
    f32x4 ra[8], rb[8];
#define CM_SRC(it_, src_, ldw_) const float* src_; int ldw_; { if ((it_) < NE * I1) { const int e_ = (it_) >> 7, q_ = (it_) & 127, kb_ = q_ >> 4, nb_ = q_ & 15; ldw_ = 2048; src_ = w1 + (size_t)e_ * 1024 * 2048 + (size_t)(128 * kb_) * 2048 + 128 * nb_; } \
        else { const int j_ = (it_) - NE * I1, e_ = j_ >> 6, q_ = j_ & 63, kb_ = q_ >> 3, nb_ = q_ & 7; ldw_ = 1024; src_ = w2 + (size_t)e_ * 1024 * 1024 + (size_t)(128 * kb_) * 1024 + 128 * nb_; } }
#define CM_LOAD(R_, it_) do { CM_SRC(it_, sp_, lw_); _Pragma("unroll") for (int i = 0; i < 8; ++i) R_[i] = __builtin_nontemporal_load((const f32x4*)(sp_ + (size_t)(lrow + 16 * i) * lw_ + lcol)); } while (0)
#define CM_ITEM(R_, it_) do { \
        _Pragma("unroll") for (int i = 0; i < 8; ++i) *(LAS f32x4*)(buf + (lrow + 16 * i) * 132 + (lcol ^ (8 * (i & 3)))) = R_[i];     \
        __syncthreads(); \
        if ((it_) + 2 * G < itend) CM_LOAD(R_, (it_) + 2 * G); \
        unsigned char* dst; float sc; \
        if ((it_) < NE * I1) { const int e = (it_) >> 7, q = (it_) & 127, kb = q >> 4, nb = q & 15; dst = W1T + (size_t)e * 2048 * 1024 + (size_t)(128 * nb) * 1024 + 128 * kb; sc = (float)(1 << W1_SH); } \
        else { const int j = (it_) - NE * I1, e = j >> 6, q = j & 63, kb = q >> 3, nb = q & 7; dst = W2T + (size_t)e * 1024 * 1024 + (size_t)(128 * nb) * 1024 + 128 * kb; sc = (float)(1 << W2_SH); } \
        const int c = tid & 7; \
        _Pragma("unroll") for (int p = 0; p < 2; ++p) { const int nn = (tid >> 3) + 64 * p; const LAS float* sp = buf + (16 * c) * 132 + (nn ^ (8 * (c & 3))); \
            u32x4 o; \
            o.x = pk4_fp8(sp[0 * 132] * sc, sp[1 * 132] * sc, sp[2 * 132] * sc, sp[3 * 132] * sc); o.y = pk4_fp8(sp[4 * 132] * sc, sp[5 * 132] * sc, sp[6 * 132] * sc, sp[7 * 132] * sc); \
            o.z = pk4_fp8(sp[8 * 132] * sc, sp[9 * 132] * sc, sp[10 * 132] * sc, sp[11 * 132] * sc); o.w = pk4_fp8(sp[12 * 132] * sc, sp[13 * 132] * sc, sp[14 * 132] * sc, sp[15 * 132] * sc); \
            *(u32x4*)(dst + (size_t)nn * 1024 + 16 * c) = o; } \
        __syncthreads(); } while (0)
    int it = bx + j0 * G; const int itend = (bx + j1 * G) < NIT ? (bx + j1 * G) : NIT;
    __syncthreads();
    if (it < itend) CM_LOAD(ra, it);
    if (it + G < itend) CM_LOAD(rb, it + G);
    for (; it < itend; it += 2 * G) {
        CM_ITEM(ra, it);
        if (it + G < itend) CM_ITEM(rb, it + G);
    }
#undef CM_ITEM
#undef CM_SRC
#undef CM_LOAD
}
__device__ __forceinline__ void ln_row(f32x4 (&v)[4], const float* w, const float* b, int lane) {
    float s = 0.f;
#pragma unroll
    for (int j = 0; j < 4; ++j) s += (v[j].x + v[j].y) + (v[j].z + v[j].w);
    const float mean = wave_sum(s) * (1.f / D); float s2 = 0.f;
#pragma unroll
    for (int j = 0; j < 4; ++j) { v[j] = v[j] - mean; s2 += (v[j].x * v[j].x + v[j].y * v[j].y) + (v[j].z * v[j].z + v[j].w * v[j].w); }
    const float rstd = 1.f / sqrtf(wave_sum(s2) * (1.f / D) + LN_EPS);
#pragma unroll
    for (int j = 0; j < 4; ++j) { const f32x4 ww = *(const f32x4*)(w + 4 * lane + 256 * j), bb = *(const f32x4*)(b + 4 * lane + 256 * j); v[j] = v[j] * rstd * ww + bb; }
}
__device__ __forceinline__ void moe_table(const unsigned* cnt, LAS int* tab, int tid) {
    if (tid < 32) tab[33 + tid] = (int)__hip_atomic_load(cnt + tid, __ATOMIC_RELAXED, __HIP_MEMORY_SCOPE_AGENT);
    __syncthreads();
    if (tid == 0) { int p = 0; for (int e = 0; e < 32; ++e) { tab[e] = p; p += (tab[33 + e] + 255) >> 8; } tab[32] = p; }
    __syncthreads();
}

constexpr int HG_KUT = 0, HG_DD = 18432, HG_QH = 20480, HG_KD = 37888, HG_OB = 55296, HG_RED = 89088;
template <int MODE>
__device__ __forceinline__ void hgrn_unit(LAS unsigned char* lds, int unit, const bf16_t* PROJ, const bf16_t* IT, float* SLOC, float* DTOT, const float* lbl, const float* anw, bf16_t* AO, int tid, int wave, int lane) {
    const int bh = unit >> 5, sc = unit & 31, b = bh >> 2, h = bh & 3;
    const int t0 = sc * 256;
    const int si = tid >> 7, dk = tid & 127;
    const int g = lane >> 4, c16 = lane & 15;
    float lb;
    { const float l0 = lbl[h * 128 + dk], l1 = lbl[512 + h * 128 + dk], l2 = lbl[1024 + h * 128 + dk]; const float m = fmaxf(l0, fmaxf(l1, l2));
      const float e0 = __expf(l0 - m), e1 = __expf(l1 - m), e2 = __expf(l2 - m); lb = e0 / (e0 + e1 + e2); }
    const float oml = 1.0f - lb;
    f32x4 S[8];
#pragma unroll
    for (int tau = 0; tau < 8; ++tau) {
        if (MODE == 1) {
#pragma unroll
            for (int r = 0; r < 4; ++r) S[tau][r] = SLOC[(size_t)unit * 16384 + (16 * tau + 4 * g + r) * 128 + 16 * wave + c16];
        } else S[tau] = (f32x4){0.f, 0.f, 0.f, 0.f};
    }
    float lsum = 1.f;
    unsigned qz[16]; u32x2 vfn[4];
    const unsigned rlo = (unsigned)(16 * si * 2048 + 2 * dk);
    { const bf16_t* sb = PROJ + ((size_t)b * SEQ + t0) * 2048 + h * 256;
#pragma unroll
      for (int j = 0; j < 16; ++j) qz[j] = *(const unsigned*)(sb + (size_t)j * 2048 + rlo);
      const bf16_t* vp = IT + (size_t)(h * 128 + 16 * wave + c16) * T + (size_t)b * SEQ + t0 + 4 * g;
#pragma unroll
      for (int i = 0; i < 4; ++i) vfn[i] = *(const u32x2*)(vp + 16 * i); }
#pragma unroll 1
    for (int c4 = 0; c4 < 4; ++c4) {
        const int tc = t0 + 64 * c4;
        u32x2 vf[4];
#pragma unroll
        for (int i = 0; i < 4; ++i) vf[i] = vfn[i];
        {
            float cp = 1.f, kdf[16];
#pragma unroll
            for (int j = 0; j < 16; ++j) {
                const float z = bfhi(qz[j]);
                const float s = frcp(1.0f + fexp2(-LOG2E * z));
                const float f = lb + oml * s, kk = oml * (1.0f - s);
                cp *= f; kdf[j] = kk * frcp(cp);
                if (MODE == 1) {
                    const float q = bflo(qz[j]);
                    const unsigned qh = pk2(q * cp, 0.f), kd = pk2(kdf[j], 0.f);
                    *(LAS bf16_t*)(lds + HG_QH + (16 * si + j) * 272 + dk * 2) = (bf16_t)(qh & 0xffffu);
                    *(LAS bf16_t*)(lds + HG_KD + (16 * si + j) * 272 + dk * 2) = (bf16_t)(kd & 0xffffu);
                }
            }
            if (c4 < 3) {
                const bf16_t* sb = PROJ + ((size_t)b * SEQ + tc + 64) * 2048 + h * 256;
#pragma unroll
                for (int j = 0; j < 16; ++j) qz[j] = *(const unsigned*)(sb + (size_t)j * 2048 + rlo);
                const bf16_t* vp = IT + (size_t)(h * 128 + 16 * wave + c16) * T + (size_t)b * SEQ + tc + 64 + 4 * g;
#pragma unroll
                for (int i = 0; i < 4; ++i) vfn[i] = *(const u32x2*)(vp + 16 * i);
            }
            const float dl = cp; lsum *= dl;
            u32x4 w0, w1;
            w0.x = pk2(kdf[0] * dl, kdf[1] * dl); w0.y = pk2(kdf[2] * dl, kdf[3] * dl); w0.z = pk2(kdf[4] * dl, kdf[5] * dl); w0.w = pk2(kdf[6] * dl, kdf[7] * dl);
            w1.x = pk2(kdf[8] * dl, kdf[9] * dl); w1.y = pk2(kdf[10] * dl, kdf[11] * dl); w1.z = pk2(kdf[12] * dl, kdf[13] * dl); w1.w = pk2(kdf[14] * dl, kdf[15] * dl);
            *(LAS u32x4*)(lds + HG_KUT + dk * 144 + si * 32) = w0;
            *(LAS u32x4*)(lds + HG_KUT + dk * 144 + si * 32 + 16) = w1;
            *(LAS float*)(lds + HG_DD + (si * 128 + dk) * 4) = dl;
        }
        LDS_BARRIER();
#pragma unroll
        for (int i = 0; i < 4; ++i) {
            bf16x8 vb; { const s16x4 t4 = __builtin_bit_cast(s16x4, vf[i]); vb = (bf16x8){t4[0], t4[1], t4[2], t4[3], 0, 0, 0, 0}; }
            if (MODE == 1) {
                f32x4 X = (f32x4){0.f, 0.f, 0.f, 0.f};
#pragma unroll
                for (int m = 0; m < 4; ++m) {
                    const bf16x8 a = *(const LAS bf16x8*)(lds + HG_KD + (16 * i + c16) * 272 + (32 * m + 8 * g) * 2);
                    const bf16x8 bq = *(const LAS bf16x8*)(lds + HG_QH + (16 * i + c16) * 272 + (32 * m + 8 * g) * 2);
                    X = __builtin_amdgcn_mfma_f32_16x16x32_bf16(a, bq, X, 0, 0, 0);
                }
#pragma unroll
                for (int r = 0; r < 4; ++r) X[r] = (4 * g + r <= c16) ? X[r] : 0.f;
                bf16x8 xa; { u32x2 p; p.x = pk2(X[0], X[1]); p.y = pk2(X[2], X[3]); const s16x4 t4 = __builtin_bit_cast(s16x4, p); xa = (bf16x8){t4[0], t4[1], t4[2], t4[3], 0, 0, 0, 0}; }
                f32x4 O = (f32x4){0.f, 0.f, 0.f, 0.f};
                O = __builtin_amdgcn_mfma_f32_16x16x32_bf16(xa, vb, O, 0, 0, 0);
#pragma unroll
                for (int m = 0; m < 4; ++m) {
                    u32x4 bs; bs.x = pk2(S[2 * m][0], S[2 * m][1]); bs.y = pk2(S[2 * m][2], S[2 * m][3]); bs.z = pk2(S[2 * m + 1][0], S[2 * m + 1][1]); bs.w = pk2(S[2 * m + 1][2], S[2 * m + 1][3]);
                    const u32x2 q0 = *(const LAS u32x2*)(lds + HG_QH + (16 * i + c16) * 272 + (32 * m + 4 * g) * 2);
                    const u32x2 q1 = *(const LAS u32x2*)(lds + HG_QH + (16 * i + c16) * 272 + (32 * m + 16 + 4 * g) * 2);
                    u32x4 aq; aq.x = q0.x; aq.y = q0.y; aq.z = q1.x; aq.w = q1.y;
                    O = __builtin_amdgcn_mfma_f32_16x16x32_bf16(__builtin_bit_cast(bf16x8, aq), __builtin_bit_cast(bf16x8, bs), O, 0, 0, 0);
                }
#pragma unroll
                for (int r = 0; r < 4; ++r) *(LAS float*)(lds + HG_OB + ((16 * i + 4 * g + r) * 132 + 16 * wave + c16) * 4) = O[r];
            }
#pragma unroll
            for (int tau = 0; tau < 8; ++tau) {
                const f32x4 dd = *(const LAS f32x4*)(lds + HG_DD + (i * 128 + 16 * tau + 4 * g) * 4);
                S[tau] = S[tau] * dd;
                const u32x2 k2 = *(const LAS u32x2*)(lds + HG_KUT + (16 * tau + c16) * 144 + (16 * i + 4 * g) * 2);
                u32x4 ak; ak.x = k2.x; ak.y = k2.y; ak.z = 0u; ak.w = 0u;
                S[tau] = __builtin_amdgcn_mfma_f32_16x16x32_bf16(__builtin_bit_cast(bf16x8, ak), vb, S[tau], 0, 0, 0);
            }
        }
        LDS_BARRIER();
        if (MODE == 1) {
            const int tl = tid >> 3, part = tid & 7;
            float o[16]; float ssq = 0.f;
#pragma unroll
            for (int q4 = 0; q4 < 4; ++q4) { const f32x4 v = *(const LAS f32x4*)(lds + HG_OB + (tl * 132 + 16 * part + 4 * q4) * 4);
                o[4 * q4] = v.x; o[4 * q4 + 1] = v.y; o[4 * q4 + 2] = v.z; o[4 * q4 + 3] = v.w; ssq += (v.x * v.x + v.y * v.y) + (v.z * v.z + v.w * v.w); }
            ssq += __shfl_xor(ssq, 1); ssq += __shfl_xor(ssq, 2); ssq += __shfl_xor(ssq, 4);
            const float rr = 1.0f / sqrtf(ssq * (1.0f / 128.0f) + RMS_EPS);
            const size_t row = (size_t)b * SEQ + tc + tl;
            const u32x4 g0 = *(const u32x4*)(PROJ + row * 2048 + 1024 + h * 128 + 16 * part), g1 = *(const u32x4*)(PROJ + row * 2048 + 1024 + h * 128 + 16 * part + 8);
            float gv[16];
            gv[0] = bflo(g0.x); gv[1] = bfhi(g0.x); gv[2] = bflo(g0.y); gv[3] = bfhi(g0.y); gv[4] = bflo(g0.z); gv[5] = bfhi(g0.z); gv[6] = bflo(g0.w); gv[7] = bfhi(g0.w);
            gv[8] = bflo(g1.x); gv[9] = bfhi(g1.x); gv[10] = bflo(g1.y); gv[11] = bfhi(g1.y); gv[12] = bflo(g1.z); gv[13] = bfhi(g1.z); gv[14] = bflo(g1.w); gv[15] = bfhi(g1.w);
            float r16[16];
#pragma unroll
            for (int j = 0; j < 16; ++j) { const float gg = gv[j]; const float sg = gg * frcp(1.0f + fexp2(-LOG2E * gg)); r16[j] = o[j] * rr * anw[16 * part + j] * sg; }
            u32x4 o0, o1;
            o0.x = pk2(r16[0], r16[1]); o0.y = pk2(r16[2], r16[3]); o0.z = pk2(r16[4], r16[5]); o0.w = pk2(r16[6], r16[7]);
            o1.x = pk2(r16[8], r16[9]); o1.y = pk2(r16[10], r16[11]); o1.z = pk2(r16[12], r16[13]); o1.w = pk2(r16[14], r16[15]);
            *(u32x4*)(AO + row * 1024 + h * 128 + 16 * part) = o0; *(u32x4*)(AO + row * 1024 + h * 128 + 16 * part + 8) = o1;
        }
    }
    if (MODE == 0) {
#pragma unroll
        for (int tau = 0; tau < 8; ++tau)
#pragma unroll
            for (int r = 0; r < 4; ++r) SLOC[(size_t)unit * 16384 + (16 * tau + 4 * g + r) * 128 + 16 * wave + c16] = S[tau][r];
        *(LAS float*)(lds + HG_RED + (si * 128 + dk) * 4) = lsum;
        __syncthreads();
        if (tid < 128) { const float tot = (*(LAS float*)(lds + HG_RED + tid * 4) * *(LAS float*)(lds + HG_RED + (128 + tid) * 4)) * (*(LAS float*)(lds + HG_RED + (256 + tid) * 4) * *(LAS float*)(lds + HG_RED + (384 + tid) * 4));
            DTOT[(size_t)unit * 128 + tid] = tot; }
    }
    __syncthreads();
}

__device__ __forceinline__ void pool_task(int task, const bf16_t* PROJ, bf16_t* AO, int tid) {
    const int b = task >> 6, blk = task & 63;
    const int co = tid & 63, ts = tid >> 6;
    const int W = 2 << (co >> 4);
    const int tb = blk * 128 + 16 * ts;
    const bf16_t* xp = PROJ + (size_t)b * SEQ * 2048 + 1536 + 8 * co;
    float s[8];
#pragma unroll
    for (int c = 0; c < 8; ++c) s[c] = 0.f;
    for (int r = 1; r < W; ++r) { const int t = tb - r; if (t >= 0) { const u32x4 v = *(const u32x4*)(xp + (size_t)t * 2048);
        s[0] += bflo(v.x); s[1] += bfhi(v.x); s[2] += bflo(v.y); s[3] += bfhi(v.y); s[4] += bflo(v.z); s[5] += bfhi(v.z); s[6] += bflo(v.w); s[7] += bfhi(v.w); } }
    for (int j = 0; j < 16; ++j) {
        const int t = tb + j;
        const u32x4 v = *(const u32x4*)(xp + (size_t)t * 2048);
        float x[8]; x[0] = bflo(v.x); x[1] = bfhi(v.x); x[2] = bflo(v.y); x[3] = bfhi(v.y); x[4] = bflo(v.z); x[5] = bfhi(v.z); x[6] = bflo(v.w); x[7] = bfhi(v.w);
        const float cnt = (float)((t + 1) < W ? (t + 1) : W);
        float o[8];
#pragma unroll
        for (int c = 0; c < 8; ++c) { s[c] += x[c]; o[c] = s[c] / cnt - x[c]; }
        u32x4 w; w.x = pk2(o[0], o[1]); w.y = pk2(o[2], o[3]); w.z = pk2(o[4], o[5]); w.w = pk2(o[6], o[7]);
        *(u32x4*)(AO + ((size_t)b * SEQ + t) * 1024 + 512 + 8 * co) = w;
        const int tr = t - W + 1;
        if (tr >= 0) { const u32x4 u = *(const u32x4*)(xp + (size_t)tr * 2048);
            s[0] -= bflo(u.x); s[1] -= bfhi(u.x); s[2] -= bflo(u.y); s[3] -= bfhi(u.y); s[4] -= bflo(u.z); s[5] -= bfhi(u.z); s[6] -= bflo(u.w); s[7] -= bfhi(u.w); }
    }
}

constexpr int RT_YS = 1028;
constexpr int RT_Y = 0, RT_PART = 66048, RT_LOG = 82432, RT_SELE = 99328, RT_SELG = 101376, RT_SELR = 103424, RT_HIST = 105472, RT_BASE = 105600, RT_LNW = 105728;
__device__ __forceinline__ void wave_sum4(float& a, float& b, float& c, float& d) {
#pragma unroll
    for (int o = 1; o < 64; o <<= 1) { const float ta = __shfl_xor(a, o), tb = __shfl_xor(b, o), tc = __shfl_xor(c, o), td = __shfl_xor(d, o); a += ta; b += tb; c += tc; d += td; }
}
__device__ __forceinline__ void split_hl(const float (&x)[8], u32x4& hi, u32x4& lo) {
    unsigned h[4], l[4];
#pragma unroll
    for (int i = 0; i < 4; ++i) { h[i] = pk2(x[2 * i], x[2 * i + 1]); l[i] = pk2(x[2 * i] - bflo(h[i]), x[2 * i + 1] - bfhi(h[i])); }
    hi = (u32x4){h[0], h[1], h[2], h[3]}; lo = (u32x4){l[0], l[1], l[2], l[3]};
}
__device__ __forceinline__ void router_load_w(const float* wr, u32x4 (&wreg)[16], int wave, int lane) {
    const float* wp = wr + (size_t)(128 * wave + 8 * (lane >> 4)) * 32 + (lane & 15);
#pragma unroll
    for (int kk = 0; kk < 4; ++kk)
#pragma unroll
        for (int tl = 0; tl < 2; ++tl) { float x[8];
#pragma unroll
            for (int j = 0; j < 8; ++j) x[j] = wp[(32 * kk + j) * 32 + 16 * tl];
            split_hl(x, wreg[(kk * 2 + tl) * 2], wreg[(kk * 2 + tl) * 2 + 1]); }
}
template <bool XF32>
__device__ __forceinline__ void router_block(LAS unsigned char* lds, int blk, const float* X32, const bf16_t* XB, bf16_t* XBo, unsigned char* XB8, const bf16_t* H, const float* lnw, const float* lnb,
                                             const u32x4 (&wreg)[16], const float* br, unsigned* cnt, int* tokl, float* gatel, int* tinfo, int tid, int wave, int lane) {
    const int c16 = lane & 15, g = lane >> 4;
    if (tid < 32) *(LAS unsigned*)(lds + RT_HIST + tid * 4) = 0u;
    u32x2 hq[2][4]; f32x4 xq[2][4]; u32x2 xh[2][4];
#pragma unroll
    for (int j = 0; j < 4; ++j) {
#pragma unroll
        for (int k = 0; k < 2; ++k) { hq[k][j] = (u32x2){0u, 0u}; xh[k][j] = (u32x2){0u, 0u}; xq[k][j] = (f32x4){0.f, 0.f, 0.f, 0.f}; } }
    const unsigned lo4 = 4u * (unsigned)lane;
#define RT_LOAD(bt_) do { _Pragma("unroll") for (int k = 0; k < 2; ++k) { const size_t t_ = (size_t)blk * 128 + 16 * (bt_) + 2 * wave + k; \
        const bf16_t* hb_ = H + t_ * 1024 + lo4; const float* xb_ = X32 + t_ * 1024 + lo4; const bf16_t* xh_ = XB + t_ * 1024 + lo4; _Pragma("unroll") for (int j = 0; j < 4; ++j) { \
        LDPIN8(hq[k][j], hb_ + 256 * j); \
        if constexpr (XF32) LDPIN16(xq[k][j], xb_ + 256 * j); else LDPIN8(xh[k][j], xh_ + 256 * j); } } } while (0)
#define RT_PINROWS "+v"(hq[0][0]), "+v"(hq[0][1]), "+v"(hq[0][2]), "+v"(hq[0][3]), "+v"(hq[1][0]), "+v"(hq[1][1]), "+v"(hq[1][2]), "+v"(hq[1][3])
    { const f32x4 w4 = *(const f32x4*)(lnw + 4 * (tid & 255)), b4 = *(const f32x4*)(lnb + 4 * (tid & 255)); if (tid < 256) *(LAS f32x4*)(lds + RT_LNW + 16 * tid) = w4; else *(LAS f32x4*)(lds + RT_LNW + 4096 + 16 * (tid - 256)) = b4; }
    RT_LOAD(0);
    LDS_BARRIER();
#pragma unroll 1
    for (int bt = 0; bt < 8; ++bt) {
        if constexpr (XF32) asm volatile("s_waitcnt vmcnt(0)" : RT_PINROWS, "+v"(xq[0][0]), "+v"(xq[0][1]), "+v"(xq[0][2]), "+v"(xq[0][3]), "+v"(xq[1][0]), "+v"(xq[1][1]), "+v"(xq[1][2]), "+v"(xq[1][3]) :: "memory");
        else asm volatile("s_waitcnt vmcnt(0)" : RT_PINROWS, "+v"(xh[0][0]), "+v"(xh[0][1]), "+v"(xh[0][2]), "+v"(xh[0][3]), "+v"(xh[1][0]), "+v"(xh[1][1]), "+v"(xh[1][2]), "+v"(xh[1][3]) :: "memory");
#define RT_V(k_, j_) ((XF32 ? xq[k_][j_] : (f32x4){bflo(xh[k_][j_].x), bfhi(xh[k_][j_].x), bflo(xh[k_][j_].y), bfhi(xh[k_][j_].y)}) * ALPHA + (f32x4){bflo(hq[k_][j_].x), bfhi(hq[k_][j_].x), bflo(hq[k_][j_].y), bfhi(hq[k_][j_].y)})
        float s1[2], s2[2];
#pragma unroll
        for (int k = 0; k < 2; ++k) { s1[k] = 0.f; s2[k] = 0.f;
#pragma unroll
            for (int j = 0; j < 4; ++j) { const f32x4 t4 = RT_V(k, j); s1[k] += (t4.x + t4.y) + (t4.z + t4.w); s2[k] += (t4.x * t4.x + t4.y * t4.y) + (t4.z * t4.z + t4.w * t4.w); } }
        wave_sum4(s1[0], s2[0], s1[1], s2[1]);
#pragma unroll
        for (int k = 0; k < 2; ++k) {
            const int tl = 2 * wave + k; const size_t t = (size_t)blk * 128 + 16 * bt + tl;
            const float mean = s1[k] * (1.f / D); const float var = fmaxf(s2[k] * (1.f / D) - mean * mean, 0.f); const float rstd = 1.f / sqrtf(var + LN_EPS);
            bf16_t* xo_ = XBo + t * 1024; unsigned char* x8_ = XB8 + t * 1024;
#pragma unroll
            for (int j = 0; j < 4; ++j) { const f32x4 ww = *(const LAS f32x4*)(lds + RT_LNW + (256 * j + lo4) * 4), bb = *(const LAS f32x4*)(lds + RT_LNW + 4096 + (256 * j + lo4) * 4);
                const f32x4 y = (RT_V(k, j) - mean) * rstd * ww + bb;
                u32x2 o; o.x = pk2(y.x, y.y); o.y = pk2(y.z, y.w); *(u32x2*)(xo_ + 256 * j + lo4) = o;
                *(unsigned*)(x8_ + 256 * j + lo4) = pk4_fp8(y.x, y.y, y.z, y.w);
                *(LAS f32x4*)(lds + RT_Y + (tl * RT_YS + 4 * lane + 256 * j) * 4) = y; }
        }
#undef RT_V
        if constexpr (XF32) asm volatile("" : RT_PINROWS, "+v"(xq[0][0]), "+v"(xq[0][1]), "+v"(xq[0][2]), "+v"(xq[0][3]), "+v"(xq[1][0]), "+v"(xq[1][1]), "+v"(xq[1][2]), "+v"(xq[1][3]) :: "memory");
        else asm volatile("" : RT_PINROWS, "+v"(xh[0][0]), "+v"(xh[0][1]), "+v"(xh[0][2]), "+v"(xh[0][3]), "+v"(xh[1][0]), "+v"(xh[1][1]), "+v"(xh[1][2]), "+v"(xh[1][3]) :: "memory");
        if (bt < 7) RT_LOAD(bt + 1);
        LDS_BARRIER();
        {
            f32x4 a0 = (f32x4){0.f, 0.f, 0.f, 0.f}, a1 = a0;
            const LAS float* yp = (const LAS float*)(lds + RT_Y) + c16 * RT_YS + 128 * wave + 8 * g; asm volatile("" : "+v"(yp));
#pragma unroll
            for (int kk = 0; kk < 4; ++kk) {
                const f32x4 ya = *(const LAS f32x4*)(yp + 32 * kk), yb = *(const LAS f32x4*)(yp + 32 * kk + 4);
                const float x[8] = {ya.x, ya.y, ya.z, ya.w, yb.x, yb.y, yb.z, yb.w};
                u32x4 yh, yl; split_hl(x, yh, yl);
                const bf16x8 ah = __builtin_bit_cast(bf16x8, yh), al = __builtin_bit_cast(bf16x8, yl);
#pragma unroll
                for (int tl = 0; tl < 2; ++tl) { const bf16x8 wh = __builtin_bit_cast(bf16x8, wreg[(kk * 2 + tl) * 2]), wl = __builtin_bit_cast(bf16x8, wreg[(kk * 2 + tl) * 2 + 1]);
                    f32x4 acc = tl ? a1 : a0;
                    acc = __builtin_amdgcn_mfma_f32_16x16x32_bf16(al, wh, acc, 0, 0, 0); acc = __builtin_amdgcn_mfma_f32_16x16x32_bf16(ah, wl, acc, 0, 0, 0); acc = __builtin_amdgcn_mfma_f32_16x16x32_bf16(ah, wh, acc, 0, 0, 0);
                    if (tl) a1 = acc; else a0 = acc; }
            }
            LAS float* pp = (LAS float*)(lds + RT_PART) + (wave * 16 + 4 * g) * 32 + c16;
#pragma unroll
            for (int r = 0; r < 4; ++r) { pp[r * 32] = a0[r]; pp[r * 32 + 16] = a1[r]; }
        }
        LDS_BARRIER();
        {
            const int tk = tid >> 5, e = tid & 31;
            float lg = br[e];
            const LAS float* pp = (const LAS float*)(lds + RT_PART) + tk * 32 + e; asm volatile("" : "+v"(pp));
#pragma unroll
            for (int w = 0; w < 8; ++w) lg += pp[w * 512];
            *(LAS float*)(lds + RT_LOG + ((16 * bt + tk) * 33 + e) * 4) = lg;
        }
    }
#undef RT_LOAD
#undef RT_PINROWS
    LDS_BARRIER();
    if (tid < 128) {
        const LAS float* lp = (const LAS float*)(lds + RT_LOG) + tid * 33;
        float v0 = -INFINITY, v1 = -INFINITY, v2 = -INFINITY, v3 = -INFINITY; int i0 = 0, i1 = 0, i2 = 0, i3 = 0;
#pragma unroll
        for (int e = 0; e < 32; ++e) { const float x = lp[e];
            const bool g0 = x > v0, g1 = x > v1, g2 = x > v2, g3 = x > v3;
            v3 = g2 ? v2 : (g3 ? x : v3); i3 = g2 ? i2 : (g3 ? e : i3);
            v2 = g1 ? v1 : (g2 ? x : v2); i2 = g1 ? i1 : (g2 ? e : i2);
            v1 = g0 ? v0 : (g1 ? x : v1); i1 = g0 ? i0 : (g1 ? e : i1);
            v0 = g0 ? x : v0; i0 = g0 ? e : i0; }
        const float e1 = __expf(v1 - v0), e2 = __expf(v2 - v0), e3 = __expf(v3 - v0);
        const float inv = 1.0f / (1.0f + e1 + e2 + e3);
        const int mi[4] = {i0, i1, i2, i3}; const float gt[4] = {inv, e1 * inv, e2 * inv, e3 * inv};
#pragma unroll
        for (int k = 0; k < 4; ++k) {
            const unsigned lr = __hip_atomic_fetch_add((LAS unsigned*)(lds + RT_HIST + mi[k] * 4), 1u, __ATOMIC_RELAXED, __HIP_MEMORY_SCOPE_WORKGROUP);
            const int sidx = tid * 4 + k;
            *(LAS int*)(lds + RT_SELE + sidx * 4) = mi[k]; *(LAS float*)(lds + RT_SELG + sidx * 4) = gt[k]; *(LAS unsigned*)(lds + RT_SELR + sidx * 4) = lr;
        }
    }
    LDS_BARRIER();
    if (tid < 32) { const unsigned hc = *(LAS unsigned*)(lds + RT_HIST + tid * 4);
        *(LAS unsigned*)(lds + RT_BASE + tid * 4) = __hip_atomic_fetch_add(cnt + tid, hc, __ATOMIC_RELAXED, __HIP_MEMORY_SCOPE_AGENT); }
    __syncthreads();
    {
        const int me = *(LAS int*)(lds + RT_SELE + tid * 4); const float gt = *(LAS float*)(lds + RT_SELG + tid * 4);
        const unsigned rank = *(LAS unsigned*)(lds + RT_BASE + me * 4) + *(LAS unsigned*)(lds + RT_SELR + tid * 4);
        const int tok = blk * 128 + (tid >> 2);
        tokl[(size_t)me * T + rank] = tok; gatel[(size_t)me * T + rank] = gt; tinfo[(size_t)tok * 4 + (tid & 3)] = (me << 16) | (int)rank;
    }
    __syncthreads();
}

__device__ __forceinline__ void combine_rows2(size_t t0, size_t t1, const unsigned char* Y, const int* tinfo, const LAS int* tab, const bf16_t* XB, bf16_t* XBo, float* OUT32, const f32x4 (&lw)[4], const f32x4 (&lb)[4], int lane) {
    f32x4 v[2][4]; float s1[2], s2[2];
#pragma unroll
    for (int k2 = 0; k2 < 2; ++k2) {
        const size_t t = k2 ? t1 : t0;
        const u32x4 x0 = *(const u32x4*)(XB + t * 1024 + 16 * lane), x1 = *(const u32x4*)(XB + t * 1024 + 16 * lane + 8);
        const u32x4 inf4 = *(const u32x4*)(tinfo + t * 4);
        v[k2][0] = (f32x4){bflo(x0.x), bfhi(x0.x), bflo(x0.y), bfhi(x0.y)} * ALPHA; v[k2][1] = (f32x4){bflo(x0.z), bfhi(x0.z), bflo(x0.w), bfhi(x0.w)} * ALPHA;
        v[k2][2] = (f32x4){bflo(x1.x), bfhi(x1.x), bflo(x1.y), bfhi(x1.y)} * ALPHA; v[k2][3] = (f32x4){bflo(x1.z), bfhi(x1.z), bflo(x1.w), bfhi(x1.w)} * ALPHA;
        u32x4 yy[4];
#pragma unroll
        for (int k = 0; k < 4; ++k) { const unsigned inf = k == 0 ? inf4.x : k == 1 ? inf4.y : k == 2 ? inf4.z : inf4.w; const int ee = (int)(inf >> 16), rk = (int)(inf & 0xffffu);
            const size_t slot = (size_t)tab[ee] * 256 + rk; yy[k] = *(const u32x4*)(Y + slot * 1024 + 16 * lane); }
#pragma unroll
        for (int k = 0; k < 4; ++k) {
#pragma unroll
            for (int j = 0; j < 4; ++j) { const int w = (int)(j == 0 ? yy[k].x : j == 1 ? yy[k].y : j == 2 ? yy[k].z : yy[k].w);
                const f32x2 lo2 = __builtin_amdgcn_cvt_pk_f32_fp8(w, false), hi2 = __builtin_amdgcn_cvt_pk_f32_fp8(w, true);
                v[k2][j] = v[k2][j] + (f32x4){lo2.x, lo2.y, hi2.x, hi2.y} * 0.0625f; } }
        float a = 0.f, q = 0.f;
#pragma unroll
        for (int j = 0; j < 4; ++j) { const f32x4 u = v[k2][j]; a += (u.x + u.y) + (u.z + u.w); q += (u.x * u.x + u.y * u.y) + (u.z * u.z + u.w * u.w); }
        s1[k2] = a; s2[k2] = q;
    }
    wave_sum4(s1[0], s2[0], s1[1], s2[1]);
#pragma unroll
    for (int k2 = 0; k2 < 2; ++k2) {
        const size_t t = k2 ? t1 : t0;
        const float mean = s1[k2] * (1.f / D); const float var = fmaxf(s2[k2] * (1.f / D) - mean * mean, 0.f); const float rstd = 1.f / sqrtf(var + LN_EPS);
        f32x4 y[4];
#pragma unroll
        for (int j = 0; j < 4; ++j) y[j] = (v[k2][j] - mean) * rstd * lw[j] + lb[j];
        if (OUT32) {
#pragma unroll
            for (int j = 0; j < 4; ++j) *(f32x4*)(OUT32 + t * 1024 + 16 * lane + 4 * j) = y[j];
        } else {
            u32x4 o0, o1; o0.x = pk2(y[0].x, y[0].y); o0.y = pk2(y[0].z, y[0].w); o0.z = pk2(y[1].x, y[1].y); o0.w = pk2(y[1].z, y[1].w);
            o1.x = pk2(y[2].x, y[2].y); o1.y = pk2(y[2].z, y[2].w); o1.z = pk2(y[3].x, y[3].y); o1.w = pk2(y[3].z, y[3].w);
            *(u32x4*)(XBo + t * 1024 + 16 * lane) = o0; *(u32x4*)(XBo + t * 1024 + 16 * lane + 8) = o1;
        }
    }
}

__device__ __forceinline__ int crow(int r, int hi) { return (r & 3) + 8 * (r >> 2) + 4 * hi; }
__device__ __forceinline__ void attn_phase(const bf16_t* QB, const bf16_t* KB, const bf16_t* VT, bf16_t* AO, int gw, int ngw, int lane) {
    const int r32 = lane & 31, hi = lane >> 5;
    for (int task = gw; task < BATCH * 16 * (SEQ / 32); task += ngw) {
        const int qt = task & 255, bh = task >> 8, b = bh >> 4, h = bh & 15;
        const size_t rowb = (size_t)b * SEQ; const int q0 = qt * 32;
        bf16x8 qf[4];
        { const bf16_t* qp = QB + (rowb + q0 + r32) * 1024 + h * 64 + hi * 8;
#pragma unroll
          for (int s = 0; s < 4; ++s) qf[s] = *(const bf16x8*)(qp + 16 * s); }
        f32x16 o0, o1;
#pragma unroll
        for (int r = 0; r < 16; ++r) { o0[r] = 0.f; o1[r] = 0.f; }
        float carry = 1.f;
        const bf16_t* kbase = KB + (size_t)bh * 256 * 4 * 64 * 8 + lane * 8;
        const bf16_t* vbase = VT + (size_t)bh * 256 * 4 * 64 * 8 + lane * 8;
        bf16x8 kn[4];
#pragma unroll
        for (int s = 0; s < 4; ++s) kn[s] = *(const bf16x8*)(kbase + (size_t)qt * 2048 + s * 512);
        for (int kt = qt; kt >= 0; --kt) {
            bf16x8 kf[4];
#pragma unroll
            for (int s = 0; s < 4; ++s) kf[s] = kn[s];
            bf16x8 va[2][2];
#pragma unroll
            for (int dt = 0; dt < 2; ++dt)
#pragma unroll
                for (int sp = 0; sp < 2; ++sp) va[dt][sp] = *(const bf16x8*)(vbase + (size_t)kt * 2048 + (dt * 2 + sp) * 512);
            { const int kp = kt > 0 ? kt - 1 : 0;
#pragma unroll
              for (int s = 0; s < 4; ++s) kn[s] = *(const bf16x8*)(kbase + (size_t)kp * 2048 + s * 512); }
            f32x16 st;
#pragma unroll
            for (int r = 0; r < 16; ++r) st[r] = 0.f;
#pragma unroll
            for (int s = 0; s < 4; ++s) st = __builtin_amdgcn_mfma_f32_32x32x16_bf16(kf[s], qf[s], st, 0, 0, 0);
            const bool diag = (kt == qt);
            float R[16], Bt[16];
#pragma unroll
            for (int r = 0; r < 16; r += 2) {
                const f32x2 e = (f32x2){fexp2(st[r]), fexp2(st[r + 1])};
                const f32x2 d = e + 1.0f;
                f32x2 rr = (f32x2){frcp(d.x), frcp(d.y)};
                if (diag) { rr.x = (crow(r, hi) < r32) ? rr.x : 1.0f; rr.y = (crow(r + 1, hi) < r32) ? rr.y : 1.0f; }
                const f32x2 bt = 1.0f - rr;
                R[r] = rr.x; R[r + 1] = rr.y; Bt[r] = bt.x; Bt[r + 1] = bt.y;
            }
            float own[4], pg[4];
#pragma unroll
            for (int rg = 0; rg < 4; ++rg) { own[rg] = (R[4 * rg] * R[4 * rg + 1]) * (R[4 * rg + 2] * R[4 * rg + 3]); pg[rg] = __shfl_xor(own[rg], 32); }
            float aft[4];
            { float run = 1.f;
#pragma unroll
              for (int rg = 3; rg >= 0; --rg) { aft[rg] = (hi == 0) ? run * pg[rg] : run; run *= own[rg] * pg[rg]; }
              float w[16];
#pragma unroll
              for (int rg = 0; rg < 4; ++rg) { float lat = carry * aft[rg];
#pragma unroll
                  for (int p = 3; p >= 0; --p) { w[4 * rg + p] = Bt[4 * rg + p] * lat; lat *= R[4 * rg + p]; } }
              carry *= run;
              u32x4 p0, p1;
              p0.x = pk2(w[0], w[1]); p0.y = pk2(w[2], w[3]); p0.z = pk2(w[4], w[5]); p0.w = pk2(w[6], w[7]);
              p1.x = pk2(w[8], w[9]); p1.y = pk2(w[10], w[11]); p1.z = pk2(w[12], w[13]); p1.w = pk2(w[14], w[15]);
              const bf16x8 pf0 = __builtin_bit_cast(bf16x8, p0), pf1 = __builtin_bit_cast(bf16x8, p1);
              o0 = __builtin_amdgcn_mfma_f32_32x32x16_bf16(va[0][0], pf0, o0, 0, 0, 0); o0 = __builtin_amdgcn_mfma_f32_32x32x16_bf16(va[0][1], pf1, o0, 0, 0, 0);
              o1 = __builtin_amdgcn_mfma_f32_32x32x16_bf16(va[1][0], pf0, o1, 0, 0, 0); o1 = __builtin_amdgcn_mfma_f32_32x32x16_bf16(va[1][1], pf1, o1, 0, 0, 0);
            }
            if (__all(carry < ATT_THR)) break;
        }
        bf16_t* op = AO + (rowb + q0 + r32) * 1024 + h * 64 + 4 * hi;
#pragma unroll
        for (int rg = 0; rg < 4; ++rg) {
            u32x2 w; w.x = pk2(o0[4 * rg], o0[4 * rg + 1]); w.y = pk2(o0[4 * rg + 2], o0[4 * rg + 3]); *(u32x2*)(op + 8 * rg) = w;
            w.x = pk2(o1[4 * rg], o1[4 * rg + 1]); w.y = pk2(o1[4 * rg + 2], o1[4 * rg + 3]); *(u32x2*)(op + 32 + 8 * rg) = w;
        }
    }
}

constexpr int NWAVES = 8;
constexpr int NPHASE = 17;
struct Args { const float* in[29]; float* out; unsigned char* ws; int ph_lo, ph_hi; };

#ifndef PH_MASK
#define PH_MASK 0xfff
#endif
#define EN(b) ((PH_MASK >> (b)) & 1)
#ifndef REP_MASK
#define REP_MASK 0
#endif
#define RP(b) ((REP_MASK >> (b)) & 1)
#define PHASE(b, k, ...) if (EN(b) && IN(k)) { PH_IDS; { __VA_ARGS__ } if (RP(b)) { __VA_ARGS__ } }
#define IN(k) (lo <= (k) && (k) < hi)
#if MK_PER_PHASE
#define SEAM(k) do { } while (0)
#else
#define SEAM(k) do { if (IN(k) && IN((k) + 1)) xcd_barrier(bar); } while (0)
#endif
#define PH_IDS const int lane = lane_id_asm(); const int wave = wave0; const int tid = wave * 64 + lane; const int G = gridDim.x, bx = blockIdx.x; const int gw = bx * NWAVES + wave, NGW = G * NWAVES; (void)tid; (void)lane; (void)gw; (void)NGW; (void)G; (void)bx
#define WSP(T_, off) ((T_*)(args.ws + (off)))

template <int LAYER>
__device__ __forceinline__ void layer_tail(const Args& args, LAS unsigned char* lds, const XcdBarrier& bar, int lo, int hi, const int wave0) {
    constexpr int PB = LAYER == 0 ? 5 : 12;
    LAS int* moetab = (LAS int*)(lds + MOETAB_OFF);
    LAS unsigned* rowtab = (LAS unsigned*)(lds + ROWTAB_OFF);
    PHASE(5, PB,
        pg8::Gemm g{WSP(bf16_t, WS_SB), WSP(bf16_t, LAYER ? WS_WO1T : WS_WO0T), 1024, 0}; pg8::StaticOrder S; S.init(T, 1024, G, bx); pg8::EpiPlain E{WSP(bf16_t, WS_SB + 64 * MiB), 1024, 0, 0, 1.f};
        pg8::gemm_phase<pg8::EpiPlain, pg8::StaticOrder, 0>(lds, g, S, E, nullptr, rowtab, tid);)
    SEAM(PB);
    if (RP(6) && EN(6) && IN(PB + 1)) { PH_IDS;
        unsigned* cnt = WSP(unsigned, WS_CTL) + CW_CNT + 128 + LAYER * 64;
        u32x4 wreg[16]; router_load_w(args.in[LAYER ? 21 : 9], wreg, wave, lane);
        for (int blk = bx; blk < T / 128; blk += G)
            router_block<LAYER == 0>(lds, blk, LAYER ? nullptr : args.in[0], WSP(bf16_t, WS_XB), WSP(bf16_t, WS_END), WSP(unsigned char, WS_END + 64 * MiB), WSP(bf16_t, WS_SB + 64 * MiB), args.in[LAYER ? 19 : 7], args.in[LAYER ? 20 : 8], wreg, args.in[LAYER ? 22 : 10],
                         cnt, WSP(int, WS_END + 96 * MiB), WSP(float, WS_END + 100 * MiB), WSP(int, WS_END + 104 * MiB), tid, wave, lane); }
    if (EN(6) && IN(PB + 1)) { PH_IDS;
        unsigned* cnt = WSP(unsigned, WS_CTL) + CW_CNT + LAYER * 64;
        u32x4 wreg[16]; router_load_w(args.in[LAYER ? 21 : 9], wreg, wave, lane);
        for (int blk = bx; blk < T / 128; blk += G)
            router_block<LAYER == 0>(lds, blk, LAYER ? nullptr : args.in[0], WSP(bf16_t, WS_XB), WSP(bf16_t, WS_XB), WSP(unsigned char, WS_XB8), WSP(bf16_t, WS_SB + 64 * MiB), args.in[LAYER ? 19 : 7], args.in[LAYER ? 20 : 8], wreg, args.in[LAYER ? 22 : 10],
                         cnt, WSP(int, WS_TOKL), WSP(float, WS_GATEL), WSP(int, WS_TINFO), tid, wave, lane); }
    SEAM(PB + 1);
    PHASE(7, PB + 2,
        moe_table(WSP(unsigned, WS_CTL) + CW_CNT + LAYER * 64, moetab, tid);
        pg8::Gemm g{WSP(bf16_t, WS_XB8), WSP(bf16_t, WS_W1T), 512, 2048}; pg8::MoeOrder S; S.init(moetab, 8, G, bx); pg8::EpiSwiglu8 E{WSP(unsigned char, WS_SA), args.in[LAYER ? 24 : 12]};
        pg8::gemm_phase<pg8::EpiSwiglu8, pg8::MoeOrder, 1, 127 - W1_SH>(lds, g, S, E, WSP(int, WS_TOKL), rowtab, tid);)
    SEAM(PB + 2);
    PHASE(8, PB + 3,
        moe_table(WSP(unsigned, WS_CTL) + CW_CNT + LAYER * 64, moetab, tid);
        pg8::Gemm g{WSP(bf16_t, WS_SA), WSP(bf16_t, WS_W2T), 512, 1024}; pg8::MoeOrder S; S.init(moetab, 4, G, bx); pg8::EpiDown8 E{WSP(unsigned char, WS_SB), args.in[LAYER ? 26 : 14], WSP(float, WS_GATEL)};
        pg8::gemm_phase<pg8::EpiDown8, pg8::MoeOrder, 2, 127 - W2_SH>(lds, g, S, E, nullptr, rowtab, tid);)
    SEAM(PB + 3);
    if (EN(9) && IN(PB + 4)) { PH_IDS;
        moe_table(WSP(unsigned, WS_CTL) + CW_CNT + LAYER * 64, moetab, tid);
        f32x4 lw[4], lb[4];
#pragma unroll
        for (int j = 0; j < 4; ++j) { lw[j] = *(const f32x4*)(args.in[LAYER ? 27 : 15] + 16 * lane + 4 * j); lb[j] = *(const f32x4*)(args.in[LAYER ? 28 : 16] + 16 * lane + 4 * j); }
        if (RP(9)) { for (int t = gw; t < T; t += 2 * NGW) combine_rows2((size_t)t, (size_t)(t + NGW), WSP(unsigned char, WS_SB), WSP(int, WS_TINFO), moetab, WSP(bf16_t, WS_XB), WSP(bf16_t, WS_END), LAYER ? (float*)WSP(float, WS_END) : nullptr, lw, lb, lane); }
        for (int t = gw; t < T; t += 2 * NGW) combine_rows2((size_t)t, (size_t)(t + NGW), WSP(unsigned char, WS_SB), WSP(int, WS_TINFO), moetab, WSP(bf16_t, WS_XB), WSP(bf16_t, WS_XB), LAYER ? args.out : nullptr, lw, lb, lane);
    }
    if (LAYER == 0) SEAM(PB + 4);
}

__global__ void __launch_bounds__(NWAVES * 64, 2) mk_fwd(Args args) {
    extern __shared__ __attribute__((aligned(16))) unsigned char lds_raw[];
    LAS unsigned char* lds = (LAS unsigned char*)lds_raw;
    volatile LAS unsigned* MISC = (volatile LAS unsigned*)(lds + MISC_OFF);
    LAS unsigned* rowtab = (LAS unsigned*)(lds + ROWTAB_OFF);
    if (threadIdx.x < 32) MISC[threadIdx.x] = 0u;
    __syncthreads();
    const int wave0 = __builtin_amdgcn_readfirstlane(threadIdx.x >> 6);
    XcdBarrier bar; bar.bar = WSP(unsigned, WS_CTL) + CW_BAR; bar.x = 0; bar.st = nullptr; bar.wave = wave0;
#if !MK_PER_PHASE
    bar = xcd_barrier_post(WSP(unsigned, WS_CTL) + CW_BAR, MISC + 8);
#endif
    const int lo = args.ph_lo, hi = args.ph_hi;

    PHASE(0, 0,
        const float* x_in = args.in[0]; const float* w_in0 = args.in[2]; const float* wpool = args.in[4]; const float* pscale = args.in[5]; const float* w_o0 = args.in[6];
        const float* w_in1 = args.in[17]; const float* w_o1 = args.in[18];
        bf16_t* WIN0T = WSP(bf16_t, WS_WIN0T); bf16_t* WO0T = WSP(bf16_t, WS_WO0T); bf16_t* WIN1T = WSP(bf16_t, WS_WIN1T); bf16_t* WO1T = WSP(bf16_t, WS_WO1T); bf16_t* XB = WSP(bf16_t, WS_XB);
        LAS float* scr = (LAS float*)(lds + wave * 16384);
        constexpr int I_IN0 = 16 * 80, I_O0 = 8 * 32, I_IN1 = 16 * 96, I_O1 = 16 * 32, NIT = I_IN0 + I_O0 + I_IN1 + I_O1;
        for (int it = gw; it < NIT; it += NGW) {
            int r = it;
            if (r < I_IN0) { const int kb = r / 80, nb = r % 80, n0 = 32 * nb;
                const int dr = n0 < 512 ? 2 * n0 : (n0 < 1024 ? 2 * (n0 - 512) + 1 : (n0 < 1536 ? n0 + 1024 : n0 - 512));
                transpose_item(w_in0, 2560, WIN0T, 1024, 64 * kb, n0, dr, scr, lane, n0 < 1024 ? 2 : 1); continue; } r -= I_IN0;
            if (r < I_O0) { const int kb = r / 32, nb = r % 32; transpose_item(w_o0, 1024, WO0T, 1024, 64 * kb, 32 * nb, 32 * nb, scr, lane); continue; } r -= I_O0;
            if (r < I_IN1) { const int kb = r / 96, nb = r % 96; transpose_item(w_in1, 3072, WIN1T, 1024, 64 * kb, 32 * nb, 32 * nb, scr, lane); continue; } r -= I_IN1;
            { const int kb = r / 32, nb = r % 32; transpose_item(w_o1, 1024, WO1T, 1024, 64 * kb, 32 * nb, 32 * nb, scr, lane); }
        }
        for (int idx = bx * 512 + tid; idx < 512 * 1024; idx += G * 512) {
            const int n = idx & 1023, gc = idx >> 10, gg = gc >> 7;
            const float* wp = wpool + (size_t)gc * 128; const float* ps = pscale + 128 * gg; const float* wo = w_o0 + (size_t)(512 + 128 * gg) * 1024 + n;
            float a = 0.f;
_Pragma("unroll 8")
            for (int d = 0; d < 128; ++d) a += wp[d] * ps[d] * wo[(size_t)d * 1024];
            WO0T[(size_t)n * 1024 + 512 + gc] = (bf16_t)(pk2(a, 0.f) & 0xffffu);
        }
        for (size_t i = (size_t)bx * 512 + tid; i < (size_t)T * D / 8; i += (size_t)G * 512) {
            const f32x4 a = *(const f32x4*)(x_in + i * 8), b2 = *(const f32x4*)(x_in + i * 8 + 4);
            u32x4 o; o.x = pk2(a.x, a.y); o.y = pk2(a.z, a.w); o.z = pk2(b2.x, b2.y); o.w = pk2(b2.z, b2.w);
            *(u32x4*)(XB + i * 8) = o;
        })
    SEAM(0);
    PHASE(1, 1,
        { pg8::Gemm g{WSP(bf16_t, WS_XB), WSP(bf16_t, WS_WIN0T), 1024, 0}; pg8::StaticOrder S; S.init(T, 2048, G, bx); pg8::EpiPlain E{WSP(bf16_t, WS_SA), 2048, 0, 0, 1.f};
          pg8::gemm_phase<pg8::EpiPlain, pg8::StaticOrder, 0>(lds, g, S, E, nullptr, rowtab, tid); }
        { pg8::Gemm g{WSP(bf16_t, WS_WIN0T) + (size_t)2048 * 1024, WSP(bf16_t, WS_XB), 1024, 0}; pg8::StaticOrder S; S.init(512, T, G, bx); pg8::EpiPlain E{WSP(bf16_t, WS_SA + 128 * MiB), T, 0, 0, 1.f};
          pg8::gemm_phase<pg8::EpiPlain, pg8::StaticOrder, 0>(lds, g, S, E, nullptr, rowtab, tid); })
    SEAM(1);
#define HG_UNIT0(u_) hgrn_unit<0>(lds, u_, WSP(bf16_t, WS_SA), WSP(bf16_t, WS_SA + 128 * MiB), WSP(float, WS_SB + 128 * MiB), WSP(float, WS_SB + 160 * MiB), args.in[1], args.in[3], WSP(bf16_t, WS_SB), tid, wave, lane)
#define HG_UNIT1(u_) hgrn_unit<1>(lds, u_, WSP(bf16_t, WS_SA), WSP(bf16_t, WS_SA + 128 * MiB), WSP(float, WS_SB + 128 * MiB), WSP(float, WS_SB + 160 * MiB), args.in[1], args.in[3], WSP(bf16_t, WS_SB), tid, wave, lane)
#define CONV0(q0_, q1_) conv_moe_wg(args.in[11], args.in[13], WSP(unsigned char, WS_W1T), WSP(unsigned char, WS_W2T), (LAS float*)lds, bx, G, tid, (q0_) * cq, (q1_) * cq)
    PHASE(2, 2,
        const bool cfirst = (bx & 1) != 0; const int cq = ((NE * 192 + G - 1) / G + 3) / 4;
        if (cfirst) CONV0(0, 1);
        if (bx < 512) HG_UNIT0(bx);
        if (cfirst) CONV0(1, 2); else CONV0(0, 1);
        for (int u = bx + G; u < 512; u += G) HG_UNIT0(u);
        if (!cfirst) CONV0(1, 2);
        for (int task = bx; task < 256; task += G) pool_task(task, WSP(bf16_t, WS_SA), WSP(bf16_t, WS_SB), tid);)
    SEAM(2);
    PHASE(3, 3,
        float* SLOC = WSP(float, WS_SB + 128 * MiB); const float* DTOT = WSP(float, WS_SB + 160 * MiB);
        for (int ch = bx * 512 + tid; ch < 16 * 16384; ch += G * 512) {
            const int bh = ch >> 14, el = ch & 16383, dk = el >> 7;
            float* sp = SLOC + (size_t)bh * 32 * 16384 + el; const float* dp = DTOT + (size_t)bh * 32 * 128 + dk;
            float loc[32], dd[32];
_Pragma("unroll")
            for (int sc = 0; sc < 32; ++sc) { loc[sc] = sp[(size_t)sc * 16384]; dd[sc] = dp[sc * 128]; }
            float S = 0.f;
_Pragma("unroll")
            for (int sc = 0; sc < 32; ++sc) { sp[(size_t)sc * 16384] = S; S = dd[sc] * S + loc[sc]; }
        })
    SEAM(3);
    PHASE(4, 4,
        const bool cfirst = (bx & 1) != 0; const int cq = ((NE * 192 + G - 1) / G + 3) / 4;
        if (cfirst) CONV0(2, 3);
        if (bx < 512) HG_UNIT1(bx);
        if (cfirst) CONV0(3, 4); else CONV0(2, 3);
        for (int u = bx + G; u < 512; u += G) HG_UNIT1(u);
        if (!cfirst) CONV0(3, 4);
        )
#undef CONV0
#undef HG_UNIT0
#undef HG_UNIT1
    SEAM(4);
    layer_tail<0>(args, lds, bar, lo, hi, wave0);
    PHASE(10, 10,
        { pg8::Gemm g{WSP(bf16_t, WS_XB), WSP(bf16_t, WS_WIN1T), 1024, 0}; pg8::StaticOrder S; S.init(T, 2048, G, bx); pg8::EpiQK E{WSP(bf16_t, WS_SA), WSP(bf16_t, WS_SA + 64 * MiB), QSCALE};
          pg8::gemm_phase<pg8::EpiQK, pg8::StaticOrder, 0>(lds, g, S, E, nullptr, rowtab, tid); }
        { pg8::Gemm g{WSP(bf16_t, WS_WIN1T) + (size_t)2048 * 1024, WSP(bf16_t, WS_XB), 1024, 0}; pg8::StaticOrder S; S.init(1024, T, G, bx); pg8::EpiVF E{WSP(bf16_t, WS_SA + 128 * MiB)};
          pg8::gemm_phase<pg8::EpiVF, pg8::StaticOrder, 0>(lds, g, S, E, nullptr, rowtab, tid); })
    SEAM(10);
    PHASE(11, 11,
        const bool cfirst = (bx & 1) != 0;
        if (cfirst) conv_moe_wg(args.in[23], args.in[25], WSP(unsigned char, WS_W1T), WSP(unsigned char, WS_W2T), (LAS float*)lds, bx, G, tid, 0, (NE * 192 + G - 1) / G);
        attn_phase(WSP(bf16_t, WS_SA), WSP(bf16_t, WS_SA + 64 * MiB), WSP(bf16_t, WS_SA + 128 * MiB), WSP(bf16_t, WS_SB), gw, NGW, lane);
        if (!cfirst) conv_moe_wg(args.in[23], args.in[25], WSP(unsigned char, WS_W1T), WSP(unsigned char, WS_W2T), (LAS float*)lds, bx, G, tid, 0, (NE * 192 + G - 1) / G);)
    SEAM(11);
    layer_tail<1>(args, lds, bar, lo, hi, wave0);
}
#undef IN
#undef SEAM

extern "C" void kernel_launch(void* const* d_in, const int* in_sizes, int n_in, void* d_out, int out_size, void* d_ws, size_t ws_size, hipStream_t stream) {
    static int grid = 0;
    if (grid == 0) {
        if (n_in != 29 || in_sizes[0] != T * D || out_size != T * D || ws_size < WS_END) { fprintf(stderr, "kernel_launch: unexpected shapes (n_in %d, in0 %d, out %d, ws %zu)\n", n_in, n_in > 0 ? in_sizes[0] : -1, out_size, ws_size); grid = -1; return; }
        int dev = 0, cus = 0, per_cu = 0;
        if (hipGetDevice(&dev) != hipSuccess || hipDeviceGetAttribute(&cus, hipDeviceAttributeMultiprocessorCount, dev) != hipSuccess) { grid = -1; return; }
        if (hipFuncSetAttribute((const void*)mk_fwd, hipFuncAttributeMaxDynamicSharedMemorySize, LDS_BYTES) != hipSuccess) { fprintf(stderr, "kernel_launch: hipFuncSetAttribute failed\n"); grid = -1; return; }
        if (hipOccupancyMaxActiveBlocksPerMultiprocessor(&per_cu, (const void*)mk_fwd, NWAVES * 64, LDS_BYTES) != hipSuccess || per_cu < 1) { fprintf(stderr, "kernel_launch: occupancy query says %d\n", per_cu); }
        (void)hipGetLastError();
        grid = cus;
    }
    if (grid < 0) return;
    if (hipMemsetAsync((char*)d_ws + WS_CTL, 0, CTL_ZERO_BYTES, stream) != hipSuccess) return;
    Args a{};
    for (int i = 0; i < 29; ++i) a.in[i] = (const float*)d_in[i];
    a.out = (float*)d_out; a.ws = (unsigned char*)d_ws;
#if MK_PER_PHASE
    for (int p = 0; p < NPHASE; ++p) { a.ph_lo = p; a.ph_hi = p + 1; hipLaunchKernelGGL(mk_fwd, dim3(grid), dim3(NWAVES * 64), LDS_BYTES, stream, a); }
#else
    a.ph_lo = 0; a.ph_hi = NPHASE;
    hipLaunchKernelGGL(mk_fwd, dim3(grid), dim3(NWAVES * 64), LDS_BYTES, stream, a);
#endif
}
```

```cpp
#include <hip/hip_runtime.h>
#include <cstdio>
#include <cstdint>

#ifndef MK_PER_PHASE
#define MK_PER_PHASE 0
#endif

#define LAS __attribute__((address_space(3)))
#define GAS __attribute__((address_space(1)))
typedef unsigned short bf16_t;
typedef short bf16x8 __attribute__((ext_vector_type(8)));
typedef short s16x4 __attribute__((ext_vector_type(4)));
typedef float f32x2 __attribute__((ext_vector_type(2)));
typedef float f32x4 __attribute__((ext_vector_type(4)));
typedef float f32x16 __attribute__((ext_vector_type(16)));
typedef unsigned u32x2 __attribute__((ext_vector_type(2)));
typedef unsigned u32x4 __attribute__((ext_vector_type(4)));
typedef __bf16 bf16x2_t __attribute__((ext_vector_type(2)));
typedef int i32x4 __attribute__((ext_vector_type(4)));
typedef int i32x8 __attribute__((ext_vector_type(8)));

constexpr int BATCH = 4, SEQ = 8192, T = BATCH * SEQ, D = 1024;
constexpr int NE = 32;
constexpr float ALPHA = 1.41421356237309515f;
constexpr float LN_EPS = 1e-5f, RMS_EPS = 1e-6f;
constexpr float LOG2E = 1.4426950408889634f;
constexpr float QSCALE = 0.125f * LOG2E;
constexpr float ATT_THR = 7.5231638e-37f;

__device__ __forceinline__ unsigned pk2(float lo, float hi) { f32x2 v = {lo, hi}; bf16x2_t b = __builtin_convertvector(v, bf16x2_t); return __builtin_bit_cast(unsigned, b); }
__device__ __forceinline__ float bflo(unsigned u) { return __uint_as_float(u << 16); }
__device__ __forceinline__ float bfhi(unsigned u) { return __uint_as_float(u & 0xffff0000u); }
__device__ __forceinline__ float bf2f(bf16_t h) { return __uint_as_float(((unsigned)h) << 16); }
__device__ __forceinline__ float clamp448(float x) { return __builtin_amdgcn_fmed3f(x, -448.0f, 448.0f); }
__device__ __forceinline__ unsigned pk4_fp8_nc(float a, float b, float c, float d) { int p = 0; p = __builtin_amdgcn_cvt_pk_fp8_f32(a, b, p, false); p = __builtin_amdgcn_cvt_pk_fp8_f32(c, d, p, true); return (unsigned)p; }
__device__ __forceinline__ unsigned pk4_fp8(float a, float b, float c, float d) { int p = 0; p = __builtin_amdgcn_cvt_pk_fp8_f32(clamp448(a), clamp448(b), p, false); p = __builtin_amdgcn_cvt_pk_fp8_f32(clamp448(c), clamp448(d), p, true); return (unsigned)p; }
__device__ __forceinline__ float fexp2(float x) { return __builtin_amdgcn_exp2f(x); }
__device__ __forceinline__ float flog2(float x) { return __builtin_amdgcn_logf(x); }
__device__ __forceinline__ float frcp(float x) { return __builtin_amdgcn_rcpf(x); }

__device__ __forceinline__ int lane_id_asm() { int l; asm volatile("v_mbcnt_lo_u32_b32 %0, -1, 0\n\tv_mbcnt_hi_u32_b32 %0, -1, %0" : "=v"(l)); return l; }

#define LDPIN16(dst_, p_) asm volatile("global_load_dwordx4 %0, %1, off" : "+v"(dst_) : "v"(p_) : "memory")
#define LDPIN8(dst_, p_)  asm volatile("global_load_dwordx2 %0, %1, off" : "+v"(dst_) : "v"(p_) : "memory")

namespace pg8 {
constexpr int BM = 256, BK = 64, HALF = 128, HTB = HALF * BK * 2, STAGE_BYTES = 8 * HTB, NXCD = 8, WGM = 8;
constexpr int AUX_OFF = STAGE_BYTES + 2048 + 512 + 256;
__host__ __device__ __forceinline__ int lds_byte(int r, int c) { const int st = (r >> 4) * 2 + (c >> 5), rr = r & 15, cc = c & 31, ob = rr * 64 + cc * 2; return st * 1024 + (ob ^ (((ob >> 9) & 1) << 5)); }
__host__ __device__ __forceinline__ void stage_rc(int b, int& R, int& C) { const int st = b / 1024, sb = b % 1024, swz = sb ^ (((sb >> 9) & 1) << 5); R = (st >> 1) * 16 + swz / 64; C = (st & 1) * 32 + (swz % 64) / 2; }
__host__ __device__ __forceinline__ int perm32(int rho) { const int n = rho >> 4, i = rho & 15; return 8 * (i >> 2) + 4 * n + (i & 3); }

struct Unit { int pm, pn, e, mt, valid; };
struct Gemm { const bf16_t* A; const bf16_t* Bt; int K; int brows; };

__device__ __forceinline__ void tile_of(int L, int nM, int nN, int& pm, int& pn) {
    const int nwg = nM * nN;
    int wgid = L; { const int q = nwg / NXCD, r = nwg % NXCD, xcd = wgid % NXCD, off = wgid / NXCD; wgid = (xcd < r ? xcd * (q + 1) : r * (q + 1) + (xcd - r) * q) + off; }
    const int nig = WGM * nN, gid = wgid / nig, fm = gid * WGM, gsz = (nM - fm) < WGM ? (nM - fm) : WGM;
    pm = fm + ((wgid % nig) % gsz); pn = (wgid % nig) / gsz;
}
struct StaticOrder {
    int nM, nN, nwg, G, c;
    __device__ __forceinline__ void init(int M, int N, int G_, int c_) { nM = M / BM; nN = N / BM; nwg = nM * nN; G = G_; c = c_; }
    __device__ __forceinline__ bool next(int i, Unit& u) const {
        const long L = (long)i * G + c; if (L >= nwg) return false;
        tile_of((int)L, nM, nN, u.pm, u.pn); u.e = 0; u.mt = u.pm; u.valid = 256; return true;
    }
};
struct MoeOrder {
    const LAS int* tab; int nM, nN, nwg, G, c;
    __device__ __forceinline__ void init(const LAS int* tab_, int nN_, int G_, int c_) { tab = tab_; nM = tab_[32]; nN = nN_; nwg = nM * nN; G = G_; c = c_; }
    __device__ __forceinline__ bool next(int i, Unit& u) const {
        const long L = (long)i * G + c; if (L >= nwg) return false;
        tile_of((int)L, nM, nN, u.pm, u.pn);
        int e = 0;
#pragma unroll
        for (int j = 1; j < 32; ++j) e += (u.pm >= tab[j]) ? 1 : 0;
        u.e = e; u.mt = u.pm - tab[e]; const int rem = tab[33 + e] - u.mt * 256; u.valid = rem < 256 ? rem : 256; return true;
    }
};

__device__ __forceinline__ unsigned cvt_pk_bf16(float lo, float hi) { return pk2(lo, hi); }

struct EpiPlain {
    static constexpr bool PERM = true; static constexpr int NAUX = 0;
    bf16_t* O; int ldc; int split_cols; size_t split_stride; float scale0;
    __device__ __forceinline__ void operator()(const f32x4 (&acc)[2][2][4][2], const Unit& u, int wr, int wc, int fr, int fq, const LAS float* aux) const {
        asm volatile("" : "+v"(fr), "+v"(fq));
        const int row0 = u.pm * BM + wr * 64 + fr; int colt = u.pn * BM; bf16_t* base = O;
        float sc = 1.f; if (split_cols) { const int t = colt / split_cols; base += (size_t)t * split_stride; colt -= t * split_cols; if (t == 0) sc = scale0; }
        const int col0 = colt + wc * 32 + 8 * fq;
#pragma unroll
        for (int ai = 0; ai < 2; ++ai)
#pragma unroll
            for (int m = 0; m < 4; ++m) { bf16_t* rowp = base + (size_t)(row0 + ai * HALF + m * 16) * ldc + col0;
#pragma unroll
                for (int bj = 0; bj < 2; ++bj) { f32x4 v0 = acc[ai][bj][m][0] * sc, v1 = acc[ai][bj][m][1] * sc;
                    u32x4 w; w.x = cvt_pk_bf16(v0[0], v0[1]); w.y = cvt_pk_bf16(v0[2], v0[3]); w.z = cvt_pk_bf16(v1[0], v1[1]); w.w = cvt_pk_bf16(v1[2], v1[3]);
                    *(u32x4*)(rowp + bj * HALF) = w; } }
    }
};
struct EpiQK {
    static constexpr bool PERM = true; static constexpr int NAUX = 0;
    bf16_t* Q; bf16_t* KF; float scale;
    __device__ __forceinline__ void operator()(const f32x4 (&acc)[2][2][4][2], const Unit& u, int wr, int wc, int fr, int fq, const LAS float* aux) const {
        asm volatile("" : "+v"(fr), "+v"(fq));
        const int row0 = u.pm * BM + wr * 64 + fr; const int colt = u.pn * BM; const bool isk = colt >= 1024;
        const int col0 = (isk ? colt - 1024 : colt) + wc * 32 + 8 * fq;
        const float sc = isk ? 1.f : scale;
#pragma unroll
        for (int ai = 0; ai < 2; ++ai)
#pragma unroll
            for (int m = 0; m < 4; ++m) { const int t = row0 + ai * HALF + m * 16;
#pragma unroll
                for (int bj = 0; bj < 2; ++bj) { const f32x4 v0 = acc[ai][bj][m][0] * sc, v1 = acc[ai][bj][m][1] * sc; const int c = col0 + bj * HALF;
                    u32x4 w; w.x = cvt_pk_bf16(v0[0], v0[1]); w.y = cvt_pk_bf16(v0[2], v0[3]); w.z = cvt_pk_bf16(v1[0], v1[1]); w.w = cvt_pk_bf16(v1[2], v1[3]);
                    bf16_t* p;
                    if (isk) { const int b = t >> 13, tt = t & 8191, h = c >> 6, d8 = (c & 63) >> 3;
                        p = KF + ((((size_t)(b * 16 + h) * 256 + (tt >> 5)) * 4 + (d8 >> 1)) * 64 + (d8 & 1) * 32 + (tt & 31)) * 8; }
                    else p = Q + (size_t)t * 1024 + c;
                    *(u32x4*)p = w; } }
    }
};
struct EpiVF {
    static constexpr bool PERM = true; static constexpr int NAUX = 0;
    bf16_t* VF;
    __device__ __forceinline__ void operator()(const f32x4 (&acc)[2][2][4][2], const Unit& u, int wr, int wc, int fr, int fq, const LAS float* aux) const {
        asm volatile("" : "+v"(fr), "+v"(fq));
        const int row0 = u.pm * BM + wr * 64 + fr; const int col0 = u.pn * BM + wc * 32 + 8 * fq;
#pragma unroll
        for (int ai = 0; ai < 2; ++ai)
#pragma unroll
            for (int m = 0; m < 4; ++m) { const int dg = row0 + ai * HALF + m * 16; const int h = dg >> 6, dd = dg & 63;
#pragma unroll
                for (int bj = 0; bj < 2; ++bj) { const f32x4 v0 = acc[ai][bj][m][0], v1 = acc[ai][bj][m][1]; const int t = col0 + bj * HALF;
                    const int b = t >> 13, tt = t & 8191, t32 = tt & 31;
                    bf16_t* p = VF + (((((size_t)(b * 16 + h) * 256 + (tt >> 5)) * 2 + (dd >> 5)) * 2 + (t32 >> 4)) * 64 + (dd & 31)) * 8 + ((t32 >> 3) & 1) * 4;
                    u32x2 w0, w1; w0.x = cvt_pk_bf16(v0[0], v0[1]); w0.y = cvt_pk_bf16(v0[2], v0[3]); w1.x = cvt_pk_bf16(v1[0], v1[1]); w1.y = cvt_pk_bf16(v1[2], v1[3]);
                    *(u32x2*)p = w0; *(u32x2*)(p + 32 * 8) = w1; } }
    }
};
__device__ __forceinline__ float swiglu1(float xg, float xl) {
    const float g = fminf(xg, 7.0f), l = __builtin_amdgcn_fmed3f(xl, -7.0f, 7.0f);
    const float s = frcp(1.0f + fexp2(-1.702f * LOG2E * g));
    return g * s * (l + 1.0f);
}
struct EpiSwiglu {
    static constexpr bool PERM = true; static constexpr int NAUX = 0;
    bf16_t* O; const float* b1;
    __device__ __forceinline__ void operator()(const f32x4 (&acc)[2][2][4][2], const Unit& u, int wr, int wc, int fr, int fq, const LAS float* aux) const {
        asm volatile("" : "+v"(fr), "+v"(fq));
        const int row0 = u.pm * BM + wr * 64 + fr; const int col0 = u.pn * BM + wc * 32 + 8 * fq;
        const float* bp = b1 + (size_t)u.e * 2048 + col0;
        f32x4 bv[2][2];
#pragma unroll
        for (int bj = 0; bj < 2; ++bj)
#pragma unroll
            for (int n = 0; n < 2; ++n) bv[bj][n] = *(const f32x4*)(bp + bj * HALF + 4 * n);
#pragma unroll
        for (int ai = 0; ai < 2; ++ai)
#pragma unroll
            for (int m = 0; m < 4; ++m) { bf16_t* rowp = O + (size_t)(row0 + ai * HALF + m * 16) * 1024 + (col0 >> 1);
#pragma unroll
                for (int bj = 0; bj < 2; ++bj) { const f32x4 v0 = acc[ai][bj][m][0] + bv[bj][0], v1 = acc[ai][bj][m][1] + bv[bj][1];
                    u32x2 w; w.x = cvt_pk_bf16(swiglu1(v0[0], v0[1]), swiglu1(v0[2], v0[3])); w.y = cvt_pk_bf16(swiglu1(v1[0], v1[1]), swiglu1(v1[2], v1[3]));
                    *(u32x2*)(rowp + bj * (HALF / 2)) = w; } }
    }
};
struct EpiSwiglu8 {
    static constexpr bool PERM = true; static constexpr int NAUX = 1;
    __device__ __forceinline__ const float* aux_src(const Unit& u, int) const { return b1 + (size_t)u.e * 2048 + u.pn * BM; }
    unsigned char* O; const float* b1;
    __device__ __forceinline__ void operator()(const f32x4 (&acc)[2][2][4][2], const Unit& u, int wr, int wc, int fr, int fq, const LAS float* aux) const {
        asm volatile("" : "+v"(fr), "+v"(fq));
        const int row0 = u.pm * BM + wr * 64 + fr; const int col0 = u.pn * BM + wc * 32 + 8 * fq;
        f32x4 bv[2][2];
#pragma unroll
        for (int bj = 0; bj < 2; ++bj)
#pragma unroll
            for (int n = 0; n < 2; ++n) bv[bj][n] = *(const LAS f32x4*)(aux + wc * 32 + 8 * fq + bj * HALF + 4 * n);
#pragma unroll
        for (int ai = 0; ai < 2; ++ai)
#pragma unroll
            for (int m = 0; m < 4; ++m) {
                f32x2 g[4], l[4], t[4];
#pragma unroll
                for (int bj = 0; bj < 2; ++bj)
#pragma unroll
                    for (int n = 0; n < 2; ++n) { const f32x4 v = acc[ai][bj][m][n] + bv[bj][n]; const int o = bj * 2 + n;
                        g[o] = (f32x2){fminf(v[0], 7.0f), fminf(v[2], 7.0f)}; l[o] = (f32x2){__builtin_amdgcn_fmed3f(v[1], -7.0f, 7.0f), __builtin_amdgcn_fmed3f(v[3], -7.0f, 7.0f)} + 1.0f; }
#pragma unroll
                for (int i = 0; i < 4; ++i) { const f32x2 a = g[i] * (-1.702f * LOG2E); t[i] = (f32x2){fexp2(a.x), fexp2(a.y)}; }
                __builtin_amdgcn_sched_barrier(0);
#pragma unroll
                for (int i = 0; i < 4; ++i) { const f32x2 d = t[i] + 1.0f; t[i] = (f32x2){frcp(d.x), frcp(d.y)}; }
                __builtin_amdgcn_sched_barrier(0);
#pragma unroll
                for (int i = 0; i < 4; ++i) t[i] = (g[i] * t[i]) * l[i];
                unsigned char* rowp = O + (size_t)(row0 + ai * HALF + m * 16) * 1024 + (col0 >> 1);
                *(unsigned*)rowp = pk4_fp8_nc(t[0].x, t[0].y, t[1].x, t[1].y); *(unsigned*)(rowp + HALF / 2) = pk4_fp8_nc(t[2].x, t[2].y, t[3].x, t[3].y);
            }
    }
};
struct EpiDown {
    static constexpr bool PERM = true; static constexpr int NAUX = 0;
    bf16_t* O; const float* b2; const float* gatel;
    __device__ __forceinline__ void operator()(const f32x4 (&acc)[2][2][4][2], const Unit& u, int wr, int wc, int fr, int fq, const LAS float* aux) const {
        asm volatile("" : "+v"(fr), "+v"(fq));
        const int rl0 = wr * 64 + fr; const int col0 = u.pn * BM + wc * 32 + 8 * fq;
        const float* bp = b2 + (size_t)u.e * 1024 + col0; const float* gp = gatel + (size_t)u.e * T + u.mt * 256 + rl0;
        f32x4 bv[2][2];
#pragma unroll
        for (int bj = 0; bj < 2; ++bj)
#pragma unroll
            for (int n = 0; n < 2; ++n) bv[bj][n] = *(const f32x4*)(bp + bj * HALF + 4 * n);
#pragma unroll
        for (int ai = 0; ai < 2; ++ai)
#pragma unroll
            for (int m = 0; m < 4; ++m) { const float gt = gp[ai * HALF + m * 16]; bf16_t* rowp = O + (size_t)(u.pm * BM + rl0 + ai * HALF + m * 16) * 1024 + col0;
#pragma unroll
                for (int bj = 0; bj < 2; ++bj) { const f32x4 v0 = (acc[ai][bj][m][0] + bv[bj][0]) * gt, v1 = (acc[ai][bj][m][1] + bv[bj][1]) * gt;
                    u32x4 w; w.x = cvt_pk_bf16(v0[0], v0[1]); w.y = cvt_pk_bf16(v0[2], v0[3]); w.z = cvt_pk_bf16(v1[0], v1[1]); w.w = cvt_pk_bf16(v1[2], v1[3]);
                    *(u32x4*)(rowp + bj * HALF) = w; } }
    }
};

struct EpiDown8 {
    static constexpr bool PERM = true; static constexpr int NAUX = 2;
    __device__ __forceinline__ const float* aux_src(const Unit& u, int k) const { return k == 0 ? b2 + (size_t)u.e * 1024 + u.pn * BM : gatel + (size_t)u.e * T + u.mt * 256; }
    unsigned char* O; const float* b2; const float* gatel;
    __device__ __forceinline__ void operator()(const f32x4 (&acc)[2][2][4][2], const Unit& u, int wr, int wc, int fr, int fq, const LAS float* aux) const {
        asm volatile("" : "+v"(fr), "+v"(fq));
        const int rl0 = wr * 64 + fr; const int col0 = u.pn * BM + wc * 32 + 8 * fq;
        const LAS float* gp = aux + 256 + rl0;
        f32x4 bv[2][2];
#pragma unroll
        for (int bj = 0; bj < 2; ++bj)
#pragma unroll
            for (int n = 0; n < 2; ++n) bv[bj][n] = *(const LAS f32x4*)(aux + wc * 32 + 8 * fq + bj * HALF + 4 * n);
#pragma unroll
        for (int ai = 0; ai < 2; ++ai)
#pragma unroll
            for (int m = 0; m < 4; ++m) { const float gt = gp[ai * HALF + m * 16] * 16.0f; unsigned char* rowp = O + (size_t)(u.pm * BM + rl0 + ai * HALF + m * 16) * 1024 + col0;
#pragma unroll
                for (int bj = 0; bj < 2; ++bj) { const f32x4 v0 = (acc[ai][bj][m][0] + bv[bj][0]) * gt, v1 = (acc[ai][bj][m][1] + bv[bj][1]) * gt;
                    u32x2 w; w.x = pk4_fp8(v0[0], v0[1], v0[2], v0[3]); w.y = pk4_fp8(v1[0], v1[1], v1[2], v1[3]);
                    *(u32x2*)(rowp + bj * HALF) = w; } }
    }
};

template <class Epi, class Sched, int GATHER, int F8 = 0>
__device__ __forceinline__ void gemm_phase(LAS unsigned char* lds, const Gemm g, const Sched& S, const Epi& E, const int* tokl, LAS unsigned* rowtab, const int tid) {
    const int wid = __builtin_amdgcn_readfirstlane(tid >> 6), lane = tid & 63, wr = wid >> 2, wc = wid & 3, fr = lane & 15, fq = lane >> 4;
    const int K = g.K, nt = K / BK;
    unsigned voffA[2], voffB[2];
#pragma unroll
    for (int i = 0; i < 2; ++i) { int R, C; stage_rc(tid * 16 + i * 8192, R, C); const int Rb = Epi::PERM ? ((R & ~31) + perm32(R & 31)) : R;
        voffA[i] = (unsigned)(R * K + C) * 2u; voffB[i] = (unsigned)(Rb * K + C) * 2u; }
    const size_t kstep = (size_t)(BK * 2);
    const size_t hstep = (size_t)HALF * K * 2;
    const size_t tstep = 2 * hstep;
    const unsigned ldsw = (unsigned)wid * 1024u;
    const int aoff = lds_byte(wr * 64 + fr, fq * 8), boff = lds_byte(wc * 32 + fr, fq * 8);
    unsigned vC[2][2];
#define PG8_SA(b, h) (((b) * 2 + (h)) * HTB)
#define PG8_SB(b, h) ((4 + (b) * 2 + (h)) * HTB)
#define PG8_GLDS(gp, bufoff, i_) __builtin_amdgcn_global_load_lds((const unsigned*)(gp), (LAS unsigned*)(lds + (bufoff) + ldsw + (i_) * 8192), 16, 0, 0)
#define PG8_STAGE_B(bufoff, gbase) do { _Pragma("unroll") for (int _i = 0; _i < 2; ++_i) PG8_GLDS((const char*)(gbase) + voffB[_i], bufoff, _i); } while (0)
#define PG8_STAGE_A(bufoff, gbase, h, nx) do { _Pragma("unroll") for (int _i = 0; _i < 2; ++_i) { \
        if constexpr (GATHER) { PG8_GLDS((const char*)(gbase) + vC[h][_i], bufoff, _i); } \
        else PG8_GLDS((const char*)(gbase) + (h) * hstep + voffA[_i], bufoff, _i); } } while (0)
#define PG8_LDA(dst, b, h) do { _Pragma("unroll") for (int m = 0; m < 4; ++m) _Pragma("unroll") for (int k = 0; k < 2; ++k) dst[m][k] = *(const LAS bf16x8*)(lds + PG8_SA(b, h) + aoff + m * 2048 + k * 1024); } while (0)
#define PG8_LDB(dst, b, h) do { _Pragma("unroll") for (int n = 0; n < 2; ++n) _Pragma("unroll") for (int k = 0; k < 2; ++k) dst[n][k] = *(const LAS bf16x8*)(lds + PG8_SB(b, h) + boff + n * 2048 + k * 1024); } while (0)
#define PG8_MMA(ai, bj, At, Bt) do { __builtin_amdgcn_s_setprio(1); _Pragma("unroll") for (int m = 0; m < 4; ++m) _Pragma("unroll") for (int n = 0; n < 2; ++n) { \
        if constexpr (F8 != 0) {   \
            const i32x4 _b0 = __builtin_bit_cast(i32x4, Bt[n][0]), _b1 = __builtin_bit_cast(i32x4, Bt[n][1]), _a0 = __builtin_bit_cast(i32x4, At[m][0]), _a1 = __builtin_bit_cast(i32x4, At[m][1]); \
            const i32x8 _bb = __builtin_shufflevector(_b0, _b1, 0, 1, 2, 3, 4, 5, 6, 7), _aa = __builtin_shufflevector(_a0, _a1, 0, 1, 2, 3, 4, 5, 6, 7); \
            acc[ai][bj][m][n] = __builtin_amdgcn_mfma_scale_f32_16x16x128_f8f6f4(_bb, _aa, acc[ai][bj][m][n], 0, 0, 0, (int)(F8 * 0x01010101u), 0, 0x7f7f7f7f); \
        } else { _Pragma("unroll") for (int k = 0; k < 2; ++k) acc[ai][bj][m][n] = __builtin_amdgcn_mfma_f32_16x16x32_bf16(Bt[n][k], At[m][k], acc[ai][bj][m][n], 0, 0, 0); } } \
        __builtin_amdgcn_s_setprio(0); } while (0)
#define PG8_WAIT_V(n) asm volatile("s_waitcnt vmcnt(" #n ")" ::: "memory")
#define PG8_WAIT_L(n) asm volatile("s_waitcnt lgkmcnt(" #n ")" ::: "memory")
#define PG8_BAR __builtin_amdgcn_s_barrier()
#define PG8_SCHED __builtin_amdgcn_sched_barrier(0)
#define PG8_ROWDMA(u_, slot_) do { if (GATHER == 1 && wid < 4) __builtin_amdgcn_global_load_lds((const unsigned*)(tokl + (size_t)(u_).e * T + (u_).mt * 256 + wid * 64 + lane), (LAS unsigned*)(rowtab + (slot_) * 256 + wid * 64), 4, 0, 0); } while (0)
#define PG8_ROWOFF(dst, u_, slot_) do { _Pragma("unroll") for (int _i = 0; _i < 2; ++_i) { int _R, _C; stage_rc(tid * 16 + _i * 8192, _R, _C); _Pragma("unroll") for (int _h = 0; _h < 2; ++_h) { const int _r = _h * HALF + _R; \
        unsigned _t; if constexpr (GATHER == 1) { _t = rowtab[(slot_) * 256 + _r]; _t = (_r < (u_).valid) ? _t : 0u; } else _t = (unsigned)((u_).pm * 256 + _r); \
        dst[_h][_i] = _t * (unsigned)(K * 2) + (unsigned)_C * 2u; } } } while (0)
    Unit cur, nxt; int ui = 0;
    if (!S.next(0, cur)) return;
    f32x4 acc[2][2][4][2];
#pragma unroll
    for (int a = 0; a < 2; ++a)
#pragma unroll
        for (int b = 0; b < 2; ++b)
#pragma unroll
            for (int m = 0; m < 4; ++m)
#pragma unroll
                for (int n = 0; n < 2; ++n) acc[a][b][m][n] = (f32x4){0.f, 0.f, 0.f, 0.f};
    bf16x8 At[4][2], B0[2][2], B1[2][2];
    const char* cA = GATHER ? (const char*)g.A : (const char*)g.A + (size_t)cur.pm * tstep;
    const char* cB = (const char*)g.Bt + ((size_t)cur.e * g.brows + (size_t)cur.pn * BM) * K * 2;
    if constexpr (GATHER != 0) {
        PG8_ROWDMA(cur, 0); PG8_WAIT_V(0); __syncthreads();
        PG8_ROWOFF(vC, cur, 0);
        PG8_WAIT_L(0);
    }
    PG8_STAGE_B(PG8_SB(0, 0), cB); PG8_STAGE_B(PG8_SB(0, 1), cB + hstep); PG8_STAGE_A(PG8_SA(0, 0), cA, 0, false); PG8_STAGE_A(PG8_SA(0, 1), cA, 1, false);
    if (wr == 1) PG8_BAR;
    PG8_WAIT_V(2); PG8_BAR;
    PG8_STAGE_B(PG8_SB(1, 0), cB + kstep); PG8_STAGE_A(PG8_SA(1, 0), cA + kstep, 0, false); PG8_STAGE_B(PG8_SB(1, 1), cB + hstep + kstep);
    PG8_WAIT_V(6); PG8_BAR;
    for (;;) {
        if constexpr (Epi::NAUX > 0) { if (wid < Epi::NAUX) __builtin_amdgcn_global_load_lds((const unsigned*)(E.aux_src(cur, wid) + lane * 4), (LAS unsigned*)(lds + AUX_OFF + (ui & 1) * 2048 + wid * 1024), 16, 0, 0); }
        const bool has_next = S.next(ui + 1, nxt);
        if constexpr (GATHER) { if (has_next) PG8_ROWDMA(nxt, (ui + 1) & 1); }
        const char* nA = has_next ? (GATHER ? (const char*)g.A : (const char*)g.A + (size_t)nxt.pm * tstep) : cA;
        const char* nB = has_next ? (const char*)g.Bt + ((size_t)nxt.e * g.brows + (size_t)nxt.pn * BM) * K * 2 : cB;
#pragma unroll 1
        for (int t = 0; t < nt; t += 2) {
            const bool last = (t == nt - 2);
            const char* a1 = cA + (size_t)(t + 1) * kstep;
            const char* a2 = last ? nA : cA + (size_t)(t + 2) * kstep; const char* b2 = last ? nB : cB + (size_t)(t + 2) * kstep;
            const char* a3 = a2 + kstep; const char* b3 = b2 + kstep;
            PG8_LDB(B0, 0, 0); PG8_LDB(B1, 0, 1); PG8_SCHED; PG8_LDA(At, 0, 0); PG8_STAGE_A(PG8_SA(1, 1), a1, 1, false);
            if constexpr (GATHER) { if (last && has_next) { PG8_ROWOFF(vC, nxt, (ui + 1) & 1); } }
            PG8_WAIT_V(8); PG8_WAIT_L(0); PG8_BAR; PG8_MMA(0, 0, At, B0); PG8_MMA(0, 1, At, B1); PG8_BAR; PG8_SCHED;
            PG8_LDA(At, 0, 1); PG8_STAGE_B(PG8_SB(0, 0), b2); PG8_STAGE_B(PG8_SB(0, 1), b2 + hstep); PG8_STAGE_A(PG8_SA(0, 0), a2, 0, last);
            PG8_WAIT_V(8); PG8_WAIT_L(0); PG8_BAR; PG8_MMA(1, 0, At, B0); PG8_MMA(1, 1, At, B1); PG8_BAR; PG8_SCHED;
            PG8_LDB(B0, 1, 0); PG8_LDB(B1, 1, 1); PG8_SCHED; PG8_LDA(At, 1, 0); PG8_STAGE_A(PG8_SA(0, 1), a2, 1, last);
            PG8_WAIT_V(8); PG8_WAIT_L(0); PG8_BAR; PG8_MMA(0, 0, At, B0); PG8_MMA(0, 1, At, B1); PG8_BAR; PG8_SCHED;
            PG8_LDA(At, 1, 1); PG8_STAGE_B(PG8_SB(1, 0), b3); PG8_STAGE_B(PG8_SB(1, 1), b3 + hstep); PG8_STAGE_A(PG8_SA(1, 0), a3, 0, last);
            PG8_WAIT_V(8); PG8_WAIT_L(0); PG8_BAR; PG8_MMA(1, 0, At, B0); PG8_MMA(1, 1, At, B1); PG8_BAR; PG8_SCHED;
        }
        if (wr == 0) PG8_BAR;
        E(acc, cur, wr, wc, fr, fq, (const LAS float*)(lds + AUX_OFF + (ui & 1) * 2048));
#if defined(PROBE_EPI2)
        E(acc, cur, wr, wc, fr, fq, (const LAS float*)(lds + AUX_OFF + (ui & 1) * 2048));
#endif
        if (!has_next) break;
#pragma unroll
        for (int a = 0; a < 2; ++a)
#pragma unroll
            for (int b = 0; b < 2; ++b)
#pragma unroll
                for (int m = 0; m < 4; ++m)
#pragma unroll
                    for (int n = 0; n < 2; ++n) acc[a][b][m][n] = (f32x4){0.f, 0.f, 0.f, 0.f};
        cur = nxt; cA = nA; cB = nB; ++ui;
        if (wr == 1) PG8_BAR;
    }
    PG8_WAIT_V(0);
    PG8_BAR;
#undef PG8_SA
#undef PG8_SB
#undef PG8_GLDS
#undef PG8_STAGE_A
#undef PG8_STAGE_B
#undef PG8_LDA
#undef PG8_LDB
#undef PG8_MMA
#undef PG8_WAIT_V
#undef PG8_WAIT_L
#undef PG8_BAR
#undef PG8_SCHED
#undef PG8_ROWDMA
#undef PG8_ROWOFF
}
}

constexpr size_t MiB = 1u << 20;
constexpr size_t WS_CTL = 0, CTL_ZERO_BYTES = 128 * 1024;
constexpr size_t WS_TOKL = 1 * MiB, WS_GATEL = 5 * MiB, WS_TINFO = 9 * MiB;
constexpr size_t WS_WIN0T = 10 * MiB, WS_WO0T = 15 * MiB, WS_WIN1T = 17 * MiB, WS_WO1T = 23 * MiB;
constexpr size_t WS_W1T = 26 * MiB, WS_W2T = 154 * MiB, WS_XB = 218 * MiB;
constexpr size_t WS_SA = 282 * MiB, WS_SB = 554 * MiB, WS_XB8 = 826 * MiB, WS_END = 858 * MiB;
constexpr int CW_BAR = 4096, CW_CNT = 16384;

constexpr int RING_BYTES = 131072;
constexpr int ROWTAB_OFF = RING_BYTES;
constexpr int MOETAB_OFF = ROWTAB_OFF + 2048;
constexpr int MISC_OFF = MOETAB_OFF + 512;
constexpr int LDS_BYTES = 147456;
static_assert(pg8::AUX_OFF == MISC_OFF + 256 && pg8::AUX_OFF + 4096 <= LDS_BYTES, "LDS map");

#define XB_TMO      128
#define XB_XCNT(j)  (256  + 64 * (j))
#define XB_XSUB(j)  (1280 + 64 * (j))
#define XB_XGEN(j)  (2304 + 64 * (j))
#define XB_TOP      3328
#define XB_TOPGEN   3392
#define XCD_BAR_WORDS 3456
#define XB_SPIN_CAP (1u << 20)
__device__ __forceinline__ unsigned xb_ld(unsigned* p)              { return __hip_atomic_load(p, __ATOMIC_RELAXED, __HIP_MEMORY_SCOPE_AGENT); }
__device__ __forceinline__ unsigned xb_add(unsigned* p, unsigned v) { return __hip_atomic_fetch_add(p, v, __ATOMIC_RELAXED, __HIP_MEMORY_SCOPE_AGENT); }
__device__ __forceinline__ unsigned xb_xcc_id() { return (unsigned)__builtin_amdgcn_s_getreg((3 << 11) | 20) & 0xFu; }
#define XB_SPIN(cond, bar) do { unsigned _sp = 0; while (cond) { __builtin_amdgcn_s_sleep(1); \
    if ((++_sp & 255u) == 0u) { if (xb_ld(&(bar)[XB_TMO])) break; if (_sp > XB_SPIN_CAP) { atomicAdd(&(bar)[XB_TMO], 1u); break; } } } } while (0)
struct XcdBarrier { unsigned* bar; unsigned x; volatile LAS unsigned* st; int wave; };
__device__ __forceinline__ XcdBarrier xcd_barrier_post(unsigned* bar, volatile LAS unsigned* st) {
    XcdBarrier b; b.bar = bar; b.x = xb_xcc_id(); b.st = st; b.wave = __builtin_amdgcn_readfirstlane(threadIdx.x >> 6);
    if (threadIdx.x == 0) (void)xb_add(&bar[XB_XCNT(b.x)], 1u);
    return b;
}
__device__ __forceinline__ void xcd_barrier_complete(unsigned* bar, unsigned x, unsigned& nloc, unsigned& nx) {
    const unsigned G = gridDim.x * gridDim.y * gridDim.z;
    unsigned sum, cnt, mine, sp = 0u;
    for (;;) {
        sum = 0u; cnt = 0u; mine = 0u;
#pragma unroll
        for (unsigned j = 0; j < 16; ++j) { const unsigned c = xb_ld(&bar[XB_XCNT(j)]); sum += c; cnt += (c > 0u) ? 1u : 0u; mine = (j == x) ? c : mine; }
        if (sum == G) break;
        __builtin_amdgcn_s_sleep(1);
        if ((++sp & 255u) == 0u) { if (xb_ld(&bar[XB_TMO])) break; if (sp > XB_SPIN_CAP) { atomicAdd(&bar[XB_TMO], 1u); break; } }
    }
    nloc = mine > 0u ? mine : 1u; nx = cnt > 0u ? cnt : 1u;
}
__device__ __forceinline__ void xcd_barrier(const XcdBarrier& b) {
    asm volatile("s_waitcnt vmcnt(0)" ::: "memory");
    __syncthreads();
    if (b.wave == 0 && lane_id_asm() == 0) {
        unsigned* bar = b.bar;
        __builtin_amdgcn_s_waitcnt(0);
        unsigned nloc = b.st[0], nx = b.st[1];
        if (nloc == 0u) { xcd_barrier_complete(bar, b.x, nloc, nx); b.st[0] = nloc; b.st[1] = nx; }
        const unsigned old = xb_add(&bar[XB_XSUB(b.x)], 1u);
        const unsigned gen = old / nloc;
        if (old + 1u == (gen + 1u) * nloc) {
            __builtin_amdgcn_fence(__ATOMIC_RELEASE, "agent");
            asm volatile("s_waitcnt vmcnt(0)" ::: "memory");
            const unsigned og = xb_add(&bar[XB_TOP], 1u);
            const unsigned tg = og / nx;
            if (og + 1u == (tg + 1u) * nx) xb_add(&bar[XB_TOPGEN], 1u);
            else XB_SPIN(xb_ld(&bar[XB_TOPGEN]) == tg, bar);
            __builtin_amdgcn_fence(__ATOMIC_ACQUIRE, "agent");
            xb_add(&bar[XB_XGEN(b.x)], 1u);
            asm volatile("s_waitcnt vmcnt(0)" ::: "memory");
        } else {
            XB_SPIN(xb_ld(&bar[XB_XGEN(b.x)]) == gen, bar);
            __builtin_amdgcn_fence(__ATOMIC_ACQUIRE, "agent");
            asm volatile("s_waitcnt vmcnt(0)" ::: "memory");
        }
    }
    __syncthreads();
}

#define LDS_WAIT() asm volatile("s_waitcnt lgkmcnt(0)" ::: "memory")
#define LDS_BARRIER() do { asm volatile("s_waitcnt lgkmcnt(0)" ::: "memory"); __builtin_amdgcn_s_barrier(); asm volatile("" ::: "memory"); } while (0)
__device__ __forceinline__ float wave_sum(float v) {
#pragma unroll
    for (int o = 1; o < 64; o <<= 1) v += __shfl_xor(v, o);
    return v;
}
__device__ __forceinline__ void transpose_item(const float* W, int ldw, bf16_t* WT, int ldt, int k0, int n0, int dst_row0, LAS float* scr, int lane, int rstride = 1) {
#pragma unroll 8
    for (int i = 0; i < 32; ++i) { const int kk = 2 * i + (lane >> 5); scr[kk * 33 + (lane & 31)] = W[(size_t)(k0 + kk) * ldw + n0 + (lane & 31)]; }
    LDS_WAIT(); asm volatile("" ::: "memory");
    const int c = lane & 7;
#pragma unroll
    for (int j = 0; j < 4; ++j) { const int n = (lane >> 3) + 8 * j; const LAS float* s = scr + (8 * c) * 33 + n;
        u32x4 o; o.x = pk2(s[0 * 33], s[1 * 33]); o.y = pk2(s[2 * 33], s[3 * 33]); o.z = pk2(s[4 * 33], s[5 * 33]); o.w = pk2(s[6 * 33], s[7 * 33]);
        *(u32x4*)(WT + (size_t)(dst_row0 + n * rstride) * ldt + k0 + 8 * c) = o; }
    LDS_WAIT(); asm volatile("" ::: "memory");
}
constexpr int W1_SH = 6, W2_SH = 7;
__device__ __forceinline__ void conv_moe_wg(const float* w1, const float* w2, unsigned char* W1T, unsigned char* W2T, LAS float* buf, int bx, int G, int tid, int j0, int j1) {
    constexpr int I1 = 8 * 16, I2 = 8 * 8, NIT = NE * (I1 + I2);
    const int lrow = tid >> 5, lcol = (tid & 31) * 4;
    f32x4 ra[8], rb[8];
#define CM_SRC(it_, src_, ldw_) const float* src_; int ldw_; { if ((it_) < NE * I1) { const int e_ = (it_) >> 7, q_ = (it_) & 127, kb_ = q_ >> 4, nb_ = q_ & 15; ldw_ = 2048; src_ = w1 + (size_t)e_ * 1024 * 2048 + (size_t)(128 * kb_) * 2048 + 128 * nb_; } \
        else { const int j_ = (it_) - NE * I1, e_ = j_ >> 6, q_ = j_ & 63, kb_ = q_ >> 3, nb_ = q_ & 7; ldw_ = 1024; src_ = w2 + (size_t)e_ * 1024 * 1024 + (size_t)(128 * kb_) * 1024 + 128 * nb_; } }
#define CM_LOAD(R_, it_) do { CM_SRC(it_, sp_, lw_); _Pragma("unroll") for (int i = 0; i < 8; ++i) R_[i] = __builtin_nontemporal_load((const f32x4*)(sp_ + (size_t)(lrow + 16 * i) * lw_ + lcol)); } while (0)
#define CM_ITEM(R_, it_) do { \
        _Pragma("unroll") for (int i = 0; i < 8; ++i) *(LAS f32x4*)(buf + (lrow + 16 * i) * 132 + (lcol ^ (8 * (i & 3)))) = R_[i];     \
        __syncthreads(); \
        if ((it_) + 2 * G < itend) CM_LOAD(R_, (it_) + 2 * G); \
        unsigned char* dst; float sc; \
        if ((it_) < NE * I1) { const int e = (it_) >> 7, q = (it_) & 127, kb = q >> 4, nb = q & 15; dst = W1T + (size_t)e * 2048 * 1024 + (size_t)(128 * nb) * 1024 + 128 * kb; sc = (float)(1 << W1_SH); } \
        else { const int j = (it_) - NE * I1, e = j >> 6, q = j & 63, kb = q >> 3, nb = q & 7; dst = W2T + (size_t)e * 1024 * 1024 + (size_t)(128 * nb) * 1024 + 128 * kb; sc = (float)(1 << W2_SH); } \
        const int c = tid & 7; \
        _Pragma("unroll") for (int p = 0; p < 2; ++p) { const int nn = (tid >> 3) + 64 * p; const LAS float* sp = buf + (16 * c) * 132 + (nn ^ (8 * (c & 3))); \
            u32x4 o; \
            o.x = pk4_fp8(sp[0 * 132] * sc, sp[1 * 132] * sc, sp[2 * 132] * sc, sp[3 * 132] * sc); o.y = pk4_fp8(sp[4 * 132] * sc, sp[5 * 132] * sc, sp[6 * 132] * sc, sp[7 * 132] * sc); \
            o.z = pk4_fp8(sp[8 * 132] * sc, sp[9 * 132] * sc, sp[10 * 132] * sc, sp[11 * 132] * sc); o.w = pk4_fp8(sp[12 * 132] * sc, sp[13 * 132] * sc, sp[14 * 132] * sc, sp[15 * 132] * sc); \
            *(u32x4*)(dst + (size_t)nn * 1024 + 16 * c) = o; } \
        __syncthreads(); } while (0)
    int it = bx + j0 * G; const int itend = (bx + j1 * G) < NIT ? (bx + j1 * G) : NIT;
    __syncthreads();
    if (it < itend) CM_LOAD(ra, it);
    if (it + G < itend) CM_LOAD(rb, it + G);
    for (; it < itend; it += 2 * G) {
        CM_ITEM(ra, it);
        if (it + G < itend) CM_ITEM(rb, it + G);
    }
#undef CM_ITEM
#undef CM_SRC
#undef CM_LOAD
}
__device__ __forceinline__ void ln_row(f32x4 (&v)[4], const float* w, const float* b, int lane) {
    float s = 0.f;
#pragma unroll
    for (int j = 0; j < 4; ++j) s += (v[j].x + v[j].y) + (v[j].z + v[j].w);
    const float mean = wave_sum(s) * (1.f / D); float s2 = 0.f;
#pragma unroll
    for (int j = 0; j < 4; ++j) { v[j] = v[j] - mean; s2 += (v[j].x * v[j].x + v[j].y * v[j].y) + (v[j].z * v[j].z + v[j].w * v[j].w); }
    const float rstd = 1.f / sqrtf(wave_sum(s2) * (1.f / D) + LN_EPS);
#pragma unroll
    for (int j = 0; j < 4; ++j) { const f32x4 ww = *(const f32x4*)(w + 4 * lane + 256 * j), bb = *(const f32x4*)(b + 4 * lane + 256 * j); v[j] = v[j] * rstd * ww + bb; }
}
__device__ __forceinline__ void moe_table(const unsigned* cnt, LAS int* tab, int tid) {
    if (tid < 32) tab[33 + tid] = (int)__hip_atomic_load(cnt + tid, __ATOMIC_RELAXED, __HIP_MEMORY_SCOPE_AGENT);
    __syncthreads();
    if (tid == 0) { int p = 0; for (int e = 0; e < 32; ++e) { tab[e] = p; p += (tab[33 + e] + 255) >> 8; } tab[32] = p; }
    __syncthreads();
}

constexpr int HG_KUT = 0, HG_DD = 18432, HG_QH = 20480, HG_KD = 37888, HG_OB = 55296, HG_RED = 89088;
template <int MODE>
__device__ __forceinline__ void hgrn_unit(LAS unsigned char* lds, int unit, const bf16_t* PROJ, const bf16_t* IT, float* SLOC, float* DTOT, const float* lbl, const float* anw, bf16_t* AO, int tid, int wave, int lane) {
    const int bh = unit >> 5, sc = unit & 31, b = bh >> 2, h = bh & 3;
    const int t0 = sc * 256;
    const int si = tid >> 7, dk = tid & 127;
    const int g = lane >> 4, c16 = lane & 15;
    float lb;
    { const float l0 = lbl[h * 128 + dk], l1 = lbl[512 + h * 128 + dk], l2 = lbl[1024 + h * 128 + dk]; const float m = fmaxf(l0, fmaxf(l1, l2));
      const float e0 = __expf(l0 - m), e1 = __expf(l1 - m), e2 = __expf(l2 - m); lb = e0 / (e0 + e1 + e2); }
    const float oml = 1.0f - lb;
    f32x4 S[8];
#pragma unroll
    for (int tau = 0; tau < 8; ++tau) {
        if (MODE == 1) {
#pragma unroll
            for (int r = 0; r < 4; ++r) S[tau][r] = SLOC[(size_t)unit * 16384 + (16 * tau + 4 * g + r) * 128 + 16 * wave + c16];
        } else S[tau] = (f32x4){0.f, 0.f, 0.f, 0.f};
    }
    float lsum = 1.f;
    unsigned qz[16]; u32x2 vfn[4];
    const unsigned rlo = (unsigned)(16 * si * 2048 + 2 * dk);
    { const bf16_t* sb = PROJ + ((size_t)b * SEQ + t0) * 2048 + h * 256;
#pragma unroll
      for (int j = 0; j < 16; ++j) qz[j] = *(const unsigned*)(sb + (size_t)j * 2048 + rlo);
      const bf16_t* vp = IT + (size_t)(h * 128 + 16 * wave + c16) * T + (size_t)b * SEQ + t0 + 4 * g;
#pragma unroll
      for (int i = 0; i < 4; ++i) vfn[i] = *(const u32x2*)(vp + 16 * i); }
#pragma unroll 1
    for (int c4 = 0; c4 < 4; ++c4) {
        const int tc = t0 + 64 * c4;
        u32x2 vf[4];
#pragma unroll
        for (int i = 0; i < 4; ++i) vf[i] = vfn[i];
        {
            float cp = 1.f, kdf[16];
#pragma unroll
            for (int j = 0; j < 16; ++j) {
                const float z = bfhi(qz[j]);
                const float s = frcp(1.0f + fexp2(-LOG2E * z));
                const float f = lb + oml * s, kk = oml * (1.0f - s);
                cp *= f; kdf[j] = kk * frcp(cp);
                if (MODE == 1) {
                    const float q = bflo(qz[j]);
                    const unsigned qh = pk2(q * cp, 0.f), kd = pk2(kdf[j], 0.f);
                    *(LAS bf16_t*)(lds + HG_QH + (16 * si + j) * 272 + dk * 2) = (bf16_t)(qh & 0xffffu);
                    *(LAS bf16_t*)(lds + HG_KD + (16 * si + j) * 272 + dk * 2) = (bf16_t)(kd & 0xffffu);
                }
            }
            if (c4 < 3) {
                const bf16_t* sb = PROJ + ((size_t)b * SEQ + tc + 64) * 2048 + h * 256;
#pragma unroll
                for (int j = 0; j < 16; ++j) qz[j] = *(const unsigned*)(sb + (size_t)j * 2048 + rlo);
                const bf16_t* vp = IT + (size_t)(h * 128 + 16 * wave + c16) * T + (size_t)b * SEQ + tc + 64 + 4 * g;
#pragma unroll
                for (int i = 0; i < 4; ++i) vfn[i] = *(const u32x2*)(vp + 16 * i);
            }
            const float dl = cp; lsum *= dl;
            u32x4 w0, w1;
            w0.x = pk2(kdf[0] * dl, kdf[1] * dl); w0.y = pk2(kdf[2] * dl, kdf[3] * dl); w0.z = pk2(kdf[4] * dl, kdf[5] * dl); w0.w = pk2(kdf[6] * dl, kdf[7] * dl);
            w1.x = pk2(kdf[8] * dl, kdf[9] * dl); w1.y = pk2(kdf[10] * dl, kdf[11] * dl); w1.z = pk2(kdf[12] * dl, kdf[13] * dl); w1.w = pk2(kdf[14] * dl, kdf[15] * dl);
            *(LAS u32x4*)(lds + HG_KUT + dk * 144 + si * 32) = w0;
            *(LAS u32x4*)(lds + HG_KUT + dk * 144 + si * 32 + 16) = w1;
            *(LAS float*)(lds + HG_DD + (si * 128 + dk) * 4) = dl;
        }
        LDS_BARRIER();
#pragma unroll
        for (int i = 0; i < 4; ++i) {
            bf16x8 vb; { const s16x4 t4 = __builtin_bit_cast(s16x4, vf[i]); vb = (bf16x8){t4[0], t4[1], t4[2], t4[3], 0, 0, 0, 0}; }
            if (MODE == 1) {
                f32x4 X = (f32x4){0.f, 0.f, 0.f, 0.f};
#pragma unroll
                for (int m = 0; m < 4; ++m) {
                    const bf16x8 a = *(const LAS bf16x8*)(lds + HG_KD + (16 * i + c16) * 272 + (32 * m + 8 * g) * 2);
                    const bf16x8 bq = *(const LAS bf16x8*)(lds + HG_QH + (16 * i + c16) * 272 + (32 * m + 8 * g) * 2);
                    X = __builtin_amdgcn_mfma_f32_16x16x32_bf16(a, bq, X, 0, 0, 0);
                }
#pragma unroll
                for (int r = 0; r < 4; ++r) X[r] = (4 * g + r <= c16) ? X[r] : 0.f;
                bf16x8 xa; { u32x2 p; p.x = pk2(X[0], X[1]); p.y = pk2(X[2], X[3]); const s16x4 t4 = __builtin_bit_cast(s16x4, p); xa = (bf16x8){t4[0], t4[1], t4[2], t4[3], 0, 0, 0, 0}; }
                f32x4 O = (f32x4){0.f, 0.f, 0.f, 0.f};
                O = __builtin_amdgcn_mfma_f32_16x16x32_bf16(xa, vb, O, 0, 0, 0);
#pragma unroll
                for (int m = 0; m < 4; ++m) {
                    u32x4 bs; bs.x = pk2(S[2 * m][0], S[2 * m][1]); bs.y = pk2(S[2 * m][2], S[2 * m][3]); bs.z = pk2(S[2 * m + 1][0], S[2 * m + 1][1]); bs.w = pk2(S[2 * m + 1][2], S[2 * m + 1][3]);
                    const u32x2 q0 = *(const LAS u32x2*)(lds + HG_QH + (16 * i + c16) * 272 + (32 * m + 4 * g) * 2);
                    const u32x2 q1 = *(const LAS u32x2*)(lds + HG_QH + (16 * i + c16) * 272 + (32 * m + 16 + 4 * g) * 2);
                    u32x4 aq; aq.x = q0.x; aq.y = q0.y; aq.z = q1.x; aq.w = q1.y;
                    O = __builtin_amdgcn_mfma_f32_16x16x32_bf16(__builtin_bit_cast(bf16x8, aq), __builtin_bit_cast(bf16x8, bs), O, 0, 0, 0);
                }
#pragma unroll
                for (int r = 0; r < 4; ++r) *(LAS float*)(lds + HG_OB + ((16 * i + 4 * g + r) * 132 + 16 * wave + c16) * 4) = O[r];
            }
#pragma unroll
            for (int tau = 0; tau < 8; ++tau) {
                const f32x4 dd = *(const LAS f32x4*)(lds + HG_DD + (i * 128 + 16 * tau + 4 * g) * 4);
                S[tau] = S[tau] * dd;
                const u32x2 k2 = *(const LAS u32x2*)(lds + HG_KUT + (16 * tau + c16) * 144 + (16 * i + 4 * g) * 2);
                u32x4 ak; ak.x = k2.x; ak.y = k2.y; ak.z = 0u; ak.w = 0u;
                S[tau] = __builtin_amdgcn_mfma_f32_16x16x32_bf16(__builtin_bit_cast(bf16x8, ak), vb, S[tau], 0, 0, 0);
            }
        }
        LDS_BARRIER();
        if (MODE == 1) {
            const int tl = tid >> 3, part = tid & 7;
            float o[16]; float ssq = 0.f;
#pragma unroll
            for (int q4 = 0; q4 < 4; ++q4) { const f32x4 v = *(const LAS f32x4*)(lds + HG_OB + (tl * 132 + 16 * part + 4 * q4) * 4);
                o[4 * q4] = v.x; o[4 * q4 + 1] = v.y; o[4 * q4 + 2] = v.z; o[4 * q4 + 3] = v.w; ssq += (v.x * v.x + v.y * v.y) + (v.z * v.z + v.w * v.w); }
            ssq += __shfl_xor(ssq, 1); ssq += __shfl_xor(ssq, 2); ssq += __shfl_xor(ssq, 4);
            const float rr = 1.0f / sqrtf(ssq * (1.0f / 128.0f) + RMS_EPS);
            const size_t row = (size_t)b * SEQ + tc + tl;
            const u32x4 g0 = *(const u32x4*)(PROJ + row * 2048 + 1024 + h * 128 + 16 * part), g1 = *(const u32x4*)(PROJ + row * 2048 + 1024 + h * 128 + 16 * part + 8);
            float gv[16];
            gv[0] = bflo(g0.x); gv[1] = bfhi(g0.x); gv[2] = bflo(g0.y); gv[3] = bfhi(g0.y); gv[4] = bflo(g0.z); gv[5] = bfhi(g0.z); gv[6] = bflo(g0.w); gv[7] = bfhi(g0.w);
            gv[8] = bflo(g1.x); gv[9] = bfhi(g1.x); gv[10] = bflo(g1.y); gv[11] = bfhi(g1.y); gv[12] = bflo(g1.z); gv[13] = bfhi(g1.z); gv[14] = bflo(g1.w); gv[15] = bfhi(g1.w);
            float r16[16];
#pragma unroll
            for (int j = 0; j < 16; ++j) { const float gg = gv[j]; const float sg = gg * frcp(1.0f + fexp2(-LOG2E * gg)); r16[j] = o[j] * rr * anw[16 * part + j] * sg; }
            u32x4 o0, o1;
            o0.x = pk2(r16[0], r16[1]); o0.y = pk2(r16[2], r16[3]); o0.z = pk2(r16[4], r16[5]); o0.w = pk2(r16[6], r16[7]);
            o1.x = pk2(r16[8], r16[9]); o1.y = pk2(r16[10], r16[11]); o1.z = pk2(r16[12], r16[13]); o1.w = pk2(r16[14], r16[15]);
            *(u32x4*)(AO + row * 1024 + h * 128 + 16 * part) = o0; *(u32x4*)(AO + row * 1024 + h * 128 + 16 * part + 8) = o1;
        }
    }
    if (MODE == 0) {
#pragma unroll
        for (int tau = 0; tau < 8; ++tau)
#pragma unroll
            for (int r = 0; r < 4; ++r) SLOC[(size_t)unit * 16384 + (16 * tau + 4 * g + r) * 128 + 16 * wave + c16] = S[tau][r];
        *(LAS float*)(lds + HG_RED + (si * 128 + dk) * 4) = lsum;
        __syncthreads();
        if (tid < 128) { const float tot = (*(LAS float*)(lds + HG_RED + tid * 4) * *(LAS float*)(lds + HG_RED + (128 + tid) * 4)) * (*(LAS float*)(lds + HG_RED + (256 + tid) * 4) * *(LAS float*)(lds + HG_RED + (384 + tid) * 4));
            DTOT[(size_t)unit * 128 + tid] = tot; }
    }
    __syncthreads();
}

template <int W>
__device__ __forceinline__ void pool_lane(int b, int tb, int ch, const bf16_t* PROJ, bf16_t* AO) {
    const bf16_t* xp = PROJ + (size_t)b * SEQ * 2048 + 1536 + ch;
    u32x4 cur[8], prev[W - 1];
#pragma unroll
    for (int j = 0; j < 8; ++j) cur[j] = *(const u32x4*)(xp + (size_t)(tb + j) * 2048);
#pragma unroll
    for (int r = 1; r < W; ++r) { prev[r - 1] = (u32x4){0u, 0u, 0u, 0u}; if (tb - r >= 0) prev[r - 1] = *(const u32x4*)(xp + (size_t)(tb - r) * 2048); }
#define POOL_ACC(op_, v_) do { s[0] op_ bflo((v_).x); s[1] op_ bfhi((v_).x); s[2] op_ bflo((v_).y); s[3] op_ bfhi((v_).y); s[4] op_ bflo((v_).z); s[5] op_ bfhi((v_).z); s[6] op_ bflo((v_).w); s[7] op_ bfhi((v_).w); } while (0)
    float s[8];
#pragma unroll
    for (int c = 0; c < 8; ++c) s[c] = 0.f;
#pragma unroll
    for (int r = 1; r < W; ++r) POOL_ACC(+=, prev[r - 1]);
#pragma unroll
    for (int j = 0; j < 8; ++j) {
        const int t = tb + j; const u32x4 v = cur[j];
        float x[8]; x[0] = bflo(v.x); x[1] = bfhi(v.x); x[2] = bflo(v.y); x[3] = bfhi(v.y); x[4] = bflo(v.z); x[5] = bfhi(v.z); x[6] = bflo(v.w); x[7] = bfhi(v.w);
        const float cnt = (float)((t + 1) < W ? (t + 1) : W);
        float o[8];
#pragma unroll
        for (int c = 0; c < 8; ++c) { s[c] += x[c]; o[c] = s[c] / cnt - x[c]; }
        u32x4 w; w.x = pk2(o[0], o[1]); w.y = pk2(o[2], o[3]); w.z = pk2(o[4], o[5]); w.w = pk2(o[6], o[7]);
        *(u32x4*)(AO + ((size_t)b * SEQ + t) * 1024 + 512 + ch) = w;
        if (j - W + 1 >= 0) POOL_ACC(-=, cur[j - W + 1 >= 0 ? j - W + 1 : 0]); else POOL_ACC(-=, prev[W - 2 - j >= 0 ? W - 2 - j : 0]);
    }
#undef POOL_ACC
}
__device__ __forceinline__ void pool_task(int task, const bf16_t* PROJ, bf16_t* AO, int wave, int lane) {
    const int b = task >> 6, blk = task & 63;
    const int grp = wave & 3, ch = grp * 128 + (lane & 15) * 8;
#pragma unroll 1
    for (int p = 0; p < 2; ++p) { const int tb = blk * 128 + (wave >> 2) * 64 + p * 32 + (lane >> 4) * 8;
        if (grp == 0) pool_lane<2>(b, tb, ch, PROJ, AO); else if (grp == 1) pool_lane<4>(b, tb, ch, PROJ, AO); else if (grp == 2) pool_lane<8>(b, tb, ch, PROJ, AO); else pool_lane<16>(b, tb, ch, PROJ, AO); }
}

constexpr int RT_YS = 1028;
constexpr int RT_Y = 0, RT_PART = 66048, RT_LOG = 82432, RT_SELE = 99328, RT_SELG = 101376, RT_SELR = 103424, RT_HIST = 105472, RT_BASE = 105600, RT_LNW = 105728;
__device__ __forceinline__ void wave_sum4(float& a, float& b, float& c, float& d) {
#pragma unroll
    for (int o = 1; o < 64; o <<= 1) { const float ta = __shfl_xor(a, o), tb = __shfl_xor(b, o), tc = __shfl_xor(c, o), td = __shfl_xor(d, o); a += ta; b += tb; c += tc; d += td; }
}
__device__ __forceinline__ void split_hl(const float (&x)[8], u32x4& hi, u32x4& lo) {
    unsigned h[4], l[4];
#pragma unroll
    for (int i = 0; i < 4; ++i) { h[i] = pk2(x[2 * i], x[2 * i + 1]); l[i] = pk2(x[2 * i] - bflo(h[i]), x[2 * i + 1] - bfhi(h[i])); }
    hi = (u32x4){h[0], h[1], h[2], h[3]}; lo = (u32x4){l[0], l[1], l[2], l[3]};
}
__device__ __forceinline__ void router_load_w(const float* wr, u32x4 (&wreg)[16], int wave, int lane) {
    const float* wp = wr + (size_t)(128 * wave + 8 * (lane >> 4)) * 32 + (lane & 15);
#pragma unroll
    for (int kk = 0; kk < 4; ++kk)
#pragma unroll
        for (int tl = 0; tl < 2; ++tl) { float x[8];
#pragma unroll
            for (int j = 0; j < 8; ++j) x[j] = wp[(32 * kk + j) * 32 + 16 * tl];
            split_hl(x, wreg[(kk * 2 + tl) * 2], wreg[(kk * 2 + tl) * 2 + 1]); }
}
template <bool XF32>
__device__ __forceinline__ void router_block(LAS unsigned char* lds, int blk, const float* X32, const bf16_t* XB, bf16_t* XBo, unsigned char* XB8, const bf16_t* H, const float* lnw, const float* lnb,
                                             const u32x4 (&wreg)[16], const float* br, unsigned* cnt, int* tokl, float* gatel, int* tinfo, int tid, int wave, int lane) {
    const int c16 = lane & 15, g = lane >> 4;
    if (tid < 32) *(LAS unsigned*)(lds + RT_HIST + tid * 4) = 0u;
    u32x2 hq[2][4]; f32x4 xq[2][4]; u32x2 xh[2][4];
#pragma unroll
    for (int j = 0; j < 4; ++j) {
#pragma unroll
        for (int k = 0; k < 2; ++k) { hq[k][j] = (u32x2){0u, 0u}; xh[k][j] = (u32x2){0u, 0u}; xq[k][j] = (f32x4){0.f, 0.f, 0.f, 0.f}; } }
    const unsigned lo4 = 4u * (unsigned)lane;
#define RT_LOAD(bt_) do { _Pragma("unroll") for (int k = 0; k < 2; ++k) { const size_t t_ = (size_t)blk * 128 + 16 * (bt_) + 2 * wave + k; \
        const bf16_t* hb_ = H + t_ * 1024 + lo4; const float* xb_ = X32 + t_ * 1024 + lo4; const bf16_t* xh_ = XB + t_ * 1024 + lo4; _Pragma("unroll") for (int j = 0; j < 4; ++j) { \
        LDPIN8(hq[k][j], hb_ + 256 * j); \
        if constexpr (XF32) LDPIN16(xq[k][j], xb_ + 256 * j); else LDPIN8(xh[k][j], xh_ + 256 * j); } } } while (0)
#define RT_PINROWS "+v"(hq[0][0]), "+v"(hq[0][1]), "+v"(hq[0][2]), "+v"(hq[0][3]), "+v"(hq[1][0]), "+v"(hq[1][1]), "+v"(hq[1][2]), "+v"(hq[1][3])
    { const f32x4 w4 = *(const f32x4*)(lnw + 4 * (tid & 255)), b4 = *(const f32x4*)(lnb + 4 * (tid & 255)); if (tid < 256) *(LAS f32x4*)(lds + RT_LNW + 16 * tid) = w4; else *(LAS f32x4*)(lds + RT_LNW + 4096 + 16 * (tid - 256)) = b4; }
    RT_LOAD(0);
    LDS_BARRIER();
#pragma unroll 1
    for (int bt = 0; bt < 8; ++bt) {
        if constexpr (XF32) asm volatile("s_waitcnt vmcnt(0)" : RT_PINROWS, "+v"(xq[0][0]), "+v"(xq[0][1]), "+v"(xq[0][2]), "+v"(xq[0][3]), "+v"(xq[1][0]), "+v"(xq[1][1]), "+v"(xq[1][2]), "+v"(xq[1][3]) :: "memory");
        else asm volatile("s_waitcnt vmcnt(0)" : RT_PINROWS, "+v"(xh[0][0]), "+v"(xh[0][1]), "+v"(xh[0][2]), "+v"(xh[0][3]), "+v"(xh[1][0]), "+v"(xh[1][1]), "+v"(xh[1][2]), "+v"(xh[1][3]) :: "memory");
#define RT_V(k_, j_) ((XF32 ? xq[k_][j_] : (f32x4){bflo(xh[k_][j_].x), bfhi(xh[k_][j_].x), bflo(xh[k_][j_].y), bfhi(xh[k_][j_].y)}) * ALPHA + (f32x4){bflo(hq[k_][j_].x), bfhi(hq[k_][j_].x), bflo(hq[k_][j_].y), bfhi(hq[k_][j_].y)})
        float s1[2], s2[2];
#pragma unroll
        for (int k = 0; k < 2; ++k) { s1[k] = 0.f; s2[k] = 0.f;
#pragma unroll
            for (int j = 0; j < 4; ++j) { const f32x4 t4 = RT_V(k, j); s1[k] += (t4.x + t4.y) + (t4.z + t4.w); s2[k] += (t4.x * t4.x + t4.y * t4.y) + (t4.z * t4.z + t4.w * t4.w); } }
        wave_sum4(s1[0], s2[0], s1[1], s2[1]);
#pragma unroll
        for (int k = 0; k < 2; ++k) {
            const int tl = 2 * wave + k; const size_t t = (size_t)blk * 128 + 16 * bt + tl;
            const float mean = s1[k] * (1.f / D); const float var = fmaxf(s2[k] * (1.f / D) - mean * mean, 0.f); const float rstd = 1.f / sqrtf(var + LN_EPS);
            bf16_t* xo_ = XBo + t * 1024; unsigned char* x8_ = XB8 + t * 1024;
#pragma unroll
            for (int j = 0; j < 4; ++j) { const f32x4 ww = *(const LAS f32x4*)(lds + RT_LNW + (256 * j + lo4) * 4), bb = *(const LAS f32x4*)(lds + RT_LNW + 4096 + (256 * j + lo4) * 4);
                const f32x4 y = (RT_V(k, j) - mean) * rstd * ww + bb;
                u32x2 o; o.x = pk2(y.x, y.y); o.y = pk2(y.z, y.w); *(u32x2*)(xo_ + 256 * j + lo4) = o;
                *(unsigned*)(x8_ + 256 * j + lo4) = pk4_fp8(y.x, y.y, y.z, y.w);
                *(LAS f32x4*)(lds + RT_Y + (tl * RT_YS + 4 * lane + 256 * j) * 4) = y; }
        }
#undef RT_V
        if constexpr (XF32) asm volatile("" : RT_PINROWS, "+v"(xq[0][0]), "+v"(xq[0][1]), "+v"(xq[0][2]), "+v"(xq[0][3]), "+v"(xq[1][0]), "+v"(xq[1][1]), "+v"(xq[1][2]), "+v"(xq[1][3]) :: "memory");
        else asm volatile("" : RT_PINROWS, "+v"(xh[0][0]), "+v"(xh[0][1]), "+v"(xh[0][2]), "+v"(xh[0][3]), "+v"(xh[1][0]), "+v"(xh[1][1]), "+v"(xh[1][2]), "+v"(xh[1][3]) :: "memory");
        if (bt < 7) RT_LOAD(bt + 1);
        LDS_BARRIER();
        {
            f32x4 a0 = (f32x4){0.f, 0.f, 0.f, 0.f}, a1 = a0;
            const LAS float* yp = (const LAS float*)(lds + RT_Y) + c16 * RT_YS + 128 * wave + 8 * g; asm volatile("" : "+v"(yp));
#pragma unroll
            for (int kk = 0; kk < 4; ++kk) {
                const f32x4 ya = *(const LAS f32x4*)(yp + 32 * kk), yb = *(const LAS f32x4*)(yp + 32 * kk + 4);
                const float x[8] = {ya.x, ya.y, ya.z, ya.w, yb.x, yb.y, yb.z, yb.w};
                u32x4 yh, yl; split_hl(x, yh, yl);
                const bf16x8 ah = __builtin_bit_cast(bf16x8, yh), al = __builtin_bit_cast(bf16x8, yl);
#pragma unroll
                for (int tl = 0; tl < 2; ++tl) { const bf16x8 wh = __builtin_bit_cast(bf16x8, wreg[(kk * 2 + tl) * 2]), wl = __builtin_bit_cast(bf16x8, wreg[(kk * 2 + tl) * 2 + 1]);
                    f32x4 acc = tl ? a1 : a0;
                    acc = __builtin_amdgcn_mfma_f32_16x16x32_bf16(al, wh, acc, 0, 0, 0); acc = __builtin_amdgcn_mfma_f32_16x16x32_bf16(ah, wl, acc, 0, 0, 0); acc = __builtin_amdgcn_mfma_f32_16x16x32_bf16(ah, wh, acc, 0, 0, 0);
                    if (tl) a1 = acc; else a0 = acc; }
            }
            LAS float* pp = (LAS float*)(lds + RT_PART) + (wave * 16 + 4 * g) * 32 + c16;
#pragma unroll
            for (int r = 0; r < 4; ++r) { pp[r * 32] = a0[r]; pp[r * 32 + 16] = a1[r]; }
        }
        LDS_BARRIER();
        {
            const int tk = tid >> 5, e = tid & 31;
            float lg = br[e];
            const LAS float* pp = (const LAS float*)(lds + RT_PART) + tk * 32 + e; asm volatile("" : "+v"(pp));
#pragma unroll
            for (int w = 0; w < 8; ++w) lg += pp[w * 512];
            *(LAS float*)(lds + RT_LOG + ((16 * bt + tk) * 33 + e) * 4) = lg;
        }
    }
#undef RT_LOAD
#undef RT_PINROWS
    LDS_BARRIER();
    if (tid < 128) {
        const LAS float* lp = (const LAS float*)(lds + RT_LOG) + tid * 33;
        float v0 = -INFINITY, v1 = -INFINITY, v2 = -INFINITY, v3 = -INFINITY; int i0 = 0, i1 = 0, i2 = 0, i3 = 0;
#pragma unroll
        for (int e = 0; e < 32; ++e) { const float x = lp[e];
            const bool g0 = x > v0, g1 = x > v1, g2 = x > v2, g3 = x > v3;
            v3 = g2 ? v2 : (g3 ? x : v3); i3 = g2 ? i2 : (g3 ? e : i3);
            v2 = g1 ? v1 : (g2 ? x : v2); i2 = g1 ? i1 : (g2 ? e : i2);
            v1 = g0 ? v0 : (g1 ? x : v1); i1 = g0 ? i0 : (g1 ? e : i1);
            v0 = g0 ? x : v0; i0 = g0 ? e : i0; }
        const float e1 = __expf(v1 - v0), e2 = __expf(v2 - v0), e3 = __expf(v3 - v0);
        const float inv = 1.0f / (1.0f + e1 + e2 + e3);
        const int mi[4] = {i0, i1, i2, i3}; const float gt[4] = {inv, e1 * inv, e2 * inv, e3 * inv};
#pragma unroll
        for (int k = 0; k < 4; ++k) {
            const unsigned lr = __hip_atomic_fetch_add((LAS unsigned*)(lds + RT_HIST + mi[k] * 4), 1u, __ATOMIC_RELAXED, __HIP_MEMORY_SCOPE_WORKGROUP);
            const int sidx = tid * 4 + k;
            *(LAS int*)(lds + RT_SELE + sidx * 4) = mi[k]; *(LAS float*)(lds + RT_SELG + sidx * 4) = gt[k]; *(LAS unsigned*)(lds + RT_SELR + sidx * 4) = lr;
        }
    }
    LDS_BARRIER();
    if (tid < 32) { const unsigned hc = *(LAS unsigned*)(lds + RT_HIST + tid * 4);
        *(LAS unsigned*)(lds + RT_BASE + tid * 4) = __hip_atomic_fetch_add(cnt + tid, hc, __ATOMIC_RELAXED, __HIP_MEMORY_SCOPE_AGENT); }
    __syncthreads();
    {
        const int me = *(LAS int*)(lds + RT_SELE + tid * 4); const float gt = *(LAS float*)(lds + RT_SELG + tid * 4);
        const unsigned rank = *(LAS unsigned*)(lds + RT_BASE + me * 4) + *(LAS unsigned*)(lds + RT_SELR + tid * 4);
        const int tok = blk * 128 + (tid >> 2);
        tokl[(size_t)me * T + rank] = tok; gatel[(size_t)me * T + rank] = gt; tinfo[(size_t)tok * 4 + (tid & 3)] = (me << 16) | (int)rank;
    }
    __syncthreads();
}

__device__ __forceinline__ void combine_rows2(size_t t0, size_t t1, const unsigned char* Y, const int* tinfo, const LAS int* tab, const bf16_t* XB, bf16_t* XBo, float* OUT32, const f32x4 (&lw)[4], const f32x4 (&lb)[4], int lane) {
    f32x4 v[2][4]; float s1[2], s2[2];
#pragma unroll
    for (int k2 = 0; k2 < 2; ++k2) {
        const size_t t = k2 ? t1 : t0;
        const u32x4 x0 = *(const u32x4*)(XB + t * 1024 + 16 * lane), x1 = *(const u32x4*)(XB + t * 1024 + 16 * lane + 8);
        const u32x4 inf4 = *(const u32x4*)(tinfo + t * 4);
        v[k2][0] = (f32x4){bflo(x0.x), bfhi(x0.x), bflo(x0.y), bfhi(x0.y)} * ALPHA; v[k2][1] = (f32x4){bflo(x0.z), bfhi(x0.z), bflo(x0.w), bfhi(x0.w)} * ALPHA;
        v[k2][2] = (f32x4){bflo(x1.x), bfhi(x1.x), bflo(x1.y), bfhi(x1.y)} * ALPHA; v[k2][3] = (f32x4){bflo(x1.z), bfhi(x1.z), bflo(x1.w), bfhi(x1.w)} * ALPHA;
        u32x4 yy[4];
#pragma unroll
        for (int k = 0; k < 4; ++k) { const unsigned inf = k == 0 ? inf4.x : k == 1 ? inf4.y : k == 2 ? inf4.z : inf4.w; const int ee = (int)(inf >> 16), rk = (int)(inf & 0xffffu);
            const size_t slot = (size_t)tab[ee] * 256 + rk; yy[k] = *(const u32x4*)(Y + slot * 1024 + 16 * lane); }
#pragma unroll
        for (int k = 0; k < 4; ++k) {
#pragma unroll
            for (int j = 0; j < 4; ++j) { const int w = (int)(j == 0 ? yy[k].x : j == 1 ? yy[k].y : j == 2 ? yy[k].z : yy[k].w);
                const f32x2 lo2 = __builtin_amdgcn_cvt_pk_f32_fp8(w, false), hi2 = __builtin_amdgcn_cvt_pk_f32_fp8(w, true);
                v[k2][j] = v[k2][j] + (f32x4){lo2.x, lo2.y, hi2.x, hi2.y} * 0.0625f; } }
        float a = 0.f, q = 0.f;
#pragma unroll
        for (int j = 0; j < 4; ++j) { const f32x4 u = v[k2][j]; a += (u.x + u.y) + (u.z + u.w); q += (u.x * u.x + u.y * u.y) + (u.z * u.z + u.w * u.w); }
        s1[k2] = a; s2[k2] = q;
    }
    wave_sum4(s1[0], s2[0], s1[1], s2[1]);
#pragma unroll
    for (int k2 = 0; k2 < 2; ++k2) {
        const size_t t = k2 ? t1 : t0;
        const float mean = s1[k2] * (1.f / D); const float var = fmaxf(s2[k2] * (1.f / D) - mean * mean, 0.f); const float rstd = 1.f / sqrtf(var + LN_EPS);
        f32x4 y[4];
#pragma unroll
        for (int j = 0; j < 4; ++j) y[j] = (v[k2][j] - mean) * rstd * lw[j] + lb[j];
        if (OUT32) {
#pragma unroll
            for (int j = 0; j < 4; ++j) *(f32x4*)(OUT32 + t * 1024 + 16 * lane + 4 * j) = y[j];
        } else {
            u32x4 o0, o1; o0.x = pk2(y[0].x, y[0].y); o0.y = pk2(y[0].z, y[0].w); o0.z = pk2(y[1].x, y[1].y); o0.w = pk2(y[1].z, y[1].w);
            o1.x = pk2(y[2].x, y[2].y); o1.y = pk2(y[2].z, y[2].w); o1.z = pk2(y[3].x, y[3].y); o1.w = pk2(y[3].z, y[3].w);
            *(u32x4*)(XBo + t * 1024 + 16 * lane) = o0; *(u32x4*)(XBo + t * 1024 + 16 * lane + 8) = o1;
        }
    }
}

__device__ __forceinline__ int crow(int r, int hi) { return (r & 3) + 8 * (r >> 2) + 4 * hi; }
__device__ __forceinline__ void attn_phase(const bf16_t* QB, const bf16_t* KB, const bf16_t* VT, bf16_t* AO, int gw, int ngw, int lane) {
    const int r32 = lane & 31, hi = lane >> 5;
    for (int task = gw; task < BATCH * 16 * (SEQ / 32); task += ngw) {
        const int qt = task & 255, bh = task >> 8, b = bh >> 4, h = bh & 15;
        const size_t rowb = (size_t)b * SEQ; const int q0 = qt * 32;
        bf16x8 qf[4];
        { const bf16_t* qp = QB + (rowb + q0 + r32) * 1024 + h * 64 + hi * 8;
#pragma unroll
          for (int s = 0; s < 4; ++s) qf[s] = *(const bf16x8*)(qp + 16 * s); }
        f32x16 o0, o1;
#pragma unroll
        for (int r = 0; r < 16; ++r) { o0[r] = 0.f; o1[r] = 0.f; }
        float carry = 1.f;
        const bf16_t* kbase = KB + (size_t)bh * 256 * 4 * 64 * 8 + lane * 8;
        const bf16_t* vbase = VT + (size_t)bh * 256 * 4 * 64 * 8 + lane * 8;
        bf16x8 kn[4];
#pragma unroll
        for (int s = 0; s < 4; ++s) kn[s] = *(const bf16x8*)(kbase + (size_t)qt * 2048 + s * 512);
        for (int kt = qt; kt >= 0; --kt) {
            bf16x8 kf[4];
#pragma unroll
            for (int s = 0; s < 4; ++s) kf[s] = kn[s];
            bf16x8 va[2][2];
#pragma unroll
            for (int dt = 0; dt < 2; ++dt)
#pragma unroll
                for (int sp = 0; sp < 2; ++sp) va[dt][sp] = *(const bf16x8*)(vbase + (size_t)kt * 2048 + (dt * 2 + sp) * 512);
            { const int kp = kt > 0 ? kt - 1 : 0;
#pragma unroll
              for (int s = 0; s < 4; ++s) kn[s] = *(const bf16x8*)(kbase + (size_t)kp * 2048 + s * 512); }
            f32x16 st;
#pragma unroll
            for (int r = 0; r < 16; ++r) st[r] = 0.f;
#pragma unroll
            for (int s = 0; s < 4; ++s) st = __builtin_amdgcn_mfma_f32_32x32x16_bf16(kf[s], qf[s], st, 0, 0, 0);
            const bool diag = (kt == qt);
            float R[16], Bt[16];
#pragma unroll
            for (int r = 0; r < 16; r += 2) {
                const f32x2 e = (f32x2){fexp2(st[r]), fexp2(st[r + 1])};
                const f32x2 d = e + 1.0f;
                f32x2 rr = (f32x2){frcp(d.x), frcp(d.y)};
                if (diag) { rr.x = (crow(r, hi) < r32) ? rr.x : 1.0f; rr.y = (crow(r + 1, hi) < r32) ? rr.y : 1.0f; }
                const f32x2 bt = 1.0f - rr;
                R[r] = rr.x; R[r + 1] = rr.y; Bt[r] = bt.x; Bt[r + 1] = bt.y;
            }
            float own[4], pg[4];
#pragma unroll
            for (int rg = 0; rg < 4; ++rg) { own[rg] = (R[4 * rg] * R[4 * rg + 1]) * (R[4 * rg + 2] * R[4 * rg + 3]); pg[rg] = __shfl_xor(own[rg], 32); }
            float aft[4];
            { float run = 1.f;
#pragma unroll
              for (int rg = 3; rg >= 0; --rg) { aft[rg] = (hi == 0) ? run * pg[rg] : run; run *= own[rg] * pg[rg]; }
              float w[16];
#pragma unroll
              for (int rg = 0; rg < 4; ++rg) { float lat = carry * aft[rg];
#pragma unroll
                  for (int p = 3; p >= 0; --p) { w[4 * rg + p] = Bt[4 * rg + p] * lat; lat *= R[4 * rg + p]; } }
              carry *= run;
              u32x4 p0, p1;
              p0.x = pk2(w[0], w[1]); p0.y = pk2(w[2], w[3]); p0.z = pk2(w[4], w[5]); p0.w = pk2(w[6], w[7]);
              p1.x = pk2(w[8], w[9]); p1.y = pk2(w[10], w[11]); p1.z = pk2(w[12], w[13]); p1.w = pk2(w[14], w[15]);
              const bf16x8 pf0 = __builtin_bit_cast(bf16x8, p0), pf1 = __builtin_bit_cast(bf16x8, p1);
              o0 = __builtin_amdgcn_mfma_f32_32x32x16_bf16(va[0][0], pf0, o0, 0, 0, 0); o0 = __builtin_amdgcn_mfma_f32_32x32x16_bf16(va[0][1], pf1, o0, 0, 0, 0);
              o1 = __builtin_amdgcn_mfma_f32_32x32x16_bf16(va[1][0], pf0, o1, 0, 0, 0); o1 = __builtin_amdgcn_mfma_f32_32x32x16_bf16(va[1][1], pf1, o1, 0, 0, 0);
            }
            if (__all(carry < ATT_THR)) break;
        }
        bf16_t* op = AO + (rowb + q0 + r32) * 1024 + h * 64 + 4 * hi;
#pragma unroll
        for (int rg = 0; rg < 4; ++rg) {
            u32x2 w; w.x = pk2(o0[4 * rg], o0[4 * rg + 1]); w.y = pk2(o0[4 * rg + 2], o0[4 * rg + 3]); *(u32x2*)(op + 8 * rg) = w;
            w.x = pk2(o1[4 * rg], o1[4 * rg + 1]); w.y = pk2(o1[4 * rg + 2], o1[4 * rg + 3]); *(u32x2*)(op + 32 + 8 * rg) = w;
        }
    }
}

constexpr int NWAVES = 8;
constexpr int NPHASE = 17;
struct Args { const float* in[29]; float* out; unsigned char* ws; int ph_lo, ph_hi; };

#ifndef PH_MASK
#define PH_MASK 0xfff
#endif
#define EN(b) ((PH_MASK >> (b)) & 1)
#ifndef REP_MASK
#define REP_MASK 0
#endif
#define RP(b) ((REP_MASK >> (b)) & 1)
#define PHASE(b, k, ...) if (EN(b) && IN(k)) { PH_IDS; { __VA_ARGS__ } if (RP(b)) { __VA_ARGS__ } }
#define IN(k) (lo <= (k) && (k) < hi)
#if MK_PER_PHASE
#define SEAM(k) do { } while (0)
#else
#define SEAM(k) do { if (IN(k) && IN((k) + 1)) xcd_barrier(bar); } while (0)
#endif
#define PH_IDS const int lane = lane_id_asm(); const int wave = wave0; const int tid = wave * 64 + lane; const int G = gridDim.x, bx = blockIdx.x; const int gw = bx * NWAVES + wave, NGW = G * NWAVES; (void)tid; (void)lane; (void)gw; (void)NGW; (void)G; (void)bx
#define WSP(T_, off) ((T_*)(args.ws + (off)))

template <int LAYER>
__device__ __forceinline__ void layer_tail(const Args& args, LAS unsigned char* lds, const XcdBarrier& bar, int lo, int hi, const int wave0) {
    constexpr int PB = LAYER == 0 ? 5 : 12;
    LAS int* moetab = (LAS int*)(lds + MOETAB_OFF);
    LAS unsigned* rowtab = (LAS unsigned*)(lds + ROWTAB_OFF);
    PHASE(5, PB,
        pg8::Gemm g{WSP(bf16_t, WS_SB), WSP(bf16_t, LAYER ? WS_WO1T : WS_WO0T), 1024, 0}; pg8::StaticOrder S; S.init(T, 1024, G, bx); pg8::EpiPlain E{WSP(bf16_t, WS_SB + 64 * MiB), 1024, 0, 0, 1.f};
        pg8::gemm_phase<pg8::EpiPlain, pg8::StaticOrder, 0>(lds, g, S, E, nullptr, rowtab, tid);)
    SEAM(PB);
    if (RP(6) && EN(6) && IN(PB + 1)) { PH_IDS;
        unsigned* cnt = WSP(unsigned, WS_CTL) + CW_CNT + 128 + LAYER * 64;
        u32x4 wreg[16]; router_load_w(args.in[LAYER ? 21 : 9], wreg, wave, lane);
        for (int blk = bx; blk < T / 128; blk += G)
            router_block<LAYER == 0>(lds, blk, LAYER ? nullptr : args.in[0], WSP(bf16_t, WS_XB), WSP(bf16_t, WS_END), WSP(unsigned char, WS_END + 64 * MiB), WSP(bf16_t, WS_SB + 64 * MiB), args.in[LAYER ? 19 : 7], args.in[LAYER ? 20 : 8], wreg, args.in[LAYER ? 22 : 10],
                         cnt, WSP(int, WS_END + 96 * MiB), WSP(float, WS_END + 100 * MiB), WSP(int, WS_END + 104 * MiB), tid, wave, lane); }
    if (EN(6) && IN(PB + 1)) { PH_IDS;
        unsigned* cnt = WSP(unsigned, WS_CTL) + CW_CNT + LAYER * 64;
        u32x4 wreg[16]; router_load_w(args.in[LAYER ? 21 : 9], wreg, wave, lane);
        for (int blk = bx; blk < T / 128; blk += G)
            router_block<LAYER == 0>(lds, blk, LAYER ? nullptr : args.in[0], WSP(bf16_t, WS_XB), WSP(bf16_t, WS_XB), WSP(unsigned char, WS_XB8), WSP(bf16_t, WS_SB + 64 * MiB), args.in[LAYER ? 19 : 7], args.in[LAYER ? 20 : 8], wreg, args.in[LAYER ? 22 : 10],
                         cnt, WSP(int, WS_TOKL), WSP(float, WS_GATEL), WSP(int, WS_TINFO), tid, wave, lane); }
    SEAM(PB + 1);
    PHASE(7, PB + 2,
        moe_table(WSP(unsigned, WS_CTL) + CW_CNT + LAYER * 64, moetab, tid);
        pg8::Gemm g{WSP(bf16_t, WS_XB8), WSP(bf16_t, WS_W1T), 512, 2048}; pg8::MoeOrder S; S.init(moetab, 8, G, bx); pg8::EpiSwiglu8 E{WSP(unsigned char, WS_SA), args.in[LAYER ? 24 : 12]};
        pg8::gemm_phase<pg8::EpiSwiglu8, pg8::MoeOrder, 1, 127 - W1_SH>(lds, g, S, E, WSP(int, WS_TOKL), rowtab, tid);)
    SEAM(PB + 2);
    PHASE(8, PB + 3,
        moe_table(WSP(unsigned, WS_CTL) + CW_CNT + LAYER * 64, moetab, tid);
        pg8::Gemm g{WSP(bf16_t, WS_SA), WSP(bf16_t, WS_W2T), 512, 1024}; pg8::MoeOrder S; S.init(moetab, 4, G, bx); pg8::EpiDown8 E{WSP(unsigned char, WS_SB), args.in[LAYER ? 26 : 14], WSP(float, WS_GATEL)};
        pg8::gemm_phase<pg8::EpiDown8, pg8::MoeOrder, 2, 127 - W2_SH>(lds, g, S, E, nullptr, rowtab, tid);)
    SEAM(PB + 3);
    if (EN(9) && IN(PB + 4)) { PH_IDS;
        moe_table(WSP(unsigned, WS_CTL) + CW_CNT + LAYER * 64, moetab, tid);
        f32x4 lw[4], lb[4];
#pragma unroll
        for (int j = 0; j < 4; ++j) { lw[j] = *(const f32x4*)(args.in[LAYER ? 27 : 15] + 16 * lane + 4 * j); lb[j] = *(const f32x4*)(args.in[LAYER ? 28 : 16] + 16 * lane + 4 * j); }
        if (RP(9)) { for (int t = gw; t < T; t += 2 * NGW) combine_rows2((size_t)t, (size_t)(t + NGW), WSP(unsigned char, WS_SB), WSP(int, WS_TINFO), moetab, WSP(bf16_t, WS_XB), WSP(bf16_t, WS_END), LAYER ? (float*)WSP(float, WS_END) : nullptr, lw, lb, lane); }
        for (int t = gw; t < T; t += 2 * NGW) combine_rows2((size_t)t, (size_t)(t + NGW), WSP(unsigned char, WS_SB), WSP(int, WS_TINFO), moetab, WSP(bf16_t, WS_XB), WSP(bf16_t, WS_XB), LAYER ? args.out : nullptr, lw, lb, lane);
    }
    if (LAYER == 0) SEAM(PB + 4);
}

__global__ void __launch_bounds__(NWAVES * 64, 2) mk_fwd(Args args) {
    extern __shared__ __attribute__((aligned(16))) unsigned char lds_raw[];
    LAS unsigned char* lds = (LAS unsigned char*)lds_raw;
    volatile LAS unsigned* MISC = (volatile LAS unsigned*)(lds + MISC_OFF);
    LAS unsigned* rowtab = (LAS unsigned*)(lds + ROWTAB_OFF);
    if (threadIdx.x < 32) MISC[threadIdx.x] = 0u;
    __syncthreads();
    const int wave0 = __builtin_amdgcn_readfirstlane(threadIdx.x >> 6);
    XcdBarrier bar; bar.bar = WSP(unsigned, WS_CTL) + CW_BAR; bar.x = 0; bar.st = nullptr; bar.wave = wave0;
#if !MK_PER_PHASE
    bar = xcd_barrier_post(WSP(unsigned, WS_CTL) + CW_BAR, MISC + 8);
#endif
    const int lo = args.ph_lo, hi = args.ph_hi;

    PHASE(0, 0,
        const float* x_in = args.in[0]; const float* w_in0 = args.in[2]; const float* wpool = args.in[4]; const float* pscale = args.in[5]; const float* w_o0 = args.in[6];
        const float* w_in1 = args.in[17]; const float* w_o1 = args.in[18];
        bf16_t* WIN0T = WSP(bf16_t, WS_WIN0T); bf16_t* WO0T = WSP(bf16_t, WS_WO0T); bf16_t* WIN1T = WSP(bf16_t, WS_WIN1T); bf16_t* WO1T = WSP(bf16_t, WS_WO1T); bf16_t* XB = WSP(bf16_t, WS_XB);
        LAS float* scr = (LAS float*)(lds + wave * 16384);
        constexpr int I_IN0 = 16 * 80, I_O0 = 8 * 32, I_IN1 = 16 * 96, I_O1 = 16 * 32, NIT = I_IN0 + I_O0 + I_IN1 + I_O1;
        for (int it = gw; it < NIT; it += NGW) {
            int r = it;
            if (r < I_IN0) { const int kb = r / 80, nb = r % 80, n0 = 32 * nb;
                const int dr = n0 < 512 ? 2 * n0 : (n0 < 1024 ? 2 * (n0 - 512) + 1 : (n0 < 1536 ? n0 + 1024 : n0 - 512));
                transpose_item(w_in0, 2560, WIN0T, 1024, 64 * kb, n0, dr, scr, lane, n0 < 1024 ? 2 : 1); continue; } r -= I_IN0;
            if (r < I_O0) { const int kb = r / 32, nb = r % 32; transpose_item(w_o0, 1024, WO0T, 1024, 64 * kb, 32 * nb, 32 * nb, scr, lane); continue; } r -= I_O0;
            if (r < I_IN1) { const int kb = r / 96, nb = r % 96; transpose_item(w_in1, 3072, WIN1T, 1024, 64 * kb, 32 * nb, 32 * nb, scr, lane); continue; } r -= I_IN1;
            { const int kb = r / 32, nb = r % 32; transpose_item(w_o1, 1024, WO1T, 1024, 64 * kb, 32 * nb, 32 * nb, scr, lane); }
        }
        for (int idx = bx * 512 + tid; idx < 512 * 1024; idx += G * 512) {
            const int n = idx & 1023, gc = idx >> 10, gg = gc >> 7;
            const float* wp = wpool + (size_t)gc * 128; const float* ps = pscale + 128 * gg; const float* wo = w_o0 + (size_t)(512 + 128 * gg) * 1024 + n;
            float a = 0.f;
_Pragma("unroll 8")
            for (int d = 0; d < 128; ++d) a += wp[d] * ps[d] * wo[(size_t)d * 1024];
            WO0T[(size_t)n * 1024 + 512 + gc] = (bf16_t)(pk2(a, 0.f) & 0xffffu);
        }
        for (size_t i = (size_t)bx * 512 + tid; i < (size_t)T * D / 8; i += (size_t)G * 512) {
            const f32x4 a = *(const f32x4*)(x_in + i * 8), b2 = *(const f32x4*)(x_in + i * 8 + 4);
            u32x4 o; o.x = pk2(a.x, a.y); o.y = pk2(a.z, a.w); o.z = pk2(b2.x, b2.y); o.w = pk2(b2.z, b2.w);
            *(u32x4*)(XB + i * 8) = o;
        })
    SEAM(0);
    PHASE(1, 1,
        { pg8::Gemm g{WSP(bf16_t, WS_XB), WSP(bf16_t, WS_WIN0T), 1024, 0}; pg8::StaticOrder S; S.init(T, 2048, G, bx); pg8::EpiPlain E{WSP(bf16_t, WS_SA), 2048, 0, 0, 1.f};
          pg8::gemm_phase<pg8::EpiPlain, pg8::StaticOrder, 0>(lds, g, S, E, nullptr, rowtab, tid); }
        { pg8::Gemm g{WSP(bf16_t, WS_WIN0T) + (size_t)2048 * 1024, WSP(bf16_t, WS_XB), 1024, 0}; pg8::StaticOrder S; S.init(512, T, G, bx); pg8::EpiPlain E{WSP(bf16_t, WS_SA + 128 * MiB), T, 0, 0, 1.f};
          pg8::gemm_phase<pg8::EpiPlain, pg8::StaticOrder, 0>(lds, g, S, E, nullptr, rowtab, tid); })
    SEAM(1);
#define HG_UNIT0(u_) hgrn_unit<0>(lds, u_, WSP(bf16_t, WS_SA), WSP(bf16_t, WS_SA + 128 * MiB), WSP(float, WS_SB + 128 * MiB), WSP(float, WS_SB + 160 * MiB), args.in[1], args.in[3], WSP(bf16_t, WS_SB), tid, wave, lane)
#define HG_UNIT1(u_) hgrn_unit<1>(lds, u_, WSP(bf16_t, WS_SA), WSP(bf16_t, WS_SA + 128 * MiB), WSP(float, WS_SB + 128 * MiB), WSP(float, WS_SB + 160 * MiB), args.in[1], args.in[3], WSP(bf16_t, WS_SB), tid, wave, lane)
#define CONV0(q0_, q1_) conv_moe_wg(args.in[11], args.in[13], WSP(unsigned char, WS_W1T), WSP(unsigned char, WS_W2T), (LAS float*)lds, bx, G, tid, (q0_) * cq, (q1_) * cq)
    PHASE(2, 2,
        const bool cfirst = (bx & 1) != 0; const int cq = ((NE * 192 + G - 1) / G + 3) / 4;
        if (cfirst) CONV0(0, 1);
        if (bx < 512) HG_UNIT0(bx);
        if (cfirst) CONV0(1, 2); else CONV0(0, 1);
        for (int u = bx + G; u < 512; u += G) HG_UNIT0(u);
        if (!cfirst) CONV0(1, 2);
        for (int task = bx; task < 256; task += G) pool_task(task, WSP(bf16_t, WS_SA), WSP(bf16_t, WS_SB), wave, lane);)
    SEAM(2);
    PHASE(3, 3,
        float* SLOC = WSP(float, WS_SB + 128 * MiB); const float* DTOT = WSP(float, WS_SB + 160 * MiB);
        for (int ch = bx * 512 + tid; ch < 16 * 16384; ch += G * 512) {
            const int bh = ch >> 14, el = ch & 16383, dk = el >> 7;
            float* sp = SLOC + (size_t)bh * 32 * 16384 + el; const float* dp = DTOT + (size_t)bh * 32 * 128 + dk;
            float loc[32], dd[32];
_Pragma("unroll")
            for (int sc = 0; sc < 32; ++sc) { loc[sc] = sp[(size_t)sc * 16384]; dd[sc] = dp[sc * 128]; }
            float S = 0.f;
_Pragma("unroll")
            for (int sc = 0; sc < 32; ++sc) { sp[(size_t)sc * 16384] = S; S = dd[sc] * S + loc[sc]; }
        })
    SEAM(3);
    PHASE(4, 4,
        const bool cfirst = (bx & 1) != 0; const int cq = ((NE * 192 + G - 1) / G + 3) / 4;
        if (cfirst) CONV0(2, 3);
        if (bx < 512) HG_UNIT1(bx);
        if (cfirst) CONV0(3, 4); else CONV0(2, 3);
        for (int u = bx + G; u < 512; u += G) HG_UNIT1(u);
        if (!cfirst) CONV0(3, 4);
        )
#undef CONV0
#undef HG_UNIT0
#undef HG_UNIT1
    SEAM(4);
    layer_tail<0>(args, lds, bar, lo, hi, wave0);
    PHASE(10, 10,
        { pg8::Gemm g{WSP(bf16_t, WS_XB), WSP(bf16_t, WS_WIN1T), 1024, 0}; pg8::StaticOrder S; S.init(T, 2048, G, bx); pg8::EpiQK E{WSP(bf16_t, WS_SA), WSP(bf16_t, WS_SA + 64 * MiB), QSCALE};
          pg8::gemm_phase<pg8::EpiQK, pg8::StaticOrder, 0>(lds, g, S, E, nullptr, rowtab, tid); }
        { pg8::Gemm g{WSP(bf16_t, WS_WIN1T) + (size_t)2048 * 1024, WSP(bf16_t, WS_XB), 1024, 0}; pg8::StaticOrder S; S.init(1024, T, G, bx); pg8::EpiVF E{WSP(bf16_t, WS_SA + 128 * MiB)};
          pg8::gemm_phase<pg8::EpiVF, pg8::StaticOrder, 0>(lds, g, S, E, nullptr, rowtab, tid); })
    SEAM(10);
    PHASE(11, 11,
        const bool cfirst = (bx & 1) != 0;
        if (cfirst) conv_moe_wg(args.in[23], args.in[25], WSP(unsigned char, WS_W1T), WSP(unsigned char, WS_W2T), (LAS float*)lds, bx, G, tid, 0, (NE * 192 + G - 1) / G);
        attn_phase(WSP(bf16_t, WS_SA), WSP(bf16_t, WS_SA + 64 * MiB), WSP(bf16_t, WS_SA + 128 * MiB), WSP(bf16_t, WS_SB), gw, NGW, lane);
        if (!cfirst) conv_moe_wg(args.in[23], args.in[25], WSP(unsigned char, WS_W1T), WSP(unsigned char, WS_W2T), (LAS float*)lds, bx, G, tid, 0, (NE * 192 + G - 1) / G);)
    SEAM(11);
    layer_tail<1>(args, lds, bar, lo, hi, wave0);
}
#undef IN
#undef SEAM

extern "C" void kernel_launch(void* const* d_in, const int* in_sizes, int n_in, void* d_out, int out_size, void* d_ws, size_t ws_size, hipStream_t stream) {
    static int grid = 0;
    if (grid == 0) {
        if (n_in != 29 || in_sizes[0] != T * D || out_size != T * D || ws_size < WS_END) { fprintf(stderr, "kernel_launch: unexpected shapes (n_in %d, in0 %d, out %d, ws %zu)\n", n_in, n_in > 0 ? in_sizes[0] : -1, out_size, ws_size); grid = -1; return; }
        int dev = 0, cus = 0, per_cu = 0;
        if (hipGetDevice(&dev) != hipSuccess || hipDeviceGetAttribute(&cus, hipDeviceAttributeMultiprocessorCount, dev) != hipSuccess) { grid = -1; return; }
        if (hipFuncSetAttribute((const void*)mk_fwd, hipFuncAttributeMaxDynamicSharedMemorySize, LDS_BYTES) != hipSuccess) { fprintf(stderr, "kernel_launch: hipFuncSetAttribute failed\n"); grid = -1; return; }
        if (hipOccupancyMaxActiveBlocksPerMultiprocessor(&per_cu, (const void*)mk_fwd, NWAVES * 64, LDS_BYTES) != hipSuccess || per_cu < 1) { fprintf(stderr, "kernel_launch: occupancy query says %d\n", per_cu); }
        (void)hipGetLastError();
        grid = cus;
    }
    if (grid < 0) return;
    if (hipMemsetAsync((char*)d_ws + WS_CTL, 0, CTL_ZERO_BYTES, stream) != hipSuccess) return;
    Args a{};
    for (int i = 0; i < 29; ++i) a.in[i] = (const float*)d_in[i];
    a.out = (float*)d_out; a.ws = (unsigned char*)d_ws;
#if MK_PER_PHASE
    for (int p = 0; p < NPHASE; ++p) { a.ph_lo = p; a.ph_hi = p + 1; hipLaunchKernelGGL(mk_fwd, dim3(grid), dim3(NWAVES * 64), LDS_BYTES, stream, a); }
#else
    a.ph_lo = 0; a.ph_hi = NPHASE;
    hipLaunchKernelGGL(mk_fwd, dim3(grid), dim3(NWAVES * 64), LDS_BYTES, stream, a);
#endif
}
```

```cpp
#include <hip/hip_runtime.h>
#include <cstdio>
#include <cstdint>

#ifndef MK_PER_PHASE
#define MK_PER_PHASE 0
#endif

#define LAS __attribute__((address_space(3)))
#define GAS __attribute__((address_space(1)))
typedef unsigned short bf16_t;
typedef short bf16x8 __attribute__((ext_vector_type(8)));
typedef short s16x4 __attribute__((ext_vector_type(4)));
typedef float f32x2 __attribute__((ext_vector_type(2)));
typedef float f32x4 __attribute__((ext_vector_type(4)));
typedef float f32x16 __attribute__((ext_vector_type(16)));
typedef unsigned u32x2 __attribute__((ext_vector_type(2)));
typedef unsigned u32x4 __attribute__((ext_vector_type(4)));
typedef __bf16 bf16x2_t __attribute__((ext_vector_type(2)));
typedef int i32x4 __attribute__((ext_vector_type(4)));
typedef int i32x8 __attribute__((ext_vector_type(8)));

constexpr int BATCH = 4, SEQ = 8192, T = BATCH * SEQ, D = 1024;
constexpr int NE = 32;
constexpr float ALPHA = 1.41421356237309515f;
constexpr float LN_EPS = 1e-5f, RMS_EPS = 1e-6f;
constexpr float LOG2E = 1.4426950408889634f;
constexpr float QSCALE = 0.125f * LOG2E;
constexpr float ATT_THR = 7.5231638e-37f;

__device__ __forceinline__ unsigned pk2(float lo, float hi) { f32x2 v = {lo, hi}; bf16x2_t b = __builtin_convertvector(v, bf16x2_t); return __builtin_bit_cast(unsigned, b); }
__device__ __forceinline__ float bflo(unsigned u) { return __uint_as_float(u << 16); }
__device__ __forceinline__ float bfhi(unsigned u) { return __uint_as_float(u & 0xffff0000u); }
__device__ __forceinline__ float bf2f(bf16_t h) { return __uint_as_float(((unsigned)h) << 16); }
__device__ __forceinline__ float clamp448(float x) { return __builtin_amdgcn_fmed3f(x, -448.0f, 448.0f); }
__device__ __forceinline__ unsigned pk4_fp8_nc(float a, float b, float c, float d) { int p = 0; p = __builtin_amdgcn_cvt_pk_fp8_f32(a, b, p, false); p = __builtin_amdgcn_cvt_pk_fp8_f32(c, d, p, true); return (unsigned)p; }
__device__ __forceinline__ unsigned pk4_fp8(float a, float b, float c, float d) { int p = 0; p = __builtin_amdgcn_cvt_pk_fp8_f32(clamp448(a), clamp448(b), p, false); p = __builtin_amdgcn_cvt_pk_fp8_f32(clamp448(c), clamp448(d), p, true); return (unsigned)p; }
__device__ __forceinline__ float fexp2(float x) { return __builtin_amdgcn_exp2f(x); }
__device__ __forceinline__ float flog2(float x) { return __builtin_amdgcn_logf(x); }
__device__ __forceinline__ float frcp(float x) { return __builtin_amdgcn_rcpf(x); }

__device__ __forceinline__ int lane_id_asm() { int l; asm volatile("v_mbcnt_lo_u32_b32 %0, -1, 0\n\tv_mbcnt_hi_u32_b32 %0, -1, %0" : "=v"(l)); return l; }

#define LDPIN16(dst_, p_) asm volatile("global_load_dwordx4 %0, %1, off" : "+v"(dst_) : "v"(p_) : "memory")
#define LDPIN8(dst_, p_)  asm volatile("global_load_dwordx2 %0, %1, off" : "+v"(dst_) : "v"(p_) : "memory")

namespace pg8 {
constexpr int BM = 256, BK = 64, HALF = 128, HTB = HALF * BK * 2, STAGE_BYTES = 8 * HTB, NXCD = 8, WGM = 8;
constexpr int AUX_OFF = STAGE_BYTES + 2048 + 512 + 256;
__host__ __device__ __forceinline__ int lds_byte(int r, int c) { const int st = (r >> 4) * 2 + (c >> 5), rr = r & 15, cc = c & 31, ob = rr * 64 + cc * 2; return st * 1024 + (ob ^ (((ob >> 9) & 1) << 5)); }
__host__ __device__ __forceinline__ void stage_rc(int b, int& R, int& C) { const int st = b / 1024, sb = b % 1024, swz = sb ^ (((sb >> 9) & 1) << 5); R = (st >> 1) * 16 + swz / 64; C = (st & 1) * 32 + (swz % 64) / 2; }
__host__ __device__ __forceinline__ int perm32(int rho) { const int n = rho >> 4, i = rho & 15; return 8 * (i >> 2) + 4 * n + (i & 3); }

struct Unit { int pm, pn, e, mt, valid; };
struct Gemm { const bf16_t* A; const bf16_t* Bt; int K; int brows; };

__device__ __forceinline__ void tile_of(int L, int nM, int nN, int& pm, int& pn) {
    const int nwg = nM * nN;
    int wgid = L; { const int q = nwg / NXCD, r = nwg % NXCD, xcd = wgid % NXCD, off = wgid / NXCD; wgid = (xcd < r ? xcd * (q + 1) : r * (q + 1) + (xcd - r) * q) + off; }
    const int nig = WGM * nN, gid = wgid / nig, fm = gid * WGM, gsz = (nM - fm) < WGM ? (nM - fm) : WGM;
    pm = fm + ((wgid % nig) % gsz); pn = (wgid % nig) / gsz;
}
struct StaticOrder {
    int nM, nN, nwg, G, c;
    __device__ __forceinline__ void init(int M, int N, int G_, int c_) { nM = M / BM; nN = N / BM; nwg = nM * nN; G = G_; c = c_; }
    __device__ __forceinline__ bool next(int i, Unit& u) const {
        const long L = (long)i * G + c; if (L >= nwg) return false;
        tile_of((int)L, nM, nN, u.pm, u.pn); u.e = 0; u.mt = u.pm; u.valid = 256; return true;
    }
};
struct MoeOrder {
    const LAS int* tab; int nM, nN, nwg, G, c;
    __device__ __forceinline__ void init(const LAS int* tab_, int nN_, int G_, int c_) { tab = tab_; nM = tab_[32]; nN = nN_; nwg = nM * nN; G = G_; c = c_; }
    __device__ __forceinline__ bool next(int i, Unit& u) const {
        const long L = (long)i * G + c; if (L >= nwg) return false;
        tile_of((int)L, nM, nN, u.pm, u.pn);
        int e = 0;
#pragma unroll
        for (int j = 1; j < 32; ++j) e += (u.pm >= tab[j]) ? 1 : 0;
        u.e = e; u.mt = u.pm - tab[e]; const int rem = tab[33 + e] - u.mt * 256; u.valid = rem < 256 ? rem : 256; return true;
    }
};

__device__ __forceinline__ unsigned cvt_pk_bf16(float lo, float hi) { return pk2(lo, hi); }

struct EpiPlain {
    static constexpr bool PERM = true; static constexpr int NAUX = 0;
    bf16_t* O; int ldc; int split_cols; size_t split_stride; float scale0;
    __device__ __forceinline__ void operator()(const f32x4 (&acc)[2][2][4][2], const Unit& u, int wr, int wc, int fr, int fq, const LAS float* aux) const {
        asm volatile("" : "+v"(fr), "+v"(fq));
        const int row0 = u.pm * BM + wr * 64 + fr; int colt = u.pn * BM; bf16_t* base = O;
        float sc = 1.f; if (split_cols) { const int t = colt / split_cols; base += (size_t)t * split_stride; colt -= t * split_cols; if (t == 0) sc = scale0; }
        const int col0 = colt + wc * 32 + 8 * fq;
#pragma unroll
        for (int ai = 0; ai < 2; ++ai)
#pragma unroll
            for (int m = 0; m < 4; ++m) { bf16_t* rowp = base + (size_t)(row0 + ai * HALF + m * 16) * ldc + col0;
#pragma unroll
                for (int bj = 0; bj < 2; ++bj) { f32x4 v0 = acc[ai][bj][m][0] * sc, v1 = acc[ai][bj][m][1] * sc;
                    u32x4 w; w.x = cvt_pk_bf16(v0[0], v0[1]); w.y = cvt_pk_bf16(v0[2], v0[3]); w.z = cvt_pk_bf16(v1[0], v1[1]); w.w = cvt_pk_bf16(v1[2], v1[3]);
                    *(u32x4*)(rowp + bj * HALF) = w; } }
    }
};
struct EpiQK {
    static constexpr bool PERM = true; static constexpr int NAUX = 0;
    bf16_t* Q; bf16_t* KF; float scale;
    __device__ __forceinline__ void operator()(const f32x4 (&acc)[2][2][4][2], const Unit& u, int wr, int wc, int fr, int fq, const LAS float* aux) const {
        asm volatile("" : "+v"(fr), "+v"(fq));
        const int row0 = u.pm * BM + wr * 64 + fr; const int colt = u.pn * BM; const bool isk = colt >= 1024;
        const int col0 = (isk ? colt - 1024 : colt) + wc * 32 + 8 * fq;
        const float sc = isk ? 1.f : scale;
#pragma unroll
        for (int ai = 0; ai < 2; ++ai)
#pragma unroll
            for (int m = 0; m < 4; ++m) { const int t = row0 + ai * HALF + m * 16;
#pragma unroll
                for (int bj = 0; bj < 2; ++bj) { const f32x4 v0 = acc[ai][bj][m][0] * sc, v1 = acc[ai][bj][m][1] * sc; const int c = col0 + bj * HALF;
                    u32x4 w; w.x = cvt_pk_bf16(v0[0], v0[1]); w.y = cvt_pk_bf16(v0[2], v0[3]); w.z = cvt_pk_bf16(v1[0], v1[1]); w.w = cvt_pk_bf16(v1[2], v1[3]);
                    bf16_t* p;
                    if (isk) { const int b = t >> 13, tt = t & 8191, h = c >> 6, d8 = (c & 63) >> 3;
                        p = KF + ((((size_t)(b * 16 + h) * 256 + (tt >> 5)) * 4 + (d8 >> 1)) * 64 + (d8 & 1) * 32 + (tt & 31)) * 8; }
                    else p = Q + (size_t)t * 1024 + c;
                    *(u32x4*)p = w; } }
    }
};
struct EpiVF {
    static constexpr bool PERM = true; static constexpr int NAUX = 0;
    bf16_t* VF;
    __device__ __forceinline__ void operator()(const f32x4 (&acc)[2][2][4][2], const Unit& u, int wr, int wc, int fr, int fq, const LAS float* aux) const {
        asm volatile("" : "+v"(fr), "+v"(fq));
        const int row0 = u.pm * BM + wr * 64 + fr; const int col0 = u.pn * BM + wc * 32 + 8 * fq;
#pragma unroll
        for (int ai = 0; ai < 2; ++ai)
#pragma unroll
            for (int m = 0; m < 4; ++m) { const int dg = row0 + ai * HALF + m * 16; const int h = dg >> 6, dd = dg & 63;
#pragma unroll
                for (int bj = 0; bj < 2; ++bj) { const f32x4 v0 = acc[ai][bj][m][0], v1 = acc[ai][bj][m][1]; const int t = col0 + bj * HALF;
                    const int b = t >> 13, tt = t & 8191, t32 = tt & 31;
                    bf16_t* p = VF + (((((size_t)(b * 16 + h) * 256 + (tt >> 5)) * 2 + (dd >> 5)) * 2 + (t32 >> 4)) * 64 + (dd & 31)) * 8 + ((t32 >> 3) & 1) * 4;
                    u32x2 w0, w1; w0.x = cvt_pk_bf16(v0[0], v0[1]); w0.y = cvt_pk_bf16(v0[2], v0[3]); w1.x = cvt_pk_bf16(v1[0], v1[1]); w1.y = cvt_pk_bf16(v1[2], v1[3]);
                    *(u32x2*)p = w0; *(u32x2*)(p + 32 * 8) = w1; } }
    }
};
__device__ __forceinline__ float swiglu1(float xg, float xl) {
    const float g = fminf(xg, 7.0f), l = __builtin_amdgcn_fmed3f(xl, -7.0f, 7.0f);
    const float s = frcp(1.0f + fexp2(-1.702f * LOG2E * g));
    return g * s * (l + 1.0f);
}
struct EpiSwiglu {
    static constexpr bool PERM = true; static constexpr int NAUX = 0;
    bf16_t* O; const float* b1;
    __device__ __forceinline__ void operator()(const f32x4 (&acc)[2][2][4][2], const Unit& u, int wr, int wc, int fr, int fq, const LAS float* aux) const {
        asm volatile("" : "+v"(fr), "+v"(fq));
        const int row0 = u.pm * BM + wr * 64 + fr; const int col0 = u.pn * BM + wc * 32 + 8 * fq;
        const float* bp = b1 + (size_t)u.e * 2048 + col0;
        f32x4 bv[2][2];
#pragma unroll
        for (int bj = 0; bj < 2; ++bj)
#pragma unroll
            for (int n = 0; n < 2; ++n) bv[bj][n] = *(const f32x4*)(bp + bj * HALF + 4 * n);
#pragma unroll
        for (int ai = 0; ai < 2; ++ai)
#pragma unroll
            for (int m = 0; m < 4; ++m) { bf16_t* rowp = O + (size_t)(row0 + ai * HALF + m * 16) * 1024 + (col0 >> 1);
#pragma unroll
                for (int bj = 0; bj < 2; ++bj) { const f32x4 v0 = acc[ai][bj][m][0] + bv[bj][0], v1 = acc[ai][bj][m][1] + bv[bj][1];
                    u32x2 w; w.x = cvt_pk_bf16(swiglu1(v0[0], v0[1]), swiglu1(v0[2], v0[3])); w.y = cvt_pk_bf16(swiglu1(v1[0], v1[1]), swiglu1(v1[2], v1[3]));
                    *(u32x2*)(rowp + bj * (HALF / 2)) = w; } }
    }
};
struct EpiSwiglu8 {
    static constexpr bool PERM = true; static constexpr int NAUX = 1;
    __device__ __forceinline__ const float* aux_src(const Unit& u, int) const { return b1 + (size_t)u.e * 2048 + u.pn * BM; }
    unsigned char* O; const float* b1;
    __device__ __forceinline__ void operator()(const f32x4 (&acc)[2][2][4][2], const Unit& u, int wr, int wc, int fr, int fq, const LAS float* aux) const {
        asm volatile("" : "+v"(fr), "+v"(fq));
        const int row0 = u.pm * BM + wr * 64 + fr; const int col0 = u.pn * BM + wc * 32 + 8 * fq;
        f32x4 bv[2][2];
#pragma unroll
        for (int bj = 0; bj < 2; ++bj)
#pragma unroll
            for (int n = 0; n < 2; ++n) bv[bj][n] = *(const LAS f32x4*)(aux + wc * 32 + 8 * fq + bj * HALF + 4 * n);
#pragma unroll
        for (int ai = 0; ai < 2; ++ai)
#pragma unroll
            for (int m = 0; m < 4; ++m) {
                f32x2 g[4], l[4], t[4];
#pragma unroll
                for (int bj = 0; bj < 2; ++bj)
#pragma unroll
                    for (int n = 0; n < 2; ++n) { const f32x4 v = acc[ai][bj][m][n] + bv[bj][n]; const int o = bj * 2 + n;
                        g[o] = (f32x2){fminf(v[0], 7.0f), fminf(v[2], 7.0f)}; l[o] = (f32x2){__builtin_amdgcn_fmed3f(v[1], -7.0f, 7.0f), __builtin_amdgcn_fmed3f(v[3], -7.0f, 7.0f)} + 1.0f; }
#pragma unroll
                for (int i = 0; i < 4; ++i) { const f32x2 a = g[i] * (-1.702f * LOG2E); t[i] = (f32x2){fexp2(a.x), fexp2(a.y)}; }
                __builtin_amdgcn_sched_barrier(0);
#pragma unroll
                for (int i = 0; i < 4; ++i) { const f32x2 d = t[i] + 1.0f; t[i] = (f32x2){frcp(d.x), frcp(d.y)}; }
                __builtin_amdgcn_sched_barrier(0);
#pragma unroll
                for (int i = 0; i < 4; ++i) t[i] = (g[i] * t[i]) * l[i];
                unsigned char* rowp = O + (size_t)(row0 + ai * HALF + m * 16) * 1024 + (col0 >> 1);
                *(unsigned*)rowp = pk4_fp8_nc(t[0].x, t[0].y, t[1].x, t[1].y); *(unsigned*)(rowp + HALF / 2) = pk4_fp8_nc(t[2].x, t[2].y, t[3].x, t[3].y);
            }
    }
};
struct EpiDown {
    static constexpr bool PERM = true; static constexpr int NAUX = 0;
    bf16_t* O; const float* b2; const float* gatel;
    __device__ __forceinline__ void operator()(const f32x4 (&acc)[2][2][4][2], const Unit& u, int wr, int wc, int fr, int fq, const LAS float* aux) const {
        asm volatile("" : "+v"(fr), "+v"(fq));
        const int rl0 = wr * 64 + fr; const int col0 = u.pn * BM + wc * 32 + 8 * fq;
        const float* bp = b2 + (size_t)u.e * 1024 + col0; const float* gp = gatel + (size_t)u.e * T + u.mt * 256 + rl0;
        f32x4 bv[2][2];
#pragma unroll
        for (int bj = 0; bj < 2; ++bj)
#pragma unroll
            for (int n = 0; n < 2; ++n) bv[bj][n] = *(const f32x4*)(bp + bj * HALF + 4 * n);
#pragma unroll
        for (int ai = 0; ai < 2; ++ai)
#pragma unroll
            for (int m = 0; m < 4; ++m) { const float gt = gp[ai * HALF + m * 16]; bf16_t* rowp = O + (size_t)(u.pm * BM + rl0 + ai * HALF + m * 16) * 1024 + col0;
#pragma unroll
                for (int bj = 0; bj < 2; ++bj) { const f32x4 v0 = (acc[ai][bj][m][0] + bv[bj][0]) * gt, v1 = (acc[ai][bj][m][1] + bv[bj][1]) * gt;
                    u32x4 w; w.x = cvt_pk_bf16(v0[0], v0[1]); w.y = cvt_pk_bf16(v0[2], v0[3]); w.z = cvt_pk_bf16(v1[0], v1[1]); w.w = cvt_pk_bf16(v1[2], v1[3]);
                    *(u32x4*)(rowp + bj * HALF) = w; } }
    }
};

struct EpiDown8 {
    static constexpr bool PERM = true; static constexpr int NAUX = 2;
    __device__ __forceinline__ const float* aux_src(const Unit& u, int k) const { return k == 0 ? b2 + (size_t)u.e * 1024 + u.pn * BM : gatel + (size_t)u.e * T + u.mt * 256; }
    unsigned char* O; const float* b2; const float* gatel;
    __device__ __forceinline__ void operator()(const f32x4 (&acc)[2][2][4][2], const Unit& u, int wr, int wc, int fr, int fq, const LAS float* aux) const {
        asm volatile("" : "+v"(fr), "+v"(fq));
        const int rl0 = wr * 64 + fr; const int col0 = u.pn * BM + wc * 32 + 8 * fq;
        const LAS float* gp = aux + 256 + rl0;
        f32x4 bv[2][2];
#pragma unroll
        for (int bj = 0; bj < 2; ++bj)
#pragma unroll
            for (int n = 0; n < 2; ++n) bv[bj][n] = *(const LAS f32x4*)(aux + wc * 32 + 8 * fq + bj * HALF + 4 * n);
#pragma unroll
        for (int ai = 0; ai < 2; ++ai)
#pragma unroll
            for (int m = 0; m < 4; ++m) { const float gt = gp[ai * HALF + m * 16] * 16.0f; unsigned char* rowp = O + (size_t)(u.pm * BM + rl0 + ai * HALF + m * 16) * 1024 + col0;
#pragma unroll
                for (int bj = 0; bj < 2; ++bj) { const f32x4 v0 = (acc[ai][bj][m][0] + bv[bj][0]) * gt, v1 = (acc[ai][bj][m][1] + bv[bj][1]) * gt;
                    u32x2 w; w.x = pk4_fp8(v0[0], v0[1], v0[2], v0[3]); w.y = pk4_fp8(v1[0], v1[1], v1[2], v1[3]);
                    *(u32x2*)(rowp + bj * HALF) = w; } }
    }
};

template <class Epi, class Sched, int GATHER, int F8 = 0>
__device__ __forceinline__ void gemm_phase(LAS unsigned char* lds, const Gemm g, const Sched& S, const Epi& E, const int* tokl, LAS unsigned* rowtab, const int tid) {
    const int wid = __builtin_amdgcn_readfirstlane(tid >> 6), lane = tid & 63, wr = wid >> 2, wc = wid & 3, fr = lane & 15, fq = lane >> 4;
    const int K = g.K, nt = K / BK;
    unsigned voffA[2], voffB[2];
#pragma unroll
    for (int i = 0; i < 2; ++i) { int R, C; stage_rc(tid * 16 + i * 8192, R, C); const int Rb = Epi::PERM ? ((R & ~31) + perm32(R & 31)) : R;
        voffA[i] = (unsigned)(R * K + C) * 2u; voffB[i] = (unsigned)(Rb * K + C) * 2u; }
    const size_t kstep = (size_t)(BK * 2);
    const size_t hstep = (size_t)HALF * K * 2;
    const size_t tstep = 2 * hstep;
    const unsigned ldsw = (unsigned)wid * 1024u;
    const int aoff = lds_byte(wr * 64 + fr, fq * 8), boff = lds_byte(wc * 32 + fr, fq * 8);
    unsigned vC[2][2];
#define PG8_SA(b, h) (((b) * 2 + (h)) * HTB)
#define PG8_SB(b, h) ((4 + (b) * 2 + (h)) * HTB)
#define PG8_GLDS(gp, bufoff, i_) __builtin_amdgcn_global_load_lds((const unsigned*)(gp), (LAS unsigned*)(lds + (bufoff) + ldsw + (i_) * 8192), 16, 0, 0)
#define PG8_STAGE_B(bufoff, gbase) do { _Pragma("unroll") for (int _i = 0; _i < 2; ++_i) PG8_GLDS((const char*)(gbase) + voffB[_i], bufoff, _i); } while (0)
#define PG8_STAGE_A(bufoff, gbase, h, nx) do { _Pragma("unroll") for (int _i = 0; _i < 2; ++_i) { \
        if constexpr (GATHER) { PG8_GLDS((const char*)(gbase) + vC[h][_i], bufoff, _i); } \
        else PG8_GLDS((const char*)(gbase) + (h) * hstep + voffA[_i], bufoff, _i); } } while (0)
#define PG8_LDA(dst, b, h) do { _Pragma("unroll") for (int m = 0; m < 4; ++m) _Pragma("unroll") for (int k = 0; k < 2; ++k) dst[m][k] = *(const LAS bf16x8*)(lds + PG8_SA(b, h) + aoff + m * 2048 + k * 1024); } while (0)
#define PG8_LDB(dst, b, h) do { _Pragma("unroll") for (int n = 0; n < 2; ++n) _Pragma("unroll") for (int k = 0; k < 2; ++k) dst[n][k] = *(const LAS bf16x8*)(lds + PG8_SB(b, h) + boff + n * 2048 + k * 1024); } while (0)
#define PG8_MMA(ai, bj, At, Bt) do { __builtin_amdgcn_s_setprio(1); _Pragma("unroll") for (int m = 0; m < 4; ++m) _Pragma("unroll") for (int n = 0; n < 2; ++n) { \
        if constexpr (F8 != 0) {   \
            const i32x4 _b0 = __builtin_bit_cast(i32x4, Bt[n][0]), _b1 = __builtin_bit_cast(i32x4, Bt[n][1]), _a0 = __builtin_bit_cast(i32x4, At[m][0]), _a1 = __builtin_bit_cast(i32x4, At[m][1]); \
            const i32x8 _bb = __builtin_shufflevector(_b0, _b1, 0, 1, 2, 3, 4, 5, 6, 7), _aa = __builtin_shufflevector(_a0, _a1, 0, 1, 2, 3, 4, 5, 6, 7); \
            acc[ai][bj][m][n] = __builtin_amdgcn_mfma_scale_f32_16x16x128_f8f6f4(_bb, _aa, acc[ai][bj][m][n], 0, 0, 0, (int)(F8 * 0x01010101u), 0, 0x7f7f7f7f); \
        } else { _Pragma("unroll") for (int k = 0; k < 2; ++k) acc[ai][bj][m][n] = __builtin_amdgcn_mfma_f32_16x16x32_bf16(Bt[n][k], At[m][k], acc[ai][bj][m][n], 0, 0, 0); } } \
        __builtin_amdgcn_s_setprio(0); } while (0)
#define PG8_WAIT_V(n) asm volatile("s_waitcnt vmcnt(" #n ")" ::: "memory")
#define PG8_WAIT_L(n) asm volatile("s_waitcnt lgkmcnt(" #n ")" ::: "memory")
#define PG8_BAR __builtin_amdgcn_s_barrier()
#define PG8_SCHED __builtin_amdgcn_sched_barrier(0)
#define PG8_ROWDMA(u_, slot_) do { if (GATHER == 1 && wid < 4) __builtin_amdgcn_global_load_lds((const unsigned*)(tokl + (size_t)(u_).e * T + (u_).mt * 256 + wid * 64 + lane), (LAS unsigned*)(rowtab + (slot_) * 256 + wid * 64), 4, 0, 0); } while (0)
#define PG8_ROWOFF(dst, u_, slot_) do { _Pragma("unroll") for (int _i = 0; _i < 2; ++_i) { int _R, _C; stage_rc(tid * 16 + _i * 8192, _R, _C); _Pragma("unroll") for (int _h = 0; _h < 2; ++_h) { const int _r = _h * HALF + _R; \
        unsigned _t; if constexpr (GATHER == 1) { _t = rowtab[(slot_) * 256 + _r]; _t = (_r < (u_).valid) ? _t : 0u; } else _t = (unsigned)((u_).pm * 256 + _r); \
        dst[_h][_i] = _t * (unsigned)(K * 2) + (unsigned)_C * 2u; } } } while (0)
    Unit cur, nxt; int ui = 0;
    if (!S.next(0, cur)) return;
    f32x4 acc[2][2][4][2];
#pragma unroll
    for (int a = 0; a < 2; ++a)
#pragma unroll
        for (int b = 0; b < 2; ++b)
#pragma unroll
            for (int m = 0; m < 4; ++m)
#pragma unroll
                for (int n = 0; n < 2; ++n) acc[a][b][m][n] = (f32x4){0.f, 0.f, 0.f, 0.f};
    bf16x8 At[4][2], B0[2][2], B1[2][2];
    const char* cA = GATHER ? (const char*)g.A : (const char*)g.A + (size_t)cur.pm * tstep;
    const char* cB = (const char*)g.Bt + ((size_t)cur.e * g.brows + (size_t)cur.pn * BM) * K * 2;
    if constexpr (GATHER != 0) {
        PG8_ROWDMA(cur, 0); PG8_WAIT_V(0); __syncthreads();
        PG8_ROWOFF(vC, cur, 0);
        PG8_WAIT_L(0);
    }
    PG8_STAGE_B(PG8_SB(0, 0), cB); PG8_STAGE_B(PG8_SB(0, 1), cB + hstep); PG8_STAGE_A(PG8_SA(0, 0), cA, 0, false); PG8_STAGE_A(PG8_SA(0, 1), cA, 1, false);
    if (wr == 1) PG8_BAR;
    PG8_WAIT_V(2); PG8_BAR;
    PG8_STAGE_B(PG8_SB(1, 0), cB + kstep); PG8_STAGE_A(PG8_SA(1, 0), cA + kstep, 0, false); PG8_STAGE_B(PG8_SB(1, 1), cB + hstep + kstep);
    PG8_WAIT_V(6); PG8_BAR;
    for (;;) {
        if constexpr (Epi::NAUX > 0) { if (wid < Epi::NAUX) __builtin_amdgcn_global_load_lds((const unsigned*)(E.aux_src(cur, wid) + lane * 4), (LAS unsigned*)(lds + AUX_OFF + (ui & 1) * 2048 + wid * 1024), 16, 0, 0); }
        const bool has_next = S.next(ui + 1, nxt);
        if constexpr (GATHER) { if (has_next) PG8_ROWDMA(nxt, (ui + 1) & 1); }
        const char* nA = has_next ? (GATHER ? (const char*)g.A : (const char*)g.A + (size_t)nxt.pm * tstep) : cA;
        const char* nB = has_next ? (const char*)g.Bt + ((size_t)nxt.e * g.brows + (size_t)nxt.pn * BM) * K * 2 : cB;
#pragma unroll 1
        for (int t = 0; t < nt; t += 2) {
            const bool last = (t == nt - 2);
            const char* a1 = cA + (size_t)(t + 1) * kstep;
            const char* a2 = last ? nA : cA + (size_t)(t + 2) * kstep; const char* b2 = last ? nB : cB + (size_t)(t + 2) * kstep;
            const char* a3 = a2 + kstep; const char* b3 = b2 + kstep;
            PG8_LDB(B0, 0, 0); PG8_LDB(B1, 0, 1); PG8_SCHED; PG8_LDA(At, 0, 0); PG8_STAGE_A(PG8_SA(1, 1), a1, 1, false);
            if constexpr (GATHER) { if (last && has_next) { PG8_ROWOFF(vC, nxt, (ui + 1) & 1); } }
            PG8_WAIT_V(8); PG8_WAIT_L(0); PG8_BAR; PG8_MMA(0, 0, At, B0); PG8_MMA(0, 1, At, B1); PG8_BAR; PG8_SCHED;
            PG8_LDA(At, 0, 1); PG8_STAGE_B(PG8_SB(0, 0), b2); PG8_STAGE_B(PG8_SB(0, 1), b2 + hstep); PG8_STAGE_A(PG8_SA(0, 0), a2, 0, last);
            PG8_WAIT_V(8); PG8_WAIT_L(0); PG8_BAR; PG8_MMA(1, 0, At, B0); PG8_MMA(1, 1, At, B1); PG8_BAR; PG8_SCHED;
            PG8_LDB(B0, 1, 0); PG8_LDB(B1, 1, 1); PG8_SCHED; PG8_LDA(At, 1, 0); PG8_STAGE_A(PG8_SA(0, 1), a2, 1, last);
            PG8_WAIT_V(8); PG8_WAIT_L(0); PG8_BAR; PG8_MMA(0, 0, At, B0); PG8_MMA(0, 1, At, B1); PG8_BAR; PG8_SCHED;
            PG8_LDA(At, 1, 1); PG8_STAGE_B(PG8_SB(1, 0), b3); PG8_STAGE_B(PG8_SB(1, 1), b3 + hstep); PG8_STAGE_A(PG8_SA(1, 0), a3, 0, last);
            PG8_WAIT_V(8); PG8_WAIT_L(0); PG8_BAR; PG8_MMA(1, 0, At, B0); PG8_MMA(1, 1, At, B1); PG8_BAR; PG8_SCHED;
        }
        if (wr == 0) PG8_BAR;
        E(acc, cur, wr, wc, fr, fq, (const LAS float*)(lds + AUX_OFF + (ui & 1) * 2048));
#if defined(PROBE_EPI2)
        E(acc, cur, wr, wc, fr, fq, (const LAS float*)(lds + AUX_OFF + (ui & 1) * 2048));
#endif
        if (!has_next) break;
#pragma unroll
        for (int a = 0; a < 2; ++a)
#pragma unroll
            for (int b = 0; b < 2; ++b)
#pragma unroll
                for (int m = 0; m < 4; ++m)
#pragma unroll
                    for (int n = 0; n < 2; ++n) acc[a][b][m][n] = (f32x4){0.f, 0.f, 0.f, 0.f};
        cur = nxt; cA = nA; cB = nB; ++ui;
        if (wr == 1) PG8_BAR;
    }
    PG8_WAIT_V(0);
    PG8_BAR;
#undef PG8_SA
#undef PG8_SB
#undef PG8_GLDS
#undef PG8_STAGE_A
#undef PG8_STAGE_B
#undef PG8_LDA
#undef PG8_LDB
#undef PG8_MMA
#undef PG8_WAIT_V
#undef PG8_WAIT_L
#undef PG8_BAR
#undef PG8_SCHED
#undef PG8_ROWDMA
#undef PG8_ROWOFF
}
}

constexpr size_t MiB = 1u << 20;
constexpr size_t WS_CTL = 0, CTL_ZERO_BYTES = 128 * 1024;
constexpr size_t WS_TOKL = 1 * MiB, WS_GATEL = 5 * MiB, WS_TINFO = 9 * MiB;
constexpr size_t WS_WIN0T = 10 * MiB, WS_WO0T = 15 * MiB, WS_WIN1T = 17 * MiB, WS_WO1T = 23 * MiB;
constexpr size_t WS_W1T = 26 * MiB, WS_W2T = 154 * MiB, WS_XB = 218 * MiB;
constexpr size_t WS_SA = 282 * MiB, WS_SB = 554 * MiB, WS_XB8 = 826 * MiB, WS_END = 858 * MiB;
constexpr int CW_BAR = 4096, CW_CNT = 16384;

constexpr int RING_BYTES = 131072;
constexpr int ROWTAB_OFF = RING_BYTES;
constexpr int MOETAB_OFF = ROWTAB_OFF + 2048;
constexpr int MISC_OFF = MOETAB_OFF + 512;
constexpr int LDS_BYTES = 147456;
static_assert(pg8::AUX_OFF == MISC_OFF + 256 && pg8::AUX_OFF + 4096 <= LDS_BYTES, "LDS map");

#define XB_TMO      128
#define XB_XCNT(j)  (256  + 64 * (j))
#define XB_XSUB(j)  (1280 + 64 * (j))
#define XB_XGEN(j)  (2304 + 64 * (j))
#define XB_TOP      3328
#define XB_TOPGEN   3392
#define XCD_BAR_WORDS 3456
#define XB_SPIN_CAP (1u << 20)
__device__ __forceinline__ unsigned xb_ld(unsigned* p)              { return __hip_atomic_load(p, __ATOMIC_RELAXED, __HIP_MEMORY_SCOPE_AGENT); }
__device__ __forceinline__ unsigned xb_add(unsigned* p, unsigned v) { return __hip_atomic_fetch_add(p, v, __ATOMIC_RELAXED, __HIP_MEMORY_SCOPE_AGENT); }
__device__ __forceinline__ unsigned xb_xcc_id() { return (unsigned)__builtin_amdgcn_s_getreg((3 << 11) | 20) & 0xFu; }
#define XB_SPIN(cond, bar) do { unsigned _sp = 0; while (cond) { __builtin_amdgcn_s_sleep(1); \
    if ((++_sp & 255u) == 0u) { if (xb_ld(&(bar)[XB_TMO])) break; if (_sp > XB_SPIN_CAP) { atomicAdd(&(bar)[XB_TMO], 1u); break; } } } } while (0)
struct XcdBarrier { unsigned* bar; unsigned x; volatile LAS unsigned* st; int wave; };
__device__ __forceinline__ XcdBarrier xcd_barrier_post(unsigned* bar, volatile LAS unsigned* st) {
    XcdBarrier b; b.bar = bar; b.x = xb_xcc_id(); b.st = st; b.wave = __builtin_amdgcn_readfirstlane(threadIdx.x >> 6);
    if (threadIdx.x == 0) (void)xb_add(&bar[XB_XCNT(b.x)], 1u);
    return b;
}
__device__ __forceinline__ void xcd_barrier_complete(unsigned* bar, unsigned x, unsigned& nloc, unsigned& nx) {
    const unsigned G = gridDim.x * gridDim.y * gridDim.z;
    unsigned sum, cnt, mine, sp = 0u;
    for (;;) {
        sum = 0u; cnt = 0u; mine = 0u;
#pragma unroll
        for (unsigned j = 0; j < 16; ++j) { const unsigned c = xb_ld(&bar[XB_XCNT(j)]); sum += c; cnt += (c > 0u) ? 1u : 0u; mine = (j == x) ? c : mine; }
        if (sum == G) break;
        __builtin_amdgcn_s_sleep(1);
        if ((++sp & 255u) == 0u) { if (xb_ld(&bar[XB_TMO])) break; if (sp > XB_SPIN_CAP) { atomicAdd(&bar[XB_TMO], 1u); break; } }
    }
    nloc = mine > 0u ? mine : 1u; nx = cnt > 0u ? cnt : 1u;
}
__device__ __forceinline__ void xcd_barrier(const XcdBarrier& b) {
    asm volatile("s_waitcnt vmcnt(0)" ::: "memory");
    __syncthreads();
    if (b.wave == 0 && lane_id_asm() == 0) {
        unsigned* bar = b.bar;
        __builtin_amdgcn_s_waitcnt(0);
        unsigned nloc = b.st[0], nx = b.st[1];
        if (nloc == 0u) { xcd_barrier_complete(bar, b.x, nloc, nx); b.st[0] = nloc; b.st[1] = nx; }
        const unsigned old = xb_add(&bar[XB_XSUB(b.x)], 1u);
        const unsigned gen = old / nloc;
        if (old + 1u == (gen + 1u) * nloc) {
            __builtin_amdgcn_fence(__ATOMIC_RELEASE, "agent");
            asm volatile("s_waitcnt vmcnt(0)" ::: "memory");
            const unsigned og = xb_add(&bar[XB_TOP], 1u);
            const unsigned tg = og / nx;
            if (og + 1u == (tg + 1u) * nx) xb_add(&bar[XB_TOPGEN], 1u);
            else XB_SPIN(xb_ld(&bar[XB_TOPGEN]) == tg, bar);
            __builtin_amdgcn_fence(__ATOMIC_ACQUIRE, "agent");
            xb_add(&bar[XB_XGEN(b.x)], 1u);
            asm volatile("s_waitcnt vmcnt(0)" ::: "memory");
        } else {
            XB_SPIN(xb_ld(&bar[XB_XGEN(b.x)]) == gen, bar);
            __builtin_amdgcn_fence(__ATOMIC_ACQUIRE, "agent");
            asm volatile("s_waitcnt vmcnt(0)" ::: "memory");
        }
    }
    __syncthreads();
}

#define LDS_WAIT() asm volatile("s_waitcnt lgkmcnt(0)" ::: "memory")
#define LDS_BARRIER() do { asm volatile("s_waitcnt lgkmcnt(0)" ::: "memory"); __builtin_amdgcn_s_barrier(); asm volatile("" ::: "memory"); } while (0)
__device__ __forceinline__ float wave_sum(float v) {
#pragma unroll
    for (int o = 1; o < 64; o <<= 1) v += __shfl_xor(v, o);
    return v;
}
__device__ __forceinline__ void transpose_item(const float* W, int ldw, bf16_t* WT, int ldt, int k0, int n0, int dst_row0, LAS float* scr, int lane, int rstride = 1) {
#pragma unroll 8
    for (int i = 0; i < 32; ++i) { const int kk = 2 * i + (lane >> 5); scr[kk * 33 + (lane & 31)] = W[(size_t)(k0 + kk) * ldw + n0 + (lane & 31)]; }
    LDS_WAIT(); asm volatile("" ::: "memory");
    const int c = lane & 7;
#pragma unroll
    for (int j = 0; j < 4; ++j) { const int n = (lane >> 3) + 8 * j; const LAS float* s = scr + (8 * c) * 33 + n;
        u32x4 o; o.x = pk2(s[0 * 33], s[1 * 33]); o.y = pk2(s[2 * 33], s[3 * 33]); o.z = pk2(s[4 * 33], s[5 * 33]); o.w = pk2(s[6 * 33], s[7 * 33]);
        *(u32x4*)(WT + (size_t)(dst_row0 + n * rstride) * ldt + k0 + 8 * c) = o; }
    LDS_WAIT(); asm volatile("" ::: "memory");
}
constexpr int W1_SH = 6, W2_SH = 7;
__device__ __forceinline__ void conv_moe_wg(const float* w1, const float* w2, unsigned char* W1T, unsigned char* W2T, LAS float* buf, int bx, int G, int tid, int j0, int j1) {
    constexpr int I1 = 8 * 16, I2 = 8 * 8, NIT = NE * (I1 + I2);
    const int lrow = tid >> 5, lcol = (tid & 31) * 4;
    f32x4 ra[8], rb[8];
#define CM_SRC(it_, src_, ldw_) const float* src_; int ldw_; { if ((it_) < NE * I1) { const int e_ = (it_) >> 7, q_ = (it_) & 127, kb_ = q_ >> 4, nb_ = q_ & 15; ldw_ = 2048; src_ = w1 + (size_t)e_ * 1024 * 2048 + (size_t)(128 * kb_) * 2048 + 128 * nb_; } \
        else { const int j_ = (it_) - NE * I1, e_ = j_ >> 6, q_ = j_ & 63, kb_ = q_ >> 3, nb_ = q_ & 7; ldw_ = 1024; src_ = w2 + (size_t)e_ * 1024 * 1024 + (size_t)(128 * kb_) * 1024 + 128 * nb_; } }
#define CM_LOAD(R_, it_) do { CM_SRC(it_, sp_, lw_); _Pragma("unroll") for (int i = 0; i < 8; ++i) R_[i] = __builtin_nontemporal_load((const f32x4*)(sp_ + (size_t)(lrow + 16 * i) * lw_ + lcol)); } while (0)
#define CM_ITEM(R_, it_) do { \
        _Pragma("unroll") for (int i = 0; i < 8; ++i) *(LAS f32x4*)(buf + (lrow + 16 * i) * 132 + (lcol ^ (8 * (i & 3)))) = R_[i];     \
        __syncthreads(); \
        if ((it_) + 2 * G < itend) CM_LOAD(R_, (it_) + 2 * G); \
        unsigned char* dst; float sc; \
        if ((it_) < NE * I1) { const int e = (it_) >> 7, q = (it_) & 127, kb = q >> 4, nb = q & 15; dst = W1T + (size_t)e * 2048 * 1024 + (size_t)(128 * nb) * 1024 + 128 * kb; sc = (float)(1 << W1_SH); } \
        else { const int j = (it_) - NE * I1, e = j >> 6, q = j & 63, kb = q >> 3, nb = q & 7; dst = W2T + (size_t)e * 1024 * 1024 + (size_t)(128 * nb) * 1024 + 128 * kb; sc = (float)(1 << W2_SH); } \
        const int c = tid & 7; \
        _Pragma("unroll") for (int p = 0; p < 2; ++p) { const int nn = (tid >> 3) + 64 * p; const LAS float* sp = buf + (16 * c) * 132 + (nn ^ (8 * (c & 3))); \
            u32x4 o; \
            o.x = pk4_fp8(sp[0 * 132] * sc, sp[1 * 132] * sc, sp[2 * 132] * sc, sp[3 * 132] * sc); o.y = pk4_fp8(sp[4 * 132] * sc, sp[5 * 132] * sc, sp[6 * 132] * sc, sp[7 * 132] * sc); \
            o.z = pk4_fp8(sp[8 * 132] * sc, sp[9 * 132] * sc, sp[10 * 132] * sc, sp[11 * 132] * sc); o.w = pk4_fp8(sp[12 * 132] * sc, sp[13 * 132] * sc, sp[14 * 132] * sc, sp[15 * 132] * sc); \
            *(u32x4*)(dst + (size_t)nn * 1024 + 16 * c) = o; } \
        __syncthreads(); } while (0)
    int it = bx + j0 * G; const int itend = (bx + j1 * G) < NIT ? (bx + j1 * G) : NIT;
    __syncthreads();
    if (it < itend) CM_LOAD(ra, it);
    if (it + G < itend) CM_LOAD(rb, it + G);
    for (; it < itend; it += 2 * G) {
        CM_ITEM(ra, it);
        if (it + G < itend) CM_ITEM(rb, it + G);
    }
#undef CM_ITEM
#undef CM_SRC
#undef CM_LOAD
}
__device__ __forceinline__ void ln_row(f32x4 (&v)[4], const float* w, const float* b, int lane) {
    float s = 0.f;
#pragma unroll
    for (int j = 0; j < 4; ++j) s += (v[j].x + v[j].y) + (v[j].z + v[j].w);
    const float mean = wave_sum(s) * (1.f / D); float s2 = 0.f;
#pragma unroll
    for (int j = 0; j < 4; ++j) { v[j] = v[j] - mean; s2 += (v[j].x * v[j].x + v[j].y * v[j].y) + (v[j].z * v[j].z + v[j].w * v[j].w); }
    const float rstd = 1.f / sqrtf(wave_sum(s2) * (1.f / D) + LN_EPS);
#pragma unroll
    for (int j = 0; j < 4; ++j) { const f32x4 ww = *(const f32x4*)(w + 4 * lane + 256 * j), bb = *(const f32x4*)(b + 4 * lane + 256 * j); v[j] = v[j] * rstd * ww + bb; }
}
__device__ __forceinline__ void moe_table(const unsigned* cnt, LAS int* tab, int tid) {
    if (tid < 32) tab[33 + tid] = (int)__hip_atomic_load(cnt + tid, __ATOMIC_RELAXED, __HIP_MEMORY_SCOPE_AGENT);
    __syncthreads();
    if (tid == 0) { int p = 0; for (int e = 0; e < 32; ++e) { tab[e] = p; p += (tab[33 + e] + 255) >> 8; } tab[32] = p; }
    __syncthreads();
}

constexpr int HG_KUT = 0, HG_DD = 18432, HG_QH = 20480, HG_KD = 37888, HG_OB = 55296, HG_RED = 89088;
template <int MODE>
__device__ __forceinline__ void hgrn_unit(LAS unsigned char* lds, int unit, const bf16_t* PROJ, const bf16_t* IT, float* SLOC, float* DTOT, const float* lbl, const float* anw, bf16_t* AO, int tid, int wave, int lane) {
    const int bh = unit >> 5, sc = unit & 31, b = bh >> 2, h = bh & 3;
    const int t0 = sc * 256;
    const int si = tid >> 7, dk = tid & 127;
    const int g = lane >> 4, c16 = lane & 15;
    float lb;
    { const float l0 = lbl[h * 128 + dk], l1 = lbl[512 + h * 128 + dk], l2 = lbl[1024 + h * 128 + dk]; const float m = fmaxf(l0, fmaxf(l1, l2));
      const float e0 = __expf(l0 - m), e1 = __expf(l1 - m), e2 = __expf(l2 - m); lb = e0 / (e0 + e1 + e2); }
    const float oml = 1.0f - lb;
    f32x4 S[8];
#pragma unroll
    for (int tau = 0; tau < 8; ++tau) {
        if (MODE == 1) {
#pragma unroll
            for (int r = 0; r < 4; ++r) S[tau][r] = SLOC[(size_t)unit * 16384 + (16 * tau + 4 * g + r) * 128 + 16 * wave + c16];
        } else S[tau] = (f32x4){0.f, 0.f, 0.f, 0.f};
    }
    float lsum = 1.f;
    unsigned qz[16]; u32x2 vfn[4];
    const unsigned rlo = (unsigned)(16 * si * 2048 + 2 * dk);
    { const bf16_t* sb = PROJ + ((size_t)b * SEQ + t0) * 2048 + h * 256;
#pragma unroll
      for (int j = 0; j < 16; ++j) qz[j] = *(const unsigned*)(sb + (size_t)j * 2048 + rlo);
      const bf16_t* vp = IT + (size_t)(h * 128 + 16 * wave + c16) * T + (size_t)b * SEQ + t0 + 4 * g;
#pragma unroll
      for (int i = 0; i < 4; ++i) vfn[i] = *(const u32x2*)(vp + 16 * i); }
#pragma unroll 1
    for (int c4 = 0; c4 < 4; ++c4) {
        const int tc = t0 + 64 * c4;
        u32x2 vf[4];
#pragma unroll
        for (int i = 0; i < 4; ++i) vf[i] = vfn[i];
        {
            float cp = 1.f, kdf[16];
#pragma unroll
            for (int j = 0; j < 16; ++j) {
                const float z = bfhi(qz[j]);
                const float s = frcp(1.0f + fexp2(-LOG2E * z));
                const float f = lb + oml * s, kk = oml * (1.0f - s);
                cp *= f; kdf[j] = kk * frcp(cp);
                if (MODE == 1) {
                    const float q = bflo(qz[j]);
                    const unsigned qh = pk2(q * cp, 0.f), kd = pk2(kdf[j], 0.f);
                    *(LAS bf16_t*)(lds + HG_QH + (16 * si + j) * 272 + dk * 2) = (bf16_t)(qh & 0xffffu);
                    *(LAS bf16_t*)(lds + HG_KD + (16 * si + j) * 272 + dk * 2) = (bf16_t)(kd & 0xffffu);
                }
            }
            if (c4 < 3) {
                const bf16_t* sb = PROJ + ((size_t)b * SEQ + tc + 64) * 2048 + h * 256;
#pragma unroll
                for (int j = 0; j < 16; ++j) qz[j] = *(const unsigned*)(sb + (size_t)j * 2048 + rlo);
                const bf16_t* vp = IT + (size_t)(h * 128 + 16 * wave + c16) * T + (size_t)b * SEQ + tc + 64 + 4 * g;
#pragma unroll
                for (int i = 0; i < 4; ++i) vfn[i] = *(const u32x2*)(vp + 16 * i);
            }
            const float dl = cp; lsum *= dl;
            u32x4 w0, w1;
            w0.x = pk2(kdf[0] * dl, kdf[1] * dl); w0.y = pk2(kdf[2] * dl, kdf[3] * dl); w0.z = pk2(kdf[4] * dl, kdf[5] * dl); w0.w = pk2(kdf[6] * dl, kdf[7] * dl);
            w1.x = pk2(kdf[8] * dl, kdf[9] * dl); w1.y = pk2(kdf[10] * dl, kdf[11] * dl); w1.z = pk2(kdf[12] * dl, kdf[13] * dl); w1.w = pk2(kdf[14] * dl, kdf[15] * dl);
            *(LAS u32x4*)(lds + HG_KUT + dk * 144 + si * 32) = w0;
            *(LAS u32x4*)(lds + HG_KUT + dk * 144 + si * 32 + 16) = w1;
            *(LAS float*)(lds + HG_DD + (si * 128 + dk) * 4) = dl;
        }
        LDS_BARRIER();
#pragma unroll
        for (int i = 0; i < 4; ++i) {
            bf16x8 vb; { const s16x4 t4 = __builtin_bit_cast(s16x4, vf[i]); vb = (bf16x8){t4[0], t4[1], t4[2], t4[3], 0, 0, 0, 0}; }
            if (MODE == 1) {
                f32x4 X = (f32x4){0.f, 0.f, 0.f, 0.f};
#pragma unroll
                for (int m = 0; m < 4; ++m) {
                    const bf16x8 a = *(const LAS bf16x8*)(lds + HG_KD + (16 * i + c16) * 272 + (32 * m + 8 * g) * 2);
                    const bf16x8 bq = *(const LAS bf16x8*)(lds + HG_QH + (16 * i + c16) * 272 + (32 * m + 8 * g) * 2);
                    X = __builtin_amdgcn_mfma_f32_16x16x32_bf16(a, bq, X, 0, 0, 0);
                }
#pragma unroll
                for (int r = 0; r < 4; ++r) X[r] = (4 * g + r <= c16) ? X[r] : 0.f;
                bf16x8 xa; { u32x2 p; p.x = pk2(X[0], X[1]); p.y = pk2(X[2], X[3]); const s16x4 t4 = __builtin_bit_cast(s16x4, p); xa = (bf16x8){t4[0], t4[1], t4[2], t4[3], 0, 0, 0, 0}; }
                f32x4 O = (f32x4){0.f, 0.f, 0.f, 0.f};
                O = __builtin_amdgcn_mfma_f32_16x16x32_bf16(xa, vb, O, 0, 0, 0);
#pragma unroll
                for (int m = 0; m < 4; ++m) {
                    u32x4 bs; bs.x = pk2(S[2 * m][0], S[2 * m][1]); bs.y = pk2(S[2 * m][2], S[2 * m][3]); bs.z = pk2(S[2 * m + 1][0], S[2 * m + 1][1]); bs.w = pk2(S[2 * m + 1][2], S[2 * m + 1][3]);
                    const u32x2 q0 = *(const LAS u32x2*)(lds + HG_QH + (16 * i + c16) * 272 + (32 * m + 4 * g) * 2);
                    const u32x2 q1 = *(const LAS u32x2*)(lds + HG_QH + (16 * i + c16) * 272 + (32 * m + 16 + 4 * g) * 2);
                    u32x4 aq; aq.x = q0.x; aq.y = q0.y; aq.z = q1.x; aq.w = q1.y;
                    O = __builtin_amdgcn_mfma_f32_16x16x32_bf16(__builtin_bit_cast(bf16x8, aq), __builtin_bit_cast(bf16x8, bs), O, 0, 0, 0);
                }
#pragma unroll
                for (int r = 0; r < 4; ++r) *(LAS float*)(lds + HG_OB + ((16 * i + 4 * g + r) * 132 + 16 * wave + c16) * 4) = O[r];
            }
#pragma unroll
            for (int tau = 0; tau < 8; ++tau) {
                const f32x4 dd = *(const LAS f32x4*)(lds + HG_DD + (i * 128 + 16 * tau + 4 * g) * 4);
                S[tau] = S[tau] * dd;
                const u32x2 k2 = *(const LAS u32x2*)(lds + HG_KUT + (16 * tau + c16) * 144 + (16 * i + 4 * g) * 2);
                u32x4 ak; ak.x = k2.x; ak.y = k2.y; ak.z = 0u; ak.w = 0u;
                S[tau] = __builtin_amdgcn_mfma_f32_16x16x32_bf16(__builtin_bit_cast(bf16x8, ak), vb, S[tau], 0, 0, 0);
            }
        }
        LDS_BARRIER();
        if (MODE == 1) {
            const int tl = tid >> 3, part = tid & 7;
            float o[16]; float ssq = 0.f;
#pragma unroll
            for (int q4 = 0; q4 < 4; ++q4) { const f32x4 v = *(const LAS f32x4*)(lds + HG_OB + (tl * 132 + 16 * part + 4 * q4) * 4);
                o[4 * q4] = v.x; o[4 * q4 + 1] = v.y; o[4 * q4 + 2] = v.z; o[4 * q4 + 3] = v.w; ssq += (v.x * v.x + v.y * v.y) + (v.z * v.z + v.w * v.w); }
            ssq += __shfl_xor(ssq, 1); ssq += __shfl_xor(ssq, 2); ssq += __shfl_xor(ssq, 4);
            const float rr = 1.0f / sqrtf(ssq * (1.0f / 128.0f) + RMS_EPS);
            const size_t row = (size_t)b * SEQ + tc + tl;
            const u32x4 g0 = *(const u32x4*)(PROJ + row * 2048 + 1024 + h * 128 + 16 * part), g1 = *(const u32x4*)(PROJ + row * 2048 + 1024 + h * 128 + 16 * part + 8);
            float gv[16];
            gv[0] = bflo(g0.x); gv[1] = bfhi(g0.x); gv[2] = bflo(g0.y); gv[3] = bfhi(g0.y); gv[4] = bflo(g0.z); gv[5] = bfhi(g0.z); gv[6] = bflo(g0.w); gv[7] = bfhi(g0.w);
            gv[8] = bflo(g1.x); gv[9] = bfhi(g1.x); gv[10] = bflo(g1.y); gv[11] = bfhi(g1.y); gv[12] = bflo(g1.z); gv[13] = bfhi(g1.z); gv[14] = bflo(g1.w); gv[15] = bfhi(g1.w);
            float r16[16];
#pragma unroll
            for (int j = 0; j < 16; ++j) { const float gg = gv[j]; const float sg = gg * frcp(1.0f + fexp2(-LOG2E * gg)); r16[j] = o[j] * rr * anw[16 * part + j] * sg; }
            u32x4 o0, o1;
            o0.x = pk2(r16[0], r16[1]); o0.y = pk2(r16[2], r16[3]); o0.z = pk2(r16[4], r16[5]); o0.w = pk2(r16[6], r16[7]);
            o1.x = pk2(r16[8], r16[9]); o1.y = pk2(r16[10], r16[11]); o1.z = pk2(r16[12], r16[13]); o1.w = pk2(r16[14], r16[15]);
            *(u32x4*)(AO + row * 1024 + h * 128 + 16 * part) = o0; *(u32x4*)(AO + row * 1024 + h * 128 + 16 * part + 8) = o1;
        }
    }
    if (MODE == 0) {
#pragma unroll
        for (int tau = 0; tau < 8; ++tau)
#pragma unroll
            for (int r = 0; r < 4; ++r) SLOC[(size_t)unit * 16384 + (16 * tau + 4 * g + r) * 128 + 16 * wave + c16] = S[tau][r];
        *(LAS float*)(lds + HG_RED + (si * 128 + dk) * 4) = lsum;
        __syncthreads();
        if (tid < 128) { const float tot = (*(LAS float*)(lds + HG_RED + tid * 4) * *(LAS float*)(lds + HG_RED + (128 + tid) * 4)) * (*(LAS float*)(lds + HG_RED + (256 + tid) * 4) * *(LAS float*)(lds + HG_RED + (384 + tid) * 4));
            DTOT[(size_t)unit * 128 + tid] = tot; }
    }
    __syncthreads();
}

template <int W>
__device__ __forceinline__ void pool_lane(int b, int tb, int ch, const bf16_t* PROJ, bf16_t* AO) {
    const bf16_t* xp = PROJ + (size_t)b * SEQ * 2048 + 1536 + ch;
    u32x4 cur[8], prev[W - 1];
#pragma unroll
    for (int j = 0; j < 8; ++j) cur[j] = *(const u32x4*)(xp + (size_t)(tb + j) * 2048);
#pragma unroll
    for (int r = 1; r < W; ++r) { prev[r - 1] = (u32x4){0u, 0u, 0u, 0u}; if (tb - r >= 0) prev[r - 1] = *(const u32x4*)(xp + (size_t)(tb - r) * 2048); }
#define POOL_ACC(op_, v_) do { s[0] op_ bflo((v_).x); s[1] op_ bfhi((v_).x); s[2] op_ bflo((v_).y); s[3] op_ bfhi((v_).y); s[4] op_ bflo((v_).z); s[5] op_ bfhi((v_).z); s[6] op_ bflo((v_).w); s[7] op_ bfhi((v_).w); } while (0)
    float s[8];
#pragma unroll
    for (int c = 0; c < 8; ++c) s[c] = 0.f;
#pragma unroll
    for (int r = 1; r < W; ++r) POOL_ACC(+=, prev[r - 1]);
#pragma unroll
    for (int j = 0; j < 8; ++j) {
        const int t = tb + j; const u32x4 v = cur[j];
        float x[8]; x[0] = bflo(v.x); x[1] = bfhi(v.x); x[2] = bflo(v.y); x[3] = bfhi(v.y); x[4] = bflo(v.z); x[5] = bfhi(v.z); x[6] = bflo(v.w); x[7] = bfhi(v.w);
        const float cnt = (float)((t + 1) < W ? (t + 1) : W);
        float o[8];
#pragma unroll
        for (int c = 0; c < 8; ++c) { s[c] += x[c]; o[c] = s[c] / cnt - x[c]; }
        u32x4 w; w.x = pk2(o[0], o[1]); w.y = pk2(o[2], o[3]); w.z = pk2(o[4], o[5]); w.w = pk2(o[6], o[7]);
        *(u32x4*)(AO + ((size_t)b * SEQ + t) * 1024 + 512 + ch) = w;
        if (j - W + 1 >= 0) POOL_ACC(-=, cur[j - W + 1 >= 0 ? j - W + 1 : 0]); else POOL_ACC(-=, prev[W - 2 - j >= 0 ? W - 2 - j : 0]);
    }
#undef POOL_ACC
}
__device__ __forceinline__ void pool_task(int task, const bf16_t* PROJ, bf16_t* AO, int wave, int lane) {
    const int b = task >> 6, blk = task & 63;
    const int grp = wave & 3, ch = grp * 128 + (lane & 15) * 8;
#pragma unroll 1
    for (int p = 0; p < 2; ++p) { const int tb = blk * 128 + (wave >> 2) * 64 + p * 32 + (lane >> 4) * 8;
        if (grp == 0) pool_lane<2>(b, tb, ch, PROJ, AO); else if (grp == 1) pool_lane<4>(b, tb, ch, PROJ, AO); else if (grp == 2) pool_lane<8>(b, tb, ch, PROJ, AO); else pool_lane<16>(b, tb, ch, PROJ, AO); }
}

constexpr int RT_YS = 1028;
constexpr int RT_Y = 0, RT_PART = 66048, RT_LOG = 82432, RT_SELE = 99328, RT_SELG = 101376, RT_SELR = 103424, RT_HIST = 105472, RT_BASE = 105600, RT_LNW = 105728;
__device__ __forceinline__ void wave_sum4(float& a, float& b, float& c, float& d) {
#pragma unroll
    for (int o = 1; o < 64; o <<= 1) { const float ta = __shfl_xor(a, o), tb = __shfl_xor(b, o), tc = __shfl_xor(c, o), td = __shfl_xor(d, o); a += ta; b += tb; c += tc; d += td; }
}
__device__ __forceinline__ void split_hl(const float (&x)[8], u32x4& hi, u32x4& lo) {
    unsigned h[4], l[4];
#pragma unroll
    for (int i = 0; i < 4; ++i) { h[i] = pk2(x[2 * i], x[2 * i + 1]); l[i] = pk2(x[2 * i] - bflo(h[i]), x[2 * i + 1] - bfhi(h[i])); }
    hi = (u32x4){h[0], h[1], h[2], h[3]}; lo = (u32x4){l[0], l[1], l[2], l[3]};
}
__device__ __forceinline__ void router_load_w(const float* wr, u32x4 (&wreg)[16], int wave, int lane) {
    const float* wp = wr + (size_t)(128 * wave + 8 * (lane >> 4)) * 32 + (lane & 15);
#pragma unroll
    for (int kk = 0; kk < 4; ++kk)
#pragma unroll
        for (int tl = 0; tl < 2; ++tl) { float x[8];
#pragma unroll
            for (int j = 0; j < 8; ++j) x[j] = wp[(32 * kk + j) * 32 + 16 * tl];
            split_hl(x, wreg[(kk * 2 + tl) * 2], wreg[(kk * 2 + tl) * 2 + 1]); }
}
template <bool XF32>
__device__ __forceinline__ void router_block(LAS unsigned char* lds, int blk, const float* X32, const bf16_t* XB, bf16_t* XBo, unsigned char* XB8, const bf16_t* H, const float* lnw, const float* lnb,
                                             const u32x4 (&wreg)[16], const float* br, unsigned* cnt, int* tokl, float* gatel, int* tinfo, int tid, int wave, int lane) {
    const int c16 = lane & 15, g = lane >> 4;
    if (tid < 32) *(LAS unsigned*)(lds + RT_HIST + tid * 4) = 0u;
    u32x2 hq[2][4]; f32x4 xq[2][4]; u32x2 xh[2][4];
#pragma unroll
    for (int j = 0; j < 4; ++j) {
#pragma unroll
        for (int k = 0; k < 2; ++k) { hq[k][j] = (u32x2){0u, 0u}; xh[k][j] = (u32x2){0u, 0u}; xq[k][j] = (f32x4){0.f, 0.f, 0.f, 0.f}; } }
    const unsigned lo4 = 4u * (unsigned)lane;
#define RT_LOAD(bt_) do { _Pragma("unroll") for (int k = 0; k < 2; ++k) { const size_t t_ = (size_t)blk * 128 + 16 * (bt_) + 2 * wave + k; \
        const bf16_t* hb_ = H + t_ * 1024 + lo4; const float* xb_ = X32 + t_ * 1024 + lo4; const bf16_t* xh_ = XB + t_ * 1024 + lo4; _Pragma("unroll") for (int j = 0; j < 4; ++j) { \
        LDPIN8(hq[k][j], hb_ + 256 * j); \
        if constexpr (XF32) LDPIN16(xq[k][j], xb_ + 256 * j); else LDPIN8(xh[k][j], xh_ + 256 * j); } } } while (0)
#define RT_PINROWS "+v"(hq[0][0]), "+v"(hq[0][1]), "+v"(hq[0][2]), "+v"(hq[0][3]), "+v"(hq[1][0]), "+v"(hq[1][1]), "+v"(hq[1][2]), "+v"(hq[1][3])
    { const f32x4 w4 = *(const f32x4*)(lnw + 4 * (tid & 255)), b4 = *(const f32x4*)(lnb + 4 * (tid & 255)); if (tid < 256) *(LAS f32x4*)(lds + RT_LNW + 16 * tid) = w4; else *(LAS f32x4*)(lds + RT_LNW + 4096 + 16 * (tid - 256)) = b4; }
    RT_LOAD(0);
    LDS_BARRIER();
#pragma unroll 1
    for (int bt = 0; bt < 8; ++bt) {
        if constexpr (XF32) asm volatile("s_waitcnt vmcnt(0)" : RT_PINROWS, "+v"(xq[0][0]), "+v"(xq[0][1]), "+v"(xq[0][2]), "+v"(xq[0][3]), "+v"(xq[1][0]), "+v"(xq[1][1]), "+v"(xq[1][2]), "+v"(xq[1][3]) :: "memory");
        else asm volatile("s_waitcnt vmcnt(0)" : RT_PINROWS, "+v"(xh[0][0]), "+v"(xh[0][1]), "+v"(xh[0][2]), "+v"(xh[0][3]), "+v"(xh[1][0]), "+v"(xh[1][1]), "+v"(xh[1][2]), "+v"(xh[1][3]) :: "memory");
#define RT_V(k_, j_) ((XF32 ? xq[k_][j_] : (f32x4){bflo(xh[k_][j_].x), bfhi(xh[k_][j_].x), bflo(xh[k_][j_].y), bfhi(xh[k_][j_].y)}) * ALPHA + (f32x4){bflo(hq[k_][j_].x), bfhi(hq[k_][j_].x), bflo(hq[k_][j_].y), bfhi(hq[k_][j_].y)})
        float s1[2], s2[2];
#pragma unroll
        for (int k = 0; k < 2; ++k) { s1[k] = 0.f; s2[k] = 0.f;
#pragma unroll
            for (int j = 0; j < 4; ++j) { const f32x4 t4 = RT_V(k, j); s1[k] += (t4.x + t4.y) + (t4.z + t4.w); s2[k] += (t4.x * t4.x + t4.y * t4.y) + (t4.z * t4.z + t4.w * t4.w); } }
        wave_sum4(s1[0], s2[0], s1[1], s2[1]);
#pragma unroll
        for (int k = 0; k < 2; ++k) {
            const int tl = 2 * wave + k; const size_t t = (size_t)blk * 128 + 16 * bt + tl;
            const float mean = s1[k] * (1.f / D); const float var = fmaxf(s2[k] * (1.f / D) - mean * mean, 0.f); const float rstd = 1.f / sqrtf(var + LN_EPS);
            bf16_t* xo_ = XBo + t * 1024; unsigned char* x8_ = XB8 + t * 1024;
#pragma unroll
            for (int j = 0; j < 4; ++j) { const f32x4 ww = *(const LAS f32x4*)(lds + RT_LNW + (256 * j + lo4) * 4), bb = *(const LAS f32x4*)(lds + RT_LNW + 4096 + (256 * j + lo4) * 4);
                const f32x4 y = (RT_V(k, j) - mean) * rstd * ww + bb;
                u32x2 o; o.x = pk2(y.x, y.y); o.y = pk2(y.z, y.w); *(u32x2*)(xo_ + 256 * j + lo4) = o;
                *(unsigned*)(x8_ + 256 * j + lo4) = pk4_fp8(y.x, y.y, y.z, y.w);
                *(LAS f32x4*)(lds + RT_Y + (tl * RT_YS + 4 * lane + 256 * j) * 4) = y; }
        }
#undef RT_V
        if constexpr (XF32) asm volatile("" : RT_PINROWS, "+v"(xq[0][0]), "+v"(xq[0][1]), "+v"(xq[0][2]), "+v"(xq[0][3]), "+v"(xq[1][0]), "+v"(xq[1][1]), "+v"(xq[1][2]), "+v"(xq[1][3]) :: "memory");
        else asm volatile("" : RT_PINROWS, "+v"(xh[0][0]), "+v"(xh[0][1]), "+v"(xh[0][2]), "+v"(xh[0][3]), "+v"(xh[1][0]), "+v"(xh[1][1]), "+v"(xh[1][2]), "+v"(xh[1][3]) :: "memory");
        if (bt < 7) RT_LOAD(bt + 1);
        LDS_BARRIER();
        {
            f32x4 a0 = (f32x4){0.f, 0.f, 0.f, 0.f}, a1 = a0;
            const LAS float* yp = (const LAS float*)(lds + RT_Y) + c16 * RT_YS + 128 * wave + 8 * g; asm volatile("" : "+v"(yp));
#pragma unroll
            for (int kk = 0; kk < 4; ++kk) {
                const f32x4 ya = *(const LAS f32x4*)(yp + 32 * kk), yb = *(const LAS f32x4*)(yp + 32 * kk + 4);
                const float x[8] = {ya.x, ya.y, ya.z, ya.w, yb.x, yb.y, yb.z, yb.w};
                u32x4 yh, yl; split_hl(x, yh, yl);
                const bf16x8 ah = __builtin_bit_cast(bf16x8, yh), al = __builtin_bit_cast(bf16x8, yl);
#pragma unroll
                for (int tl = 0; tl < 2; ++tl) { const bf16x8 wh = __builtin_bit_cast(bf16x8, wreg[(kk * 2 + tl) * 2]), wl = __builtin_bit_cast(bf16x8, wreg[(kk * 2 + tl) * 2 + 1]);
                    f32x4 acc = tl ? a1 : a0;
                    acc = __builtin_amdgcn_mfma_f32_16x16x32_bf16(al, wh, acc, 0, 0, 0); acc = __builtin_amdgcn_mfma_f32_16x16x32_bf16(ah, wl, acc, 0, 0, 0); acc = __builtin_amdgcn_mfma_f32_16x16x32_bf16(ah, wh, acc, 0, 0, 0);
                    if (tl) a1 = acc; else a0 = acc; }
            }
            LAS float* pp = (LAS float*)(lds + RT_PART) + (wave * 16 + 4 * g) * 32 + c16;
#pragma unroll
            for (int r = 0; r < 4; ++r) { pp[r * 32] = a0[r]; pp[r * 32 + 16] = a1[r]; }
        }
        LDS_BARRIER();
        {
            const int tk = tid >> 5, e = tid & 31;
            float lg = br[e];
            const LAS float* pp = (const LAS float*)(lds + RT_PART) + tk * 32 + e; asm volatile("" : "+v"(pp));
#pragma unroll
            for (int w = 0; w < 8; ++w) lg += pp[w * 512];
            *(LAS float*)(lds + RT_LOG + ((16 * bt + tk) * 33 + e) * 4) = lg;
        }
    }
#undef RT_LOAD
#undef RT_PINROWS
    LDS_BARRIER();
    if (tid < 128) {
        const LAS float* lp = (const LAS float*)(lds + RT_LOG) + tid * 33;
        float v0 = -INFINITY, v1 = -INFINITY, v2 = -INFINITY, v3 = -INFINITY; int i0 = 0, i1 = 0, i2 = 0, i3 = 0;
#pragma unroll
        for (int e = 0; e < 32; ++e) { const float x = lp[e];
            const bool g0 = x > v0, g1 = x > v1, g2 = x > v2, g3 = x > v3;
            v3 = g2 ? v2 : (g3 ? x : v3); i3 = g2 ? i2 : (g3 ? e : i3);
            v2 = g1 ? v1 : (g2 ? x : v2); i2 = g1 ? i1 : (g2 ? e : i2);
            v1 = g0 ? v0 : (g1 ? x : v1); i1 = g0 ? i0 : (g1 ? e : i1);
            v0 = g0 ? x : v0; i0 = g0 ? e : i0; }
        const float e1 = __expf(v1 - v0), e2 = __expf(v2 - v0), e3 = __expf(v3 - v0);
        const float inv = 1.0f / (1.0f + e1 + e2 + e3);
        const int mi[4] = {i0, i1, i2, i3}; const float gt[4] = {inv, e1 * inv, e2 * inv, e3 * inv};
#pragma unroll
        for (int k = 0; k < 4; ++k) {
            const unsigned lr = __hip_atomic_fetch_add((LAS unsigned*)(lds + RT_HIST + mi[k] * 4), 1u, __ATOMIC_RELAXED, __HIP_MEMORY_SCOPE_WORKGROUP);
            const int sidx = tid * 4 + k;
            *(LAS int*)(lds + RT_SELE + sidx * 4) = mi[k]; *(LAS float*)(lds + RT_SELG + sidx * 4) = gt[k]; *(LAS unsigned*)(lds + RT_SELR + sidx * 4) = lr;
        }
    }
    LDS_BARRIER();
    if (tid < 32) { const unsigned hc = *(LAS unsigned*)(lds + RT_HIST + tid * 4);
        *(LAS unsigned*)(lds + RT_BASE + tid * 4) = __hip_atomic_fetch_add(cnt + tid, hc, __ATOMIC_RELAXED, __HIP_MEMORY_SCOPE_AGENT); }
    __syncthreads();
    {
        const int me = *(LAS int*)(lds + RT_SELE + tid * 4); const float gt = *(LAS float*)(lds + RT_SELG + tid * 4);
        const unsigned rank = *(LAS unsigned*)(lds + RT_BASE + me * 4) + *(LAS unsigned*)(lds + RT_SELR + tid * 4);
        const int tok = blk * 128 + (tid >> 2);
        tokl[(size_t)me * T + rank] = tok; gatel[(size_t)me * T + rank] = gt; tinfo[(size_t)tok * 4 + (tid & 3)] = (me << 16) | (int)rank;
    }
    __syncthreads();
}

__device__ __forceinline__ void combine_rows2(size_t t0, size_t t1, const unsigned char* Y, const int* tinfo, const LAS int* tab, const bf16_t* XB, bf16_t* XBo, float* OUT32, const f32x4 (&lw)[4], const f32x4 (&lb)[4], int lane) {
    f32x4 v[2][4]; float s1[2], s2[2];
#pragma unroll
    for (int k2 = 0; k2 < 2; ++k2) {
        const size_t t = k2 ? t1 : t0;
        const u32x4 x0 = *(const u32x4*)(XB + t * 1024 + 16 * lane), x1 = *(const u32x4*)(XB + t * 1024 + 16 * lane + 8);
        const u32x4 inf4 = *(const u32x4*)(tinfo + t * 4);
        v[k2][0] = (f32x4){bflo(x0.x), bfhi(x0.x), bflo(x0.y), bfhi(x0.y)} * ALPHA; v[k2][1] = (f32x4){bflo(x0.z), bfhi(x0.z), bflo(x0.w), bfhi(x0.w)} * ALPHA;
        v[k2][2] = (f32x4){bflo(x1.x), bfhi(x1.x), bflo(x1.y), bfhi(x1.y)} * ALPHA; v[k2][3] = (f32x4){bflo(x1.z), bfhi(x1.z), bflo(x1.w), bfhi(x1.w)} * ALPHA;
        u32x4 yy[4];
#pragma unroll
        for (int k = 0; k < 4; ++k) { const unsigned inf = k == 0 ? inf4.x : k == 1 ? inf4.y : k == 2 ? inf4.z : inf4.w; const int ee = (int)(inf >> 16), rk = (int)(inf & 0xffffu);
            const size_t slot = (size_t)tab[ee] * 256 + rk; yy[k] = *(const u32x4*)(Y + slot * 1024 + 16 * lane); }
#pragma unroll
        for (int k = 0; k < 4; ++k) {
#pragma unroll
            for (int j = 0; j < 4; ++j) { const int w = (int)(j == 0 ? yy[k].x : j == 1 ? yy[k].y : j == 2 ? yy[k].z : yy[k].w);
                const f32x2 lo2 = __builtin_amdgcn_cvt_pk_f32_fp8(w, false), hi2 = __builtin_amdgcn_cvt_pk_f32_fp8(w, true);
                v[k2][j] = v[k2][j] + (f32x4){lo2.x, lo2.y, hi2.x, hi2.y} * 0.0625f; } }
        float a = 0.f, q = 0.f;
#pragma unroll
        for (int j = 0; j < 4; ++j) { const f32x4 u = v[k2][j]; a += (u.x + u.y) + (u.z + u.w); q += (u.x * u.x + u.y * u.y) + (u.z * u.z + u.w * u.w); }
        s1[k2] = a; s2[k2] = q;
    }
    wave_sum4(s1[0], s2[0], s1[1], s2[1]);
#pragma unroll
    for (int k2 = 0; k2 < 2; ++k2) {
        const size_t t = k2 ? t1 : t0;
        const float mean = s1[k2] * (1.f / D); const float var = fmaxf(s2[k2] * (1.f / D) - mean * mean, 0.f); const float rstd = 1.f / sqrtf(var + LN_EPS);
        f32x4 y[4];
#pragma unroll
        for (int j = 0; j < 4; ++j) y[j] = (v[k2][j] - mean) * rstd * lw[j] + lb[j];
        if (OUT32) {
#pragma unroll
            for (int j = 0; j < 4; ++j) *(f32x4*)(OUT32 + t * 1024 + 16 * lane + 4 * j) = y[j];
        } else {
            u32x4 o0, o1; o0.x = pk2(y[0].x, y[0].y); o0.y = pk2(y[0].z, y[0].w); o0.z = pk2(y[1].x, y[1].y); o0.w = pk2(y[1].z, y[1].w);
            o1.x = pk2(y[2].x, y[2].y); o1.y = pk2(y[2].z, y[2].w); o1.z = pk2(y[3].x, y[3].y); o1.w = pk2(y[3].z, y[3].w);
            *(u32x4*)(XBo + t * 1024 + 16 * lane) = o0; *(u32x4*)(XBo + t * 1024 + 16 * lane + 8) = o1;
        }
    }
}

__device__ __forceinline__ int crow(int r, int hi) { return (r & 3) + 8 * (r >> 2) + 4 * hi; }
__device__ __forceinline__ void attn_phase(const bf16_t* QB, const bf16_t* KB, const bf16_t* VT, bf16_t* AO, int gw, int ngw, int lane) {
    const int r32 = lane & 31, hi = lane >> 5;
    for (int task = gw; task < BATCH * 16 * (SEQ / 32); task += ngw) {
        const int qt = task & 255, bh = task >> 8, b = bh >> 4, h = bh & 15;
        const size_t rowb = (size_t)b * SEQ; const int q0 = qt * 32;
        bf16x8 qf[4];
        { const bf16_t* qp = QB + (rowb + q0 + r32) * 1024 + h * 64 + hi * 8;
#pragma unroll
          for (int s = 0; s < 4; ++s) qf[s] = *(const bf16x8*)(qp + 16 * s); }
        f32x16 o0, o1;
#pragma unroll
        for (int r = 0; r < 16; ++r) { o0[r] = 0.f; o1[r] = 0.f; }
        float carry = 1.f;
        const bf16_t* kbase = KB + (size_t)bh * 256 * 4 * 64 * 8 + lane * 8;
        const bf16_t* vbase = VT + (size_t)bh * 256 * 4 * 64 * 8 + lane * 8;
        bf16x8 kn[4];
#pragma unroll
        for (int s = 0; s < 4; ++s) kn[s] = *(const bf16x8*)(kbase + (size_t)qt * 2048 + s * 512);
        for (int kt = qt; kt >= 0; --kt) {
            bf16x8 kf[4];
#pragma unroll
            for (int s = 0; s < 4; ++s) kf[s] = kn[s];
            bf16x8 va[2][2];
#pragma unroll
            for (int dt = 0; dt < 2; ++dt)
#pragma unroll
                for (int sp = 0; sp < 2; ++sp) va[dt][sp] = *(const bf16x8*)(vbase + (size_t)kt * 2048 + (dt * 2 + sp) * 512);
            { const int kp = kt > 0 ? kt - 1 : 0;
#pragma unroll
              for (int s = 0; s < 4; ++s) kn[s] = *(const bf16x8*)(kbase + (size_t)kp * 2048 + s * 512); }
            f32x16 st;
#pragma unroll
            for (int r = 0; r < 16; ++r) st[r] = 0.f;
#pragma unroll
            for (int s = 0; s < 4; ++s) st = __builtin_amdgcn_mfma_f32_32x32x16_bf16(kf[s], qf[s], st, 0, 0, 0);
            const bool diag = (kt == qt);
            float R[16], Bt[16];
#pragma unroll
            for (int r = 0; r < 16; r += 2) {
                const f32x2 e = (f32x2){fexp2(st[r]), fexp2(st[r + 1])};
                const f32x2 d = e + 1.0f;
                f32x2 rr = (f32x2){frcp(d.x), frcp(d.y)};
                if (diag) { rr.x = (crow(r, hi) < r32) ? rr.x : 1.0f; rr.y = (crow(r + 1, hi) < r32) ? rr.y : 1.0f; }
                const f32x2 bt = 1.0f - rr;
                R[r] = rr.x; R[r + 1] = rr.y; Bt[r] = bt.x; Bt[r + 1] = bt.y;
            }
            float own[4], pg[4];
#pragma unroll
            for (int rg = 0; rg < 4; ++rg) { own[rg] = (R[4 * rg] * R[4 * rg + 1]) * (R[4 * rg + 2] * R[4 * rg + 3]); pg[rg] = __shfl_xor(own[rg], 32); }
            float aft[4];
            { float run = 1.f;
#pragma unroll
              for (int rg = 3; rg >= 0; --rg) { aft[rg] = (hi == 0) ? run * pg[rg] : run; run *= own[rg] * pg[rg]; }
              float w[16];
#pragma unroll
              for (int rg = 0; rg < 4; ++rg) { float lat = carry * aft[rg];
#pragma unroll
                  for (int p = 3; p >= 0; --p) { w[4 * rg + p] = Bt[4 * rg + p] * lat; lat *= R[4 * rg + p]; } }
              carry *= run;
              u32x4 p0, p1;
              p0.x = pk2(w[0], w[1]); p0.y = pk2(w[2], w[3]); p0.z = pk2(w[4], w[5]); p0.w = pk2(w[6], w[7]);
              p1.x = pk2(w[8], w[9]); p1.y = pk2(w[10], w[11]); p1.z = pk2(w[12], w[13]); p1.w = pk2(w[14], w[15]);
              const bf16x8 pf0 = __builtin_bit_cast(bf16x8, p0), pf1 = __builtin_bit_cast(bf16x8, p1);
              o0 = __builtin_amdgcn_mfma_f32_32x32x16_bf16(va[0][0], pf0, o0, 0, 0, 0); o0 = __builtin_amdgcn_mfma_f32_32x32x16_bf16(va[0][1], pf1, o0, 0, 0, 0);
              o1 = __builtin_amdgcn_mfma_f32_32x32x16_bf16(va[1][0], pf0, o1, 0, 0, 0); o1 = __builtin_amdgcn_mfma_f32_32x32x16_bf16(va[1][1], pf1, o1, 0, 0, 0);
            }
            if (__all(carry < ATT_THR)) break;
        }
        bf16_t* op = AO + (rowb + q0 + r32) * 1024 + h * 64 + 4 * hi;
#pragma unroll
        for (int rg = 0; rg < 4; ++rg) {
            u32x2 w; w.x = pk2(o0[4 * rg], o0[4 * rg + 1]); w.y = pk2(o0[4 * rg + 2], o0[4 * rg + 3]); *(u32x2*)(op + 8 * rg) = w;
            w.x = pk2(o1[4 * rg], o1[4 * rg + 1]); w.y = pk2(o1[4 * rg + 2], o1[4 * rg + 3]); *(u32x2*)(op + 32 + 8 * rg) = w;
        }
    }
}

constexpr int NWAVES = 8;
constexpr int NPHASE = 17;
struct Args { const float* in[29]; float* out; unsigned char* ws; int ph_lo, ph_hi; };

#ifndef PH_MASK
#define PH_MASK 0xfff
#endif
#define EN(b) ((PH_MASK >> (b)) & 1)
#ifndef REP_MASK
#define REP_MASK 0
#endif
#define RP(b) ((REP_MASK >> (b)) & 1)
#define PHASE(b, k, ...) if (EN(b) && IN(k)) { PH_IDS; { __VA_ARGS__ } if (RP(b)) { __VA_ARGS__ } }
#define IN(k) (lo <= (k) && (k) < hi)
#if MK_PER_PHASE
#define SEAM(k) do { } while (0)
#else
#define SEAM(k) do { if (IN(k) && IN((k) + 1)) xcd_barrier(bar); } while (0)
#endif
#define PH_IDS const int lane = lane_id_asm(); const int wave = wave0; const int tid = wave * 64 + lane; const int G = gridDim.x, bx = blockIdx.x; const int gw = bx * NWAVES + wave, NGW = G * NWAVES; (void)tid; (void)lane; (void)gw; (void)NGW; (void)G; (void)bx
#define WSP(T_, off) ((T_*)(args.ws + (off)))

template <int LAYER>
__device__ __forceinline__ void layer_tail(const Args& args, LAS unsigned char* lds, const XcdBarrier& bar, int lo, int hi, const int wave0) {
    constexpr int PB = LAYER == 0 ? 5 : 12;
    LAS int* moetab = (LAS int*)(lds + MOETAB_OFF);
    LAS unsigned* rowtab = (LAS unsigned*)(lds + ROWTAB_OFF);
    PHASE(5, PB,
        pg8::Gemm g{WSP(bf16_t, WS_SB), WSP(bf16_t, LAYER ? WS_WO1T : WS_WO0T), 1024, 0}; pg8::StaticOrder S; S.init(T, 1024, G, bx); pg8::EpiPlain E{WSP(bf16_t, WS_SB + 64 * MiB), 1024, 0, 0, 1.f};
        pg8::gemm_phase<pg8::EpiPlain, pg8::StaticOrder, 0>(lds, g, S, E, nullptr, rowtab, tid);)
    SEAM(PB);
    if (RP(6) && EN(6) && IN(PB + 1)) { PH_IDS;
        unsigned* cnt = WSP(unsigned, WS_CTL) + CW_CNT + 128 + LAYER * 64;
        u32x4 wreg[16]; router_load_w(args.in[LAYER ? 21 : 9], wreg, wave, lane);
        for (int blk = bx; blk < T / 128; blk += G)
            router_block<LAYER == 0>(lds, blk, LAYER ? nullptr : args.in[0], WSP(bf16_t, WS_XB), WSP(bf16_t, WS_END), WSP(unsigned char, WS_END + 64 * MiB), WSP(bf16_t, WS_SB + 64 * MiB), args.in[LAYER ? 19 : 7], args.in[LAYER ? 20 : 8], wreg, args.in[LAYER ? 22 : 10],
                         cnt, WSP(int, WS_END + 96 * MiB), WSP(float, WS_END + 100 * MiB), WSP(int, WS_END + 104 * MiB), tid, wave, lane); }
    if (EN(6) && IN(PB + 1)) { PH_IDS;
        unsigned* cnt = WSP(unsigned, WS_CTL) + CW_CNT + LAYER * 64;
        u32x4 wreg[16]; router_load_w(args.in[LAYER ? 21 : 9], wreg, wave, lane);
        for (int blk = bx; blk < T / 128; blk += G)
            router_block<LAYER == 0>(lds, blk, LAYER ? nullptr : args.in[0], WSP(bf16_t, WS_XB), WSP(bf16_t, WS_XB), WSP(unsigned char, WS_XB8), WSP(bf16_t, WS_SB + 64 * MiB), args.in[LAYER ? 19 : 7], args.in[LAYER ? 20 : 8], wreg, args.in[LAYER ? 22 : 10],
                         cnt, WSP(int, WS_TOKL), WSP(float, WS_GATEL), WSP(int, WS_TINFO), tid, wave, lane); }
    SEAM(PB + 1);
    PHASE(7, PB + 2,
        moe_table(WSP(unsigned, WS_CTL) + CW_CNT + LAYER * 64, moetab, tid);
        pg8::Gemm g{WSP(bf16_t, WS_XB8), WSP(bf16_t, WS_W1T), 512, 2048}; pg8::MoeOrder S; S.init(moetab, 8, G, bx); pg8::EpiSwiglu8 E{WSP(unsigned char, WS_SA), args.in[LAYER ? 24 : 12]};
        pg8::gemm_phase<pg8::EpiSwiglu8, pg8::MoeOrder, 1, 127 - W1_SH>(lds, g, S, E, WSP(int, WS_TOKL), rowtab, tid);)
    SEAM(PB + 2);
    PHASE(8, PB + 3,
        moe_table(WSP(unsigned, WS_CTL) + CW_CNT + LAYER * 64, moetab, tid);
        pg8::Gemm g{WSP(bf16_t, WS_SA), WSP(bf16_t, WS_W2T), 512, 1024}; pg8::MoeOrder S; S.init(moetab, 4, G, bx); pg8::EpiDown8 E{WSP(unsigned char, WS_SB), args.in[LAYER ? 26 : 14], WSP(float, WS_GATEL)};
        pg8::gemm_phase<pg8::EpiDown8, pg8::MoeOrder, 2, 127 - W2_SH>(lds, g, S, E, nullptr, rowtab, tid);)
    SEAM(PB + 3);
    if (EN(9) && IN(PB + 4)) { PH_IDS;
        moe_table(WSP(unsigned, WS_CTL) + CW_CNT + LAYER * 64, moetab, tid);
        f32x4 lw[4], lb[4];
#pragma unroll
        for (int j = 0; j < 4; ++j) { lw[j] = *(const f32x4*)(args.in[LAYER ? 27 : 15] + 16 * lane + 4 * j); lb[j] = *(const f32x4*)(args.in[LAYER ? 28 : 16] + 16 * lane + 4 * j); }
        if (RP(9)) { for (int t = gw; t < T; t += 2 * NGW) combine_rows2((size_t)t, (size_t)(t + NGW), WSP(unsigned char, WS_SB), WSP(int, WS_TINFO), moetab, WSP(bf16_t, WS_XB), WSP(bf16_t, WS_END), LAYER ? (float*)WSP(float, WS_END) : nullptr, lw, lb, lane); }
        for (int t = gw; t < T; t += 2 * NGW) combine_rows2((size_t)t, (size_t)(t + NGW), WSP(unsigned char, WS_SB), WSP(int, WS_TINFO), moetab, WSP(bf16_t, WS_XB), WSP(bf16_t, WS_XB), LAYER ? args.out : nullptr, lw, lb, lane);
    }
    if (LAYER == 0) SEAM(PB + 4);
}

__global__ void __launch_bounds__(NWAVES * 64, 2) mk_fwd(Args args) {
    extern __shared__ __attribute__((aligned(16))) unsigned char lds_raw[];
    LAS unsigned char* lds = (LAS unsigned char*)lds_raw;
    volatile LAS unsigned* MISC = (volatile LAS unsigned*)(lds + MISC_OFF);
    LAS unsigned* rowtab = (LAS unsigned*)(lds + ROWTAB_OFF);
    if (threadIdx.x < 32) MISC[threadIdx.x] = 0u;
    __syncthreads();
    const int wave0 = __builtin_amdgcn_readfirstlane(threadIdx.x >> 6);
    XcdBarrier bar; bar.bar = WSP(unsigned, WS_CTL) + CW_BAR; bar.x = 0; bar.st = nullptr; bar.wave = wave0;
#if !MK_PER_PHASE
    bar = xcd_barrier_post(WSP(unsigned, WS_CTL) + CW_BAR, MISC + 8);
#endif
    const int lo = args.ph_lo, hi = args.ph_hi;

    PHASE(0, 0,
        const float* x_in = args.in[0]; const float* w_in0 = args.in[2]; const float* wpool = args.in[4]; const float* pscale = args.in[5]; const float* w_o0 = args.in[6];
        const float* w_in1 = args.in[17]; const float* w_o1 = args.in[18];
        bf16_t* WIN0T = WSP(bf16_t, WS_WIN0T); bf16_t* WO0T = WSP(bf16_t, WS_WO0T); bf16_t* WIN1T = WSP(bf16_t, WS_WIN1T); bf16_t* WO1T = WSP(bf16_t, WS_WO1T); bf16_t* XB = WSP(bf16_t, WS_XB);
        LAS float* scr = (LAS float*)(lds + wave * 16384);
        constexpr int I_IN0 = 16 * 80, I_O0 = 8 * 32, I_IN1 = 16 * 96, I_O1 = 16 * 32, NIT = I_IN0 + I_O0 + I_IN1 + I_O1;
        for (int it = gw; it < NIT; it += NGW) {
            int r = it;
            if (r < I_IN0) { const int kb = r / 80, nb = r % 80, n0 = 32 * nb;
                const int dr = n0 < 512 ? 2 * n0 : (n0 < 1024 ? 2 * (n0 - 512) + 1 : (n0 < 1536 ? n0 + 1024 : n0 - 512));
                transpose_item(w_in0, 2560, WIN0T, 1024, 64 * kb, n0, dr, scr, lane, n0 < 1024 ? 2 : 1); continue; } r -= I_IN0;
            if (r < I_O0) { const int kb = r / 32, nb = r % 32; transpose_item(w_o0, 1024, WO0T, 1024, 64 * kb, 32 * nb, 32 * nb, scr, lane); continue; } r -= I_O0;
            if (r < I_IN1) { const int kb = r / 96, nb = r % 96; transpose_item(w_in1, 3072, WIN1T, 1024, 64 * kb, 32 * nb, 32 * nb, scr, lane); continue; } r -= I_IN1;
            { const int kb = r / 32, nb = r % 32; transpose_item(w_o1, 1024, WO1T, 1024, 64 * kb, 32 * nb, 32 * nb, scr, lane); }
        }
        for (int idx = bx * 512 + tid; idx < 512 * 1024; idx += G * 512) {
            const int n = idx & 1023, gc = idx >> 10, gg = gc >> 7;
            const float* wp = wpool + (size_t)gc * 128; const float* ps = pscale + 128 * gg; const float* wo = w_o0 + (size_t)(512 + 128 * gg) * 1024 + n;
            float a = 0.f;
_Pragma("unroll 8")
            for (int d = 0; d < 128; ++d) a += wp[d] * ps[d] * wo[(size_t)d * 1024];
            WO0T[(size_t)n * 1024 + 512 + gc] = (bf16_t)(pk2(a, 0.f) & 0xffffu);
        }
        { const size_t nv = (size_t)T * D / 8, st = (size_t)G * 512;
          size_t i = (size_t)bx * 512 + tid;
          for (; i + 3 * st < nv; i += 4 * st) {
              f32x4 a[4], c[4];
_Pragma("unroll")
              for (int q = 0; q < 4; ++q) { a[q] = __builtin_nontemporal_load((const f32x4*)(x_in + (i + q * st) * 8)); c[q] = __builtin_nontemporal_load((const f32x4*)(x_in + (i + q * st) * 8 + 4)); }
_Pragma("unroll")
              for (int q = 0; q < 4; ++q) { u32x4 o; o.x = pk2(a[q].x, a[q].y); o.y = pk2(a[q].z, a[q].w); o.z = pk2(c[q].x, c[q].y); o.w = pk2(c[q].z, c[q].w); *(u32x4*)(XB + (i + q * st) * 8) = o; }
          }
          for (; i < nv; i += st) { const f32x4 a = *(const f32x4*)(x_in + i * 8), c = *(const f32x4*)(x_in + i * 8 + 4);
              u32x4 o; o.x = pk2(a.x, a.y); o.y = pk2(a.z, a.w); o.z = pk2(c.x, c.y); o.w = pk2(c.z, c.w); *(u32x4*)(XB + i * 8) = o; }
        })
    SEAM(0);
    PHASE(1, 1,
        { pg8::Gemm g{WSP(bf16_t, WS_XB), WSP(bf16_t, WS_WIN0T), 1024, 0}; pg8::StaticOrder S; S.init(T, 2048, G, bx); pg8::EpiPlain E{WSP(bf16_t, WS_SA), 2048, 0, 0, 1.f};
          pg8::gemm_phase<pg8::EpiPlain, pg8::StaticOrder, 0>(lds, g, S, E, nullptr, rowtab, tid); }
        { pg8::Gemm g{WSP(bf16_t, WS_WIN0T) + (size_t)2048 * 1024, WSP(bf16_t, WS_XB), 1024, 0}; pg8::StaticOrder S; S.init(512, T, G, bx); pg8::EpiPlain E{WSP(bf16_t, WS_SA + 128 * MiB), T, 0, 0, 1.f};
          pg8::gemm_phase<pg8::EpiPlain, pg8::StaticOrder, 0>(lds, g, S, E, nullptr, rowtab, tid); })
    SEAM(1);
#define HG_UNIT0(u_) hgrn_unit<0>(lds, u_, WSP(bf16_t, WS_SA), WSP(bf16_t, WS_SA + 128 * MiB), WSP(float, WS_SB + 128 * MiB), WSP(float, WS_SB + 160 * MiB), args.in[1], args.in[3], WSP(bf16_t, WS_SB), tid, wave, lane)
#define HG_UNIT1(u_) hgrn_unit<1>(lds, u_, WSP(bf16_t, WS_SA), WSP(bf16_t, WS_SA + 128 * MiB), WSP(float, WS_SB + 128 * MiB), WSP(float, WS_SB + 160 * MiB), args.in[1], args.in[3], WSP(bf16_t, WS_SB), tid, wave, lane)
#define CONV0(q0_, q1_) conv_moe_wg(args.in[11], args.in[13], WSP(unsigned char, WS_W1T), WSP(unsigned char, WS_W2T), (LAS float*)lds, bx, G, tid, (q0_) * cq, (q1_) * cq)
    PHASE(2, 2,
        const bool cfirst = (bx & 1) != 0; const int cq = ((NE * 192 + G - 1) / G + 3) / 4;
        if (cfirst) CONV0(0, 1);
        if (bx < 512) HG_UNIT0(bx);
        if (cfirst) CONV0(1, 2); else CONV0(0, 1);
        for (int u = bx + G; u < 512; u += G) HG_UNIT0(u);
        if (!cfirst) CONV0(1, 2);
        for (int task = bx; task < 256; task += G) pool_task(task, WSP(bf16_t, WS_SA), WSP(bf16_t, WS_SB), wave, lane);)
    SEAM(2);
    PHASE(3, 3,
        float* SLOC = WSP(float, WS_SB + 128 * MiB); const float* DTOT = WSP(float, WS_SB + 160 * MiB);
        for (int ch = bx * 512 + tid; ch < 16 * 16384; ch += G * 512) {
            const int bh = ch >> 14, el = ch & 16383, dk = el >> 7;
            float* sp = SLOC + (size_t)bh * 32 * 16384 + el; const float* dp = DTOT + (size_t)bh * 32 * 128 + dk;
            float loc[32], dd[32];
_Pragma("unroll")
            for (int sc = 0; sc < 32; ++sc) { loc[sc] = sp[(size_t)sc * 16384]; dd[sc] = dp[sc * 128]; }
            float S = 0.f;
_Pragma("unroll")
            for (int sc = 0; sc < 32; ++sc) { sp[(size_t)sc * 16384] = S; S = dd[sc] * S + loc[sc]; }
        })
    SEAM(3);
    PHASE(4, 4,
        const bool cfirst = (bx & 1) != 0; const int cq = ((NE * 192 + G - 1) / G + 3) / 4;
        if (cfirst) CONV0(2, 3);
        if (bx < 512) HG_UNIT1(bx);
        if (cfirst) CONV0(3, 4); else CONV0(2, 3);
        for (int u = bx + G; u < 512; u += G) HG_UNIT1(u);
        if (!cfirst) CONV0(3, 4);
        )
#undef CONV0
#undef HG_UNIT0
#undef HG_UNIT1
    SEAM(4);
    layer_tail<0>(args, lds, bar, lo, hi, wave0);
    PHASE(10, 10,
        { pg8::Gemm g{WSP(bf16_t, WS_XB), WSP(bf16_t, WS_WIN1T), 1024, 0}; pg8::StaticOrder S; S.init(T, 2048, G, bx); pg8::EpiQK E{WSP(bf16_t, WS_SA), WSP(bf16_t, WS_SA + 64 * MiB), QSCALE};
          pg8::gemm_phase<pg8::EpiQK, pg8::StaticOrder, 0>(lds, g, S, E, nullptr, rowtab, tid); }
        { pg8::Gemm g{WSP(bf16_t, WS_WIN1T) + (size_t)2048 * 1024, WSP(bf16_t, WS_XB), 1024, 0}; pg8::StaticOrder S; S.init(1024, T, G, bx); pg8::EpiVF E{WSP(bf16_t, WS_SA + 128 * MiB)};
          pg8::gemm_phase<pg8::EpiVF, pg8::StaticOrder, 0>(lds, g, S, E, nullptr, rowtab, tid); })
    SEAM(10);
    PHASE(11, 11,
        const bool cfirst = (bx & 1) != 0;
        if (cfirst) conv_moe_wg(args.in[23], args.in[25], WSP(unsigned char, WS_W1T), WSP(unsigned char, WS_W2T), (LAS float*)lds, bx, G, tid, 0, (NE * 192 + G - 1) / G);
        attn_phase(WSP(bf16_t, WS_SA), WSP(bf16_t, WS_SA + 64 * MiB), WSP(bf16_t, WS_SA + 128 * MiB), WSP(bf16_t, WS_SB), gw, NGW, lane);
        if (!cfirst) conv_moe_wg(args.in[23], args.in[25], WSP(unsigned char, WS_W1T), WSP(unsigned char, WS_W2T), (LAS float*)lds, bx, G, tid, 0, (NE * 192 + G - 1) / G);)
    SEAM(11);
    layer_tail<1>(args, lds, bar, lo, hi, wave0);
}
#undef IN
#undef SEAM

extern "C" void kernel_launch(void* const* d_in, const int* in_sizes, int n_in, void* d_out, int out_size, void* d_ws, size_t ws_size, hipStream_t stream) {
    static int grid = 0;
    if (grid == 0) {
        if (n_in != 29 || in_sizes[0] != T * D || out_size != T * D || ws_size < WS_END) { fprintf(stderr, "kernel_launch: unexpected shapes (n_in %d, in0 %d, out %d, ws %zu)\n", n_in, n_in > 0 ? in_sizes[0] : -1, out_size, ws_size); grid = -1; return; }
        int dev = 0, cus = 0, per_cu = 0;
        if (hipGetDevice(&dev) != hipSuccess || hipDeviceGetAttribute(&cus, hipDeviceAttributeMultiprocessorCount, dev) != hipSuccess) { grid = -1; return; }
        if (hipFuncSetAttribute((const void*)mk_fwd, hipFuncAttributeMaxDynamicSharedMemorySize, LDS_BYTES) != hipSuccess) { fprintf(stderr, "kernel_launch: hipFuncSetAttribute failed\n"); grid = -1; return; }
        if (hipOccupancyMaxActiveBlocksPerMultiprocessor(&per_cu, (const void*)mk_fwd, NWAVES * 64, LDS_BYTES) != hipSuccess || per_cu < 1) { fprintf(stderr, "kernel_launch: occupancy query says %d\n", per_cu); }
        (void)hipGetLastError();
        grid = cus;
    }
    if (grid < 0) return;
    if (hipMemsetAsync((char*)d_ws + WS_CTL, 0, CTL_ZERO_BYTES, stream) != hipSuccess) return;
    Args a{};
    for (int i = 0; i < 29; ++i) a.in[i] = (const float*)d_in[i];
    a.out = (float*)d_out; a.ws = (unsigned char*)d_ws;
#if MK_PER_PHASE
    for (int p = 0; p < NPHASE; ++p) { a.ph_lo = p; a.ph_hi = p + 1; hipLaunchKernelGGL(mk_fwd, dim3(grid), dim3(NWAVES * 64), LDS_BYTES, stream, a); }
#else
    a.ph_lo = 0; a.ph_hi = NPHASE;
    hipLaunchKernelGGL(mk_fwd, dim3(grid), dim3(NWAVES * 64), LDS_BYTES, stream, a);
#endif
}
```

```cpp
#include <hip/hip_runtime.h>
#include <cstdio>
#include <cstdint>

#ifndef MK_PER_PHASE
#define MK_PER_PHASE 0
#endif

#define LAS __attribute__((address_space(3)))
#define GAS __attribute__((address_space(1)))
typedef unsigned short bf16_t;
typedef short bf16x8 __attribute__((ext_vector_type(8)));
typedef short s16x4 __attribute__((ext_vector_type(4)));
typedef float f32x2 __attribute__((ext_vector_type(2)));
typedef float f32x4 __attribute__((ext_vector_type(4)));
typedef float f32x16 __attribute__((ext_vector_type(16)));
typedef unsigned u32x2 __attribute__((ext_vector_type(2)));
typedef unsigned u32x4 __attribute__((ext_vector_type(4)));
typedef __bf16 bf16x2_t __attribute__((ext_vector_type(2)));
typedef int i32x4 __attribute__((ext_vector_type(4)));
typedef int i32x8 __attribute__((ext_vector_type(8)));

constexpr int BATCH = 4, SEQ = 8192, T = BATCH * SEQ, D = 1024;
constexpr int NE = 32;
constexpr float ALPHA = 1.41421356237309515f;
constexpr float LN_EPS = 1e-5f, RMS_EPS = 1e-6f;
constexpr float LOG2E = 1.4426950408889634f;
constexpr float QSCALE = 0.125f * LOG2E;
constexpr float ATT_THR = 7.5231638e-37f;

__device__ __forceinline__ unsigned pk2(float lo, float hi) { f32x2 v = {lo, hi}; bf16x2_t b = __builtin_convertvector(v, bf16x2_t); return __builtin_bit_cast(unsigned, b); }
__device__ __forceinline__ float bflo(unsigned u) { return __uint_as_float(u << 16); }
__device__ __forceinline__ float bfhi(unsigned u) { return __uint_as_float(u & 0xffff0000u); }
__device__ __forceinline__ float bf2f(bf16_t h) { return __uint_as_float(((unsigned)h) << 16); }
__device__ __forceinline__ float clamp448(float x) { return __builtin_amdgcn_fmed3f(x, -448.0f, 448.0f); }
__device__ __forceinline__ unsigned pk4_fp8_nc(float a, float b, float c, float d) { int p = 0; p = __builtin_amdgcn_cvt_pk_fp8_f32(a, b, p, false); p = __builtin_amdgcn_cvt_pk_fp8_f32(c, d, p, true); return (unsigned)p; }
__device__ __forceinline__ unsigned pk4_fp8(float a, float b, float c, float d) { int p = 0; p = __builtin_amdgcn_cvt_pk_fp8_f32(clamp448(a), clamp448(b), p, false); p = __builtin_amdgcn_cvt_pk_fp8_f32(clamp448(c), clamp448(d), p, true); return (unsigned)p; }
__device__ __forceinline__ float fexp2(float x) { return __builtin_amdgcn_exp2f(x); }
__device__ __forceinline__ float flog2(float x) { return __builtin_amdgcn_logf(x); }
__device__ __forceinline__ float frcp(float x) { return __builtin_amdgcn_rcpf(x); }

__device__ __forceinline__ int lane_id_asm() { int l; asm volatile("v_mbcnt_lo_u32_b32 %0, -1, 0\n\tv_mbcnt_hi_u32_b32 %0, -1, %0" : "=v"(l)); return l; }

#define LDPIN16(dst_, p_) asm volatile("global_load_dwordx4 %0, %1, off" : "+v"(dst_) : "v"(p_) : "memory")
#define LDPIN8(dst_, p_)  asm volatile("global_load_dwordx2 %0, %1, off" : "+v"(dst_) : "v"(p_) : "memory")

namespace pg8 {
constexpr int BM = 256, BK = 64, HALF = 128, HTB = HALF * BK * 2, STAGE_BYTES = 8 * HTB, NXCD = 8, WGM = 8;
constexpr int AUX_OFF = STAGE_BYTES + 2048 + 512 + 256;
__host__ __device__ __forceinline__ int lds_byte(int r, int c) { const int st = (r >> 4) * 2 + (c >> 5), rr = r & 15, cc = c & 31, ob = rr * 64 + cc * 2; return st * 1024 + (ob ^ (((ob >> 9) & 1) << 5)); }
__host__ __device__ __forceinline__ void stage_rc(int b, int& R, int& C) { const int st = b / 1024, sb = b % 1024, swz = sb ^ (((sb >> 9) & 1) << 5); R = (st >> 1) * 16 + swz / 64; C = (st & 1) * 32 + (swz % 64) / 2; }
__host__ __device__ __forceinline__ int perm32(int rho) { const int n = rho >> 4, i = rho & 15; return 8 * (i >> 2) + 4 * n + (i & 3); }

struct Unit { int pm, pn, e, mt, valid; };
struct Gemm { const bf16_t* A; const bf16_t* Bt; int K; int brows; };

__device__ __forceinline__ void tile_of(int L, int nM, int nN, int& pm, int& pn) {
    const int nwg = nM * nN;
    int wgid = L; { const int q = nwg / NXCD, r = nwg % NXCD, xcd = wgid % NXCD, off = wgid / NXCD; wgid = (xcd < r ? xcd * (q + 1) : r * (q + 1) + (xcd - r) * q) + off; }
    const int nig = WGM * nN, gid = wgid / nig, fm = gid * WGM, gsz = (nM - fm) < WGM ? (nM - fm) : WGM;
    pm = fm + ((wgid % nig) % gsz); pn = (wgid % nig) / gsz;
}
struct StaticOrder {
    int nM, nN, nwg, G, c;
    __device__ __forceinline__ void init(int M, int N, int G_, int c_) { nM = M / BM; nN = N / BM; nwg = nM * nN; G = G_; c = c_; }
    __device__ __forceinline__ bool next(int i, Unit& u) const {
        const long L = (long)i * G + c; if (L >= nwg) return false;
        tile_of((int)L, nM, nN, u.pm, u.pn); u.e = 0; u.mt = u.pm; u.valid = 256; return true;
    }
};
struct MoeOrder {
    const LAS int* tab; int nM, nN, nwg, G, c;
    __device__ __forceinline__ void init(const LAS int* tab_, int nN_, int G_, int c_) { tab = tab_; nM = tab_[32]; nN = nN_; nwg = nM * nN; G = G_; c = c_; }
    __device__ __forceinline__ bool next(int i, Unit& u) const {
        const long L = (long)i * G + c; if (L >= nwg) return false;
        tile_of((int)L, nM, nN, u.pm, u.pn);
        int e = 0;
#pragma unroll
        for (int j = 1; j < 32; ++j) e += (u.pm >= tab[j]) ? 1 : 0;
        u.e = e; u.mt = u.pm - tab[e]; const int rem = tab[33 + e] - u.mt * 256; u.valid = rem < 256 ? rem : 256; return true;
    }
};

__device__ __forceinline__ unsigned cvt_pk_bf16(float lo, float hi) { return pk2(lo, hi); }

struct EpiPlain {
    static constexpr bool PERM = true; static constexpr int NAUX = 0;
    bf16_t* O; int ldc; int split_cols; size_t split_stride; float scale0;
    __device__ __forceinline__ void operator()(const f32x4 (&acc)[2][2][4][2], const Unit& u, int wr, int wc, int fr, int fq, const LAS float* aux) const {
        asm volatile("" : "+v"(fr), "+v"(fq));
        const int row0 = u.pm * BM + wr * 64 + fr; int colt = u.pn * BM; bf16_t* base = O;
        float sc = 1.f; if (split_cols) { const int t = colt / split_cols; base += (size_t)t * split_stride; colt -= t * split_cols; if (t == 0) sc = scale0; }
        const int col0 = colt + wc * 32 + 8 * fq;
#pragma unroll
        for (int ai = 0; ai < 2; ++ai)
#pragma unroll
            for (int m = 0; m < 4; ++m) { bf16_t* rowp = base + (size_t)(row0 + ai * HALF + m * 16) * ldc + col0;
#pragma unroll
                for (int bj = 0; bj < 2; ++bj) { f32x4 v0 = acc[ai][bj][m][0] * sc, v1 = acc[ai][bj][m][1] * sc;
                    u32x4 w; w.x = cvt_pk_bf16(v0[0], v0[1]); w.y = cvt_pk_bf16(v0[2], v0[3]); w.z = cvt_pk_bf16(v1[0], v1[1]); w.w = cvt_pk_bf16(v1[2], v1[3]);
                    *(u32x4*)(rowp + bj * HALF) = w; } }
    }
};
struct EpiQK {
    static constexpr bool PERM = true; static constexpr int NAUX = 0;
    bf16_t* Q; bf16_t* KF; float scale;
    __device__ __forceinline__ void operator()(const f32x4 (&acc)[2][2][4][2], const Unit& u, int wr, int wc, int fr, int fq, const LAS float* aux) const {
        asm volatile("" : "+v"(fr), "+v"(fq));
        const int row0 = u.pm * BM + wr * 64 + fr; const int colt = u.pn * BM; const bool isk = colt >= 1024;
        const int col0 = (isk ? colt - 1024 : colt) + wc * 32 + 8 * fq;
        const float sc = isk ? 1.f : scale;
#pragma unroll
        for (int ai = 0; ai < 2; ++ai)
#pragma unroll
            for (int m = 0; m < 4; ++m) { const int t = row0 + ai * HALF + m * 16;
#pragma unroll
                for (int bj = 0; bj < 2; ++bj) { const f32x4 v0 = acc[ai][bj][m][0] * sc, v1 = acc[ai][bj][m][1] * sc; const int c = col0 + bj * HALF;
                    u32x4 w; w.x = cvt_pk_bf16(v0[0], v0[1]); w.y = cvt_pk_bf16(v0[2], v0[3]); w.z = cvt_pk_bf16(v1[0], v1[1]); w.w = cvt_pk_bf16(v1[2], v1[3]);
                    bf16_t* p;
                    if (isk) { const int b = t >> 13, tt = t & 8191, h = c >> 6, d8 = (c & 63) >> 3;
                        p = KF + ((((size_t)(b * 16 + h) * 256 + (tt >> 5)) * 4 + (d8 >> 1)) * 64 + (d8 & 1) * 32 + (tt & 31)) * 8; }
                    else p = Q + (size_t)t * 1024 + c;
                    *(u32x4*)p = w; } }
    }
};
struct EpiVF {
    static constexpr bool PERM = true; static constexpr int NAUX = 0;
    bf16_t* VF;
    __device__ __forceinline__ void operator()(const f32x4 (&acc)[2][2][4][2], const Unit& u, int wr, int wc, int fr, int fq, const LAS float* aux) const {
        asm volatile("" : "+v"(fr), "+v"(fq));
        const int row0 = u.pm * BM + wr * 64 + fr; const int col0 = u.pn * BM + wc * 32 + 8 * fq;
#pragma unroll
        for (int ai = 0; ai < 2; ++ai)
#pragma unroll
            for (int m = 0; m < 4; ++m) { const int dg = row0 + ai * HALF + m * 16; const int h = dg >> 6, dd = dg & 63;
#pragma unroll
                for (int bj = 0; bj < 2; ++bj) { const f32x4 v0 = acc[ai][bj][m][0], v1 = acc[ai][bj][m][1]; const int t = col0 + bj * HALF;
                    const int b = t >> 13, tt = t & 8191, t32 = tt & 31;
                    bf16_t* p = VF + (((((size_t)(b * 16 + h) * 256 + (tt >> 5)) * 2 + (dd >> 5)) * 2 + (t32 >> 4)) * 64 + (dd & 31)) * 8 + ((t32 >> 3) & 1) * 4;
                    u32x2 w0, w1; w0.x = cvt_pk_bf16(v0[0], v0[1]); w0.y = cvt_pk_bf16(v0[2], v0[3]); w1.x = cvt_pk_bf16(v1[0], v1[1]); w1.y = cvt_pk_bf16(v1[2], v1[3]);
                    *(u32x2*)p = w0; *(u32x2*)(p + 32 * 8) = w1; } }
    }
};
__device__ __forceinline__ float swiglu1(float xg, float xl) {
    const float g = fminf(xg, 7.0f), l = __builtin_amdgcn_fmed3f(xl, -7.0f, 7.0f);
    const float s = frcp(1.0f + fexp2(-1.702f * LOG2E * g));
    return g * s * (l + 1.0f);
}
struct EpiSwiglu {
    static constexpr bool PERM = true; static constexpr int NAUX = 0;
    bf16_t* O; const float* b1;
    __device__ __forceinline__ void operator()(const f32x4 (&acc)[2][2][4][2], const Unit& u, int wr, int wc, int fr, int fq, const LAS float* aux) const {
        asm volatile("" : "+v"(fr), "+v"(fq));
        const int row0 = u.pm * BM + wr * 64 + fr; const int col0 = u.pn * BM + wc * 32 + 8 * fq;
        const float* bp = b1 + (size_t)u.e * 2048 + col0;
        f32x4 bv[2][2];
#pragma unroll
        for (int bj = 0; bj < 2; ++bj)
#pragma unroll
            for (int n = 0; n < 2; ++n) bv[bj][n] = *(const f32x4*)(bp + bj * HALF + 4 * n);
#pragma unroll
        for (int ai = 0; ai < 2; ++ai)
#pragma unroll
            for (int m = 0; m < 4; ++m) { bf16_t* rowp = O + (size_t)(row0 + ai * HALF + m * 16) * 1024 + (col0 >> 1);
#pragma unroll
                for (int bj = 0; bj < 2; ++bj) { const f32x4 v0 = acc[ai][bj][m][0] + bv[bj][0], v1 = acc[ai][bj][m][1] + bv[bj][1];
                    u32x2 w; w.x = cvt_pk_bf16(swiglu1(v0[0], v0[1]), swiglu1(v0[2], v0[3])); w.y = cvt_pk_bf16(swiglu1(v1[0], v1[1]), swiglu1(v1[2], v1[3]));
                    *(u32x2*)(rowp + bj * (HALF / 2)) = w; } }
    }
};
struct EpiSwiglu8 {
    static constexpr bool PERM = true; static constexpr int NAUX = 1;
    __device__ __forceinline__ const float* aux_src(const Unit& u, int) const { return b1 + (size_t)u.e * 2048 + u.pn * BM; }
    unsigned char* O; const float* b1;
    __device__ __forceinline__ void operator()(const f32x4 (&acc)[2][2][4][2], const Unit& u, int wr, int wc, int fr, int fq, const LAS float* aux) const {
        asm volatile("" : "+v"(fr), "+v"(fq));
        const int row0 = u.pm * BM + wr * 64 + fr; const int col0 = u.pn * BM + wc * 32 + 8 * fq;
        f32x4 bv[2][2];
#pragma unroll
        for (int bj = 0; bj < 2; ++bj)
#pragma unroll
            for (int n = 0; n < 2; ++n) bv[bj][n] = *(const LAS f32x4*)(aux + wc * 32 + 8 * fq + bj * HALF + 4 * n);
#pragma unroll
        for (int ai = 0; ai < 2; ++ai)
#pragma unroll
            for (int m = 0; m < 4; ++m) {
                f32x2 g[4], l[4], t[4];
#pragma unroll
                for (int bj = 0; bj < 2; ++bj)
#pragma unroll
                    for (int n = 0; n < 2; ++n) { const f32x4 v = acc[ai][bj][m][n] + bv[bj][n]; const int o = bj * 2 + n;
                        g[o] = (f32x2){fminf(v[0], 7.0f), fminf(v[2], 7.0f)}; l[o] = (f32x2){__builtin_amdgcn_fmed3f(v[1], -7.0f, 7.0f), __builtin_amdgcn_fmed3f(v[3], -7.0f, 7.0f)} + 1.0f; }
#pragma unroll
                for (int i = 0; i < 4; ++i) { const f32x2 a = g[i] * (-1.702f * LOG2E); t[i] = (f32x2){fexp2(a.x), fexp2(a.y)}; }
                __builtin_amdgcn_sched_barrier(0);
#pragma unroll
                for (int i = 0; i < 4; ++i) { const f32x2 d = t[i] + 1.0f; t[i] = (f32x2){frcp(d.x), frcp(d.y)}; }
                __builtin_amdgcn_sched_barrier(0);
#pragma unroll
                for (int i = 0; i < 4; ++i) t[i] = (g[i] * t[i]) * l[i];
                unsigned char* rowp = O + (size_t)(row0 + ai * HALF + m * 16) * 1024 + (col0 >> 1);
                *(unsigned*)rowp = pk4_fp8_nc(t[0].x, t[0].y, t[1].x, t[1].y); *(unsigned*)(rowp + HALF / 2) = pk4_fp8_nc(t[2].x, t[2].y, t[3].x, t[3].y);
            }
    }
};
struct EpiDown {
    static constexpr bool PERM = true; static constexpr int NAUX = 0;
    bf16_t* O; const float* b2; const float* gatel;
    __device__ __forceinline__ void operator()(const f32x4 (&acc)[2][2][4][2], const Unit& u, int wr, int wc, int fr, int fq, const LAS float* aux) const {
        asm volatile("" : "+v"(fr), "+v"(fq));
        const int rl0 = wr * 64 + fr; const int col0 = u.pn * BM + wc * 32 + 8 * fq;
        const float* bp = b2 + (size_t)u.e * 1024 + col0; const float* gp = gatel + (size_t)u.e * T + u.mt * 256 + rl0;
        f32x4 bv[2][2];
#pragma unroll
        for (int bj = 0; bj < 2; ++bj)
#pragma unroll
            for (int n = 0; n < 2; ++n) bv[bj][n] = *(const f32x4*)(bp + bj * HALF + 4 * n);
#pragma unroll
        for (int ai = 0; ai < 2; ++ai)
#pragma unroll
            for (int m = 0; m < 4; ++m) { const float gt = gp[ai * HALF + m * 16]; bf16_t* rowp = O + (size_t)(u.pm * BM + rl0 + ai * HALF + m * 16) * 1024 + col0;
#pragma unroll
                for (int bj = 0; bj < 2; ++bj) { const f32x4 v0 = (acc[ai][bj][m][0] + bv[bj][0]) * gt, v1 = (acc[ai][bj][m][1] + bv[bj][1]) * gt;
                    u32x4 w; w.x = cvt_pk_bf16(v0[0], v0[1]); w.y = cvt_pk_bf16(v0[2], v0[3]); w.z = cvt_pk_bf16(v1[0], v1[1]); w.w = cvt_pk_bf16(v1[2], v1[3]);
                    *(u32x4*)(rowp + bj * HALF) = w; } }
    }
};

struct EpiDown8 {
    static constexpr bool PERM = true; static constexpr int NAUX = 2;
    __device__ __forceinline__ const float* aux_src(const Unit& u, int k) const { return k == 0 ? b2 + (size_t)u.e * 1024 + u.pn * BM : gatel + (size_t)u.e * T + u.mt * 256; }
    unsigned char* O; const float* b2; const float* gatel;
    __device__ __forceinline__ void operator()(const f32x4 (&acc)[2][2][4][2], const Unit& u, int wr, int wc, int fr, int fq, const LAS float* aux) const {
        asm volatile("" : "+v"(fr), "+v"(fq));
        const int rl0 = wr * 64 + fr; const int col0 = u.pn * BM + wc * 32 + 8 * fq;
        const LAS float* gp = aux + 256 + rl0;
        f32x4 bv[2][2];
#pragma unroll
        for (int bj = 0; bj < 2; ++bj)
#pragma unroll
            for (int n = 0; n < 2; ++n) bv[bj][n] = *(const LAS f32x4*)(aux + wc * 32 + 8 * fq + bj * HALF + 4 * n);
#pragma unroll
        for (int ai = 0; ai < 2; ++ai)
#pragma unroll
            for (int m = 0; m < 4; ++m) { const float gt = gp[ai * HALF + m * 16] * 16.0f; unsigned char* rowp = O + (size_t)(u.pm * BM + rl0 + ai * HALF + m * 16) * 1024 + col0;
#pragma unroll
                for (int bj = 0; bj < 2; ++bj) { const f32x4 v0 = (acc[ai][bj][m][0] + bv[bj][0]) * gt, v1 = (acc[ai][bj][m][1] + bv[bj][1]) * gt;
                    u32x2 w; w.x = pk4_fp8(v0[0], v0[1], v0[2], v0[3]); w.y = pk4_fp8(v1[0], v1[1], v1[2], v1[3]);
                    *(u32x2*)(rowp + bj * HALF) = w; } }
    }
};

template <class Epi, class Sched, int GATHER, int F8 = 0>
__device__ __forceinline__ void gemm_phase(LAS unsigned char* lds, const Gemm g, const Sched& S, const Epi& E, const int* tokl, LAS unsigned* rowtab, const int tid) {
    const int wid = __builtin_amdgcn_readfirstlane(tid >> 6), lane = tid & 63, wr = wid >> 2, wc = wid & 3, fr = lane & 15, fq = lane >> 4;
    const int K = g.K, nt = K / BK;
    unsigned voffA[2], voffB[2];
#pragma unroll
    for (int i = 0; i < 2; ++i) { int R, C; stage_rc(tid * 16 + i * 8192, R, C); const int Rb = Epi::PERM ? ((R & ~31) + perm32(R & 31)) : R;
        voffA[i] = (unsigned)(R * K + C) * 2u; voffB[i] = (unsigned)(Rb * K + C) * 2u; }
    const size_t kstep = (size_t)(BK * 2);
    const size_t hstep = (size_t)HALF * K * 2;
    const size_t tstep = 2 * hstep;
    const unsigned ldsw = (unsigned)wid * 1024u;
    const int aoff = lds_byte(wr * 64 + fr, fq * 8), boff = lds_byte(wc * 32 + fr, fq * 8);
    unsigned vC[2][2];
#define PG8_SA(b, h) (((b) * 2 + (h)) * HTB)
#define PG8_SB(b, h) ((4 + (b) * 2 + (h)) * HTB)
#define PG8_GLDS(gp, bufoff, i_) __builtin_amdgcn_global_load_lds((const unsigned*)(gp), (LAS unsigned*)(lds + (bufoff) + ldsw + (i_) * 8192), 16, 0, 0)
#define PG8_STAGE_B(bufoff, gbase) do { _Pragma("unroll") for (int _i = 0; _i < 2; ++_i) PG8_GLDS((const char*)(gbase) + voffB[_i], bufoff, _i); } while (0)
#define PG8_STAGE_A(bufoff, gbase, h, nx) do { _Pragma("unroll") for (int _i = 0; _i < 2; ++_i) { \
        if constexpr (GATHER) { PG8_GLDS((const char*)(gbase) + vC[h][_i], bufoff, _i); } \
        else PG8_GLDS((const char*)(gbase) + (h) * hstep + voffA[_i], bufoff, _i); } } while (0)
#define PG8_LDA(dst, b, h) do { _Pragma("unroll") for (int m = 0; m < 4; ++m) _Pragma("unroll") for (int k = 0; k < 2; ++k) dst[m][k] = *(const LAS bf16x8*)(lds + PG8_SA(b, h) + aoff + m * 2048 + k * 1024); } while (0)
#define PG8_LDB(dst, b, h) do { _Pragma("unroll") for (int n = 0; n < 2; ++n) _Pragma("unroll") for (int k = 0; k < 2; ++k) dst[n][k] = *(const LAS bf16x8*)(lds + PG8_SB(b, h) + boff + n * 2048 + k * 1024); } while (0)
#define PG8_MMA(ai, bj, At, Bt) do { __builtin_amdgcn_s_setprio(1); _Pragma("unroll") for (int m = 0; m < 4; ++m) _Pragma("unroll") for (int n = 0; n < 2; ++n) { \
        if constexpr (F8 != 0) {   \
            const i32x4 _b0 = __builtin_bit_cast(i32x4, Bt[n][0]), _b1 = __builtin_bit_cast(i32x4, Bt[n][1]), _a0 = __builtin_bit_cast(i32x4, At[m][0]), _a1 = __builtin_bit_cast(i32x4, At[m][1]); \
            const i32x8 _bb = __builtin_shufflevector(_b0, _b1, 0, 1, 2, 3, 4, 5, 6, 7), _aa = __builtin_shufflevector(_a0, _a1, 0, 1, 2, 3, 4, 5, 6, 7); \
            acc[ai][bj][m][n] = __builtin_amdgcn_mfma_scale_f32_16x16x128_f8f6f4(_bb, _aa, acc[ai][bj][m][n], 0, 0, 0, (int)(F8 * 0x01010101u), 0, 0x7f7f7f7f); \
        } else { _Pragma("unroll") for (int k = 0; k < 2; ++k) acc[ai][bj][m][n] = __builtin_amdgcn_mfma_f32_16x16x32_bf16(Bt[n][k], At[m][k], acc[ai][bj][m][n], 0, 0, 0); } } \
        __builtin_amdgcn_s_setprio(0); } while (0)
#define PG8_WAIT_V(n) asm volatile("s_waitcnt vmcnt(" #n ")" ::: "memory")
#define PG8_WAIT_L(n) asm volatile("s_waitcnt lgkmcnt(" #n ")" ::: "memory")
#define PG8_BAR __builtin_amdgcn_s_barrier()
#define PG8_SCHED __builtin_amdgcn_sched_barrier(0)
#define PG8_ROWDMA(u_, slot_) do { if (GATHER == 1 && wid < 4) __builtin_amdgcn_global_load_lds((const unsigned*)(tokl + (size_t)(u_).e * T + (u_).mt * 256 + wid * 64 + lane), (LAS unsigned*)(rowtab + (slot_) * 256 + wid * 64), 4, 0, 0); } while (0)
#define PG8_ROWOFF(dst, u_, slot_) do { _Pragma("unroll") for (int _i = 0; _i < 2; ++_i) { int _R, _C; stage_rc(tid * 16 + _i * 8192, _R, _C); _Pragma("unroll") for (int _h = 0; _h < 2; ++_h) { const int _r = _h * HALF + _R; \
        unsigned _t; if constexpr (GATHER == 1) { _t = rowtab[(slot_) * 256 + _r]; _t = (_r < (u_).valid) ? _t : 0u; } else _t = (unsigned)((u_).pm * 256 + _r); \
        dst[_h][_i] = _t * (unsigned)(K * 2) + (unsigned)_C * 2u; } } } while (0)
    Unit cur, nxt; int ui = 0;
    if (!S.next(0, cur)) return;
    f32x4 acc[2][2][4][2];
#pragma unroll
    for (int a = 0; a < 2; ++a)
#pragma unroll
        for (int b = 0; b < 2; ++b)
#pragma unroll
            for (int m = 0; m < 4; ++m)
#pragma unroll
                for (int n = 0; n < 2; ++n) acc[a][b][m][n] = (f32x4){0.f, 0.f, 0.f, 0.f};
    bf16x8 At[4][2], B0[2][2], B1[2][2];
    const char* cA = GATHER ? (const char*)g.A : (const char*)g.A + (size_t)cur.pm * tstep;
    const char* cB = (const char*)g.Bt + ((size_t)cur.e * g.brows + (size_t)cur.pn * BM) * K * 2;
    if constexpr (GATHER != 0) {
        PG8_ROWDMA(cur, 0); PG8_WAIT_V(0); __syncthreads();
        PG8_ROWOFF(vC, cur, 0);
        PG8_WAIT_L(0);
    }
    PG8_STAGE_B(PG8_SB(0, 0), cB); PG8_STAGE_B(PG8_SB(0, 1), cB + hstep); PG8_STAGE_A(PG8_SA(0, 0), cA, 0, false); PG8_STAGE_A(PG8_SA(0, 1), cA, 1, false);
    if (wr == 1) PG8_BAR;
    PG8_WAIT_V(2); PG8_BAR;
    PG8_STAGE_B(PG8_SB(1, 0), cB + kstep); PG8_STAGE_A(PG8_SA(1, 0), cA + kstep, 0, false); PG8_STAGE_B(PG8_SB(1, 1), cB + hstep + kstep);
    PG8_WAIT_V(6); PG8_BAR;
    for (;;) {
        if constexpr (Epi::NAUX > 0) { if (wid < Epi::NAUX) __builtin_amdgcn_global_load_lds((const unsigned*)(E.aux_src(cur, wid) + lane * 4), (LAS unsigned*)(lds + AUX_OFF + (ui & 1) * 2048 + wid * 1024), 16, 0, 0); }
        const bool has_next = S.next(ui + 1, nxt);
        if constexpr (GATHER) { if (has_next) PG8_ROWDMA(nxt, (ui + 1) & 1); }
        const char* nA = has_next ? (GATHER ? (const char*)g.A : (const char*)g.A + (size_t)nxt.pm * tstep) : cA;
        const char* nB = has_next ? (const char*)g.Bt + ((size_t)nxt.e * g.brows + (size_t)nxt.pn * BM) * K * 2 : cB;
#pragma unroll 1
        for (int t = 0; t < nt; t += 2) {
            const bool last = (t == nt - 2);
            const char* a1 = cA + (size_t)(t + 1) * kstep;
            const char* a2 = last ? nA : cA + (size_t)(t + 2) * kstep; const char* b2 = last ? nB : cB + (size_t)(t + 2) * kstep;
            const char* a3 = a2 + kstep; const char* b3 = b2 + kstep;
            PG8_LDB(B0, 0, 0); PG8_LDB(B1, 0, 1); PG8_SCHED; PG8_LDA(At, 0, 0); PG8_STAGE_A(PG8_SA(1, 1), a1, 1, false);
            if constexpr (GATHER) { if (last && has_next) { PG8_ROWOFF(vC, nxt, (ui + 1) & 1); } }
            PG8_WAIT_V(8); PG8_WAIT_L(0); PG8_BAR; PG8_MMA(0, 0, At, B0); PG8_MMA(0, 1, At, B1); PG8_BAR; PG8_SCHED;
            PG8_LDA(At, 0, 1); PG8_STAGE_B(PG8_SB(0, 0), b2); PG8_STAGE_B(PG8_SB(0, 1), b2 + hstep); PG8_STAGE_A(PG8_SA(0, 0), a2, 0, last);
            PG8_WAIT_V(8); PG8_WAIT_L(0); PG8_BAR; PG8_MMA(1, 0, At, B0); PG8_MMA(1, 1, At, B1); PG8_BAR; PG8_SCHED;
            PG8_LDB(B0, 1, 0); PG8_LDB(B1, 1, 1); PG8_SCHED; PG8_LDA(At, 1, 0); PG8_STAGE_A(PG8_SA(0, 1), a2, 1, last);
            PG8_WAIT_V(8); PG8_WAIT_L(0); PG8_BAR; PG8_MMA(0, 0, At, B0); PG8_MMA(0, 1, At, B1); PG8_BAR; PG8_SCHED;
            PG8_LDA(At, 1, 1); PG8_STAGE_B(PG8_SB(1, 0), b3); PG8_STAGE_B(PG8_SB(1, 1), b3 + hstep); PG8_STAGE_A(PG8_SA(1, 0), a3, 0, last);
            PG8_WAIT_V(8); PG8_WAIT_L(0); PG8_BAR; PG8_MMA(1, 0, At, B0); PG8_MMA(1, 1, At, B1); PG8_BAR; PG8_SCHED;
        }
        if (wr == 0) PG8_BAR;
        E(acc, cur, wr, wc, fr, fq, (const LAS float*)(lds + AUX_OFF + (ui & 1) * 2048));
#if defined(PROBE_EPI2)
        E(acc, cur, wr, wc, fr, fq, (const LAS float*)(lds + AUX_OFF + (ui & 1) * 2048));
#endif
        if (!has_next) break;
#pragma unroll
        for (int a = 0; a < 2; ++a)
#pragma unroll
            for (int b = 0; b < 2; ++b)
#pragma unroll
                for (int m = 0; m < 4; ++m)
#pragma unroll
                    for (int n = 0; n < 2; ++n) acc[a][b][m][n] = (f32x4){0.f, 0.f, 0.f, 0.f};
        cur = nxt; cA = nA; cB = nB; ++ui;
        if (wr == 1) PG8_BAR;
    }
    PG8_WAIT_V(0);
    PG8_BAR;
#undef PG8_SA
#undef PG8_SB
#undef PG8_GLDS
#undef PG8_STAGE_A
#undef PG8_STAGE_B
#undef PG8_LDA
#undef PG8_LDB
#undef PG8_MMA
#undef PG8_WAIT_V
#undef PG8_WAIT_L
#undef PG8_BAR
#undef PG8_SCHED
#undef PG8_ROWDMA
#undef PG8_ROWOFF
}
}

constexpr size_t MiB = 1u << 20;
constexpr size_t WS_CTL = 0, CTL_ZERO_BYTES = 128 * 1024;
constexpr size_t WS_TOKL = 1 * MiB, WS_GATEL = 5 * MiB, WS_TINFO = 9 * MiB;
constexpr size_t WS_WIN0T = 10 * MiB, WS_WO0T = 15 * MiB, WS_WIN1T = 17 * MiB, WS_WO1T = 23 * MiB;
constexpr size_t WS_W1T = 26 * MiB, WS_W2T = 154 * MiB, WS_XB = 218 * MiB;
constexpr size_t WS_SA = 282 * MiB, WS_SB = 554 * MiB, WS_XB8 = 826 * MiB, WS_END = 858 * MiB;
constexpr int CW_BAR = 4096, CW_CNT = 16384;

constexpr int RING_BYTES = 131072;
constexpr int ROWTAB_OFF = RING_BYTES;
constexpr int MOETAB_OFF = ROWTAB_OFF + 2048;
constexpr int MISC_OFF = MOETAB_OFF + 512;
constexpr int LDS_BYTES = 147456;
static_assert(pg8::AUX_OFF == MISC_OFF + 256 && pg8::AUX_OFF + 4096 <= LDS_BYTES, "LDS map");

#define XB_TMO      128
#define XB_XCNT(j)  (256  + 64 * (j))
#define XB_XSUB(j)  (1280 + 64 * (j))
#define XB_XGEN(j)  (2304 + 64 * (j))
#define XB_TOP      3328
#define XB_TOPGEN   3392
#define XCD_BAR_WORDS 3456
#define XB_SPIN_CAP (1u << 20)
__device__ __forceinline__ unsigned xb_ld(unsigned* p)              { return __hip_atomic_load(p, __ATOMIC_RELAXED, __HIP_MEMORY_SCOPE_AGENT); }
__device__ __forceinline__ unsigned xb_add(unsigned* p, unsigned v) { return __hip_atomic_fetch_add(p, v, __ATOMIC_RELAXED, __HIP_MEMORY_SCOPE_AGENT); }
__device__ __forceinline__ unsigned xb_xcc_id() { return (unsigned)__builtin_amdgcn_s_getreg((3 << 11) | 20) & 0xFu; }
#define XB_SPIN(cond, bar) do { unsigned _sp = 0; while (cond) { __builtin_amdgcn_s_sleep(1); \
    if ((++_sp & 255u) == 0u) { if (xb_ld(&(bar)[XB_TMO])) break; if (_sp > XB_SPIN_CAP) { atomicAdd(&(bar)[XB_TMO], 1u); break; } } } } while (0)
struct XcdBarrier { unsigned* bar; unsigned x; volatile LAS unsigned* st; int wave; };
__device__ __forceinline__ XcdBarrier xcd_barrier_post(unsigned* bar, volatile LAS unsigned* st) {
    XcdBarrier b; b.bar = bar; b.x = xb_xcc_id(); b.st = st; b.wave = __builtin_amdgcn_readfirstlane(threadIdx.x >> 6);
    if (threadIdx.x == 0) (void)xb_add(&bar[XB_XCNT(b.x)], 1u);
    return b;
}
__device__ __forceinline__ void xcd_barrier_complete(unsigned* bar, unsigned x, unsigned& nloc, unsigned& nx) {
    const unsigned G = gridDim.x * gridDim.y * gridDim.z;
    unsigned sum, cnt, mine, sp = 0u;
    for (;;) {
        sum = 0u; cnt = 0u; mine = 0u;
#pragma unroll
        for (unsigned j = 0; j < 16; ++j) { const unsigned c = xb_ld(&bar[XB_XCNT(j)]); sum += c; cnt += (c > 0u) ? 1u : 0u; mine = (j == x) ? c : mine; }
        if (sum == G) break;
        __builtin_amdgcn_s_sleep(1);
        if ((++sp & 255u) == 0u) { if (xb_ld(&bar[XB_TMO])) break; if (sp > XB_SPIN_CAP) { atomicAdd(&bar[XB_TMO], 1u); break; } }
    }
    nloc = mine > 0u ? mine : 1u; nx = cnt > 0u ? cnt : 1u;
}
__device__ __forceinline__ void xcd_barrier(const XcdBarrier& b) {
    asm volatile("s_waitcnt vmcnt(0)" ::: "memory");
    __syncthreads();
    if (b.wave == 0 && lane_id_asm() == 0) {
        unsigned* bar = b.bar;
        __builtin_amdgcn_s_waitcnt(0);
        unsigned nloc = b.st[0], nx = b.st[1];
        if (nloc == 0u) { xcd_barrier_complete(bar, b.x, nloc, nx); b.st[0] = nloc; b.st[1] = nx; }
        const unsigned old = xb_add(&bar[XB_XSUB(b.x)], 1u);
        const unsigned gen = old / nloc;
        if (old + 1u == (gen + 1u) * nloc) {
            __builtin_amdgcn_fence(__ATOMIC_RELEASE, "agent");
            asm volatile("s_waitcnt vmcnt(0)" ::: "memory");
            const unsigned og = xb_add(&bar[XB_TOP], 1u);
            const unsigned tg = og / nx;
            if (og + 1u == (tg + 1u) * nx) xb_add(&bar[XB_TOPGEN], 1u);
            else XB_SPIN(xb_ld(&bar[XB_TOPGEN]) == tg, bar);
            __builtin_amdgcn_fence(__ATOMIC_ACQUIRE, "agent");
            xb_add(&bar[XB_XGEN(b.x)], 1u);
            asm volatile("s_waitcnt vmcnt(0)" ::: "memory");
        } else {
            XB_SPIN(xb_ld(&bar[XB_XGEN(b.x)]) == gen, bar);
            __builtin_amdgcn_fence(__ATOMIC_ACQUIRE, "agent");
            asm volatile("s_waitcnt vmcnt(0)" ::: "memory");
        }
    }
    __syncthreads();
}

#define LDS_WAIT() asm volatile("s_waitcnt lgkmcnt(0)" ::: "memory")
#define LDS_BARRIER() do { asm volatile("s_waitcnt lgkmcnt(0)" ::: "memory"); __builtin_amdgcn_s_barrier(); asm volatile("" ::: "memory"); } while (0)
__device__ __forceinline__ float wave_sum(float v) {
#pragma unroll
    for (int o = 1; o < 64; o <<= 1) v += __shfl_xor(v, o);
    return v;
}
__device__ __forceinline__ void transpose_item(const float* W, int ldw, bf16_t* WT, int ldt, int k0, int n0, int dst_row0, LAS float* scr, int lane, int rstride = 1) {
#pragma unroll 8
    for (int i = 0; i < 32; ++i) { const int kk = 2 * i + (lane >> 5); scr[kk * 33 + (lane & 31)] = W[(size_t)(k0 + kk) * ldw + n0 + (lane & 31)]; }
    LDS_WAIT(); asm volatile("" ::: "memory");
    const int c = lane & 7;
#pragma unroll
    for (int j = 0; j < 4; ++j) { const int n = (lane >> 3) + 8 * j; const LAS float* s = scr + (8 * c) * 33 + n;
        u32x4 o; o.x = pk2(s[0 * 33], s[1 * 33]); o.y = pk2(s[2 * 33], s[3 * 33]); o.z = pk2(s[4 * 33], s[5 * 33]); o.w = pk2(s[6 * 33], s[7 * 33]);
        *(u32x4*)(WT + (size_t)(dst_row0 + n * rstride) * ldt + k0 + 8 * c) = o; }
    LDS_WAIT(); asm volatile("" ::: "memory");
}
constexpr int W1_SH = 6, W2_SH = 7;
__device__ __forceinline__ void conv_moe_wg(const float* w1, const float* w2, unsigned char* W1T, unsigned char* W2T, LAS float* buf, int bx, int G, int tid, int j0, int j1) {
    constexpr int I1 = 8 * 16, I2 = 8 * 8, NIT = NE * (I1 + I2);
    const int lrow = tid >> 5, lcol = (tid & 31) * 4;
    f32x4 ra[8], rb[8];
#define CM_SRC(it_, src_, ldw_) const float* src_; int ldw_; { if ((it_) < NE * I1) { const int e_ = (it_) >> 7, q_ = (it_) & 127, kb_ = q_ >> 4, nb_ = q_ & 15; ldw_ = 2048; src_ = w1 + (size_t)e_ * 1024 * 2048 + (size_t)(128 * kb_) * 2048 + 128 * nb_; } \
        else { const int j_ = (it_) - NE * I1, e_ = j_ >> 6, q_ = j_ & 63, kb_ = q_ >> 3, nb_ = q_ & 7; ldw_ = 1024; src_ = w2 + (size_t)e_ * 1024 * 1024 + (size_t)(128 * kb_) * 1024 + 128 * nb_; } }
#define CM_LOAD(R_, it_) do { CM_SRC(it_, sp_, lw_); _Pragma("unroll") for (int i = 0; i < 8; ++i) R_[i] = __builtin_nontemporal_load((const f32x4*)(sp_ + (size_t)(lrow + 16 * i) * lw_ + lcol)); } while (0)
#define CM_ITEM(R_, it_) do { \
        _Pragma("unroll") for (int i = 0; i < 8; ++i) *(LAS f32x4*)(buf + (lrow + 16 * i) * 132 + (lcol ^ (8 * (i & 3)))) = R_[i];     \
        __syncthreads(); \
        if ((it_) + 2 * G < itend) CM_LOAD(R_, (it_) + 2 * G); \
        unsigned char* dst; float sc; \
        if ((it_) < NE * I1) { const int e = (it_) >> 7, q = (it_) & 127, kb = q >> 4, nb = q & 15; dst = W1T + (size_t)e * 2048 * 1024 + (size_t)(128 * nb) * 1024 + 128 * kb; sc = (float)(1 << W1_SH); } \
        else { const int j = (it_) - NE * I1, e = j >> 6, q = j & 63, kb = q >> 3, nb = q & 7; dst = W2T + (size_t)e * 1024 * 1024 + (size_t)(128 * nb) * 1024 + 128 * kb; sc = (float)(1 << W2_SH); } \
        const int c = tid & 7; \
        _Pragma("unroll") for (int p = 0; p < 2; ++p) { const int nn = (tid >> 3) + 64 * p; const LAS float* sp = buf + (16 * c) * 132 + (nn ^ (8 * (c & 3))); \
            u32x4 o; \
            o.x = pk4_fp8(sp[0 * 132] * sc, sp[1 * 132] * sc, sp[2 * 132] * sc, sp[3 * 132] * sc); o.y = pk4_fp8(sp[4 * 132] * sc, sp[5 * 132] * sc, sp[6 * 132] * sc, sp[7 * 132] * sc); \
            o.z = pk4_fp8(sp[8 * 132] * sc, sp[9 * 132] * sc, sp[10 * 132] * sc, sp[11 * 132] * sc); o.w = pk4_fp8(sp[12 * 132] * sc, sp[13 * 132] * sc, sp[14 * 132] * sc, sp[15 * 132] * sc); \
            *(u32x4*)(dst + (size_t)nn * 1024 + 16 * c) = o; } \
        __syncthreads(); } while (0)
    int it = bx + j0 * G; const int itend = (bx + j1 * G) < NIT ? (bx + j1 * G) : NIT;
    __syncthreads();
    if (it < itend) CM_LOAD(ra, it);
    if (it + G < itend) CM_LOAD(rb, it + G);
    for (; it < itend; it += 2 * G) {
        CM_ITEM(ra, it);
        if (it + G < itend) CM_ITEM(rb, it + G);
    }
#undef CM_ITEM
#undef CM_SRC
#undef CM_LOAD
}
__device__ __forceinline__ void ln_row(f32x4 (&v)[4], const float* w, const float* b, int lane) {
    float s = 0.f;
#pragma unroll
    for (int j = 0; j < 4; ++j) s += (v[j].x + v[j].y) + (v[j].z + v[j].w);
    const float mean = wave_sum(s) * (1.f / D); float s2 = 0.f;
#pragma unroll
    for (int j = 0; j < 4; ++j) { v[j] = v[j] - mean; s2 += (v[j].x * v[j].x + v[j].y * v[j].y) + (v[j].z * v[j].z + v[j].w * v[j].w); }
    const float rstd = 1.f / sqrtf(wave_sum(s2) * (1.f / D) + LN_EPS);
#pragma unroll
    for (int j = 0; j < 4; ++j) { const f32x4 ww = *(const f32x4*)(w + 4 * lane + 256 * j), bb = *(const f32x4*)(b + 4 * lane + 256 * j); v[j] = v[j] * rstd * ww + bb; }
}
__device__ __forceinline__ void moe_table(const unsigned* cnt, LAS int* tab, int tid) {
    if (tid < 32) tab[33 + tid] = (int)__hip_atomic_load(cnt + tid, __ATOMIC_RELAXED, __HIP_MEMORY_SCOPE_AGENT);
    __syncthreads();
    if (tid == 0) { int p = 0; for (int e = 0; e < 32; ++e) { tab[e] = p; p += (tab[33 + e] + 255) >> 8; } tab[32] = p; }
    __syncthreads();
}

constexpr int HG_KUT = 0, HG_DD = 18432, HG_QH = 20480, HG_KD = 37888, HG_OB = 55296, HG_RED = 89088, HG_G = 91136;
template <int MODE>
__device__ __forceinline__ void hgrn_unit(LAS unsigned char* lds, int unit, const bf16_t* PROJ, const bf16_t* IT, float* SLOC, float* DTOT, const float* lbl, const float* anw, bf16_t* AO, int tid, int wave, int lane) {
    const int bh = unit >> 5, sc = unit & 31, b = bh >> 2, h = bh & 3;
    const int t0 = sc * 256;
    const int si = tid >> 7, dk = tid & 127;
    const int g = lane >> 4, c16 = lane & 15;
    float lb;
    { const float l0 = lbl[h * 128 + dk], l1 = lbl[512 + h * 128 + dk], l2 = lbl[1024 + h * 128 + dk]; const float m = fmaxf(l0, fmaxf(l1, l2));
      const float e0 = __expf(l0 - m), e1 = __expf(l1 - m), e2 = __expf(l2 - m); lb = e0 / (e0 + e1 + e2); }
    const float oml = 1.0f - lb;
    f32x4 S[8];
#pragma unroll
    for (int tau = 0; tau < 8; ++tau) {
        if (MODE == 1) {
#pragma unroll
            for (int r = 0; r < 4; ++r) S[tau][r] = SLOC[(size_t)unit * 16384 + (16 * tau + 4 * g + r) * 128 + 16 * wave + c16];
        } else S[tau] = (f32x4){0.f, 0.f, 0.f, 0.f};
    }
    float lsum = 1.f;
    unsigned qz[16]; u32x2 vfn[4];
    const unsigned rlo = (unsigned)(16 * si * 2048 + 2 * dk);
    { const bf16_t* sb = PROJ + ((size_t)b * SEQ + t0) * 2048 + h * 256;
#pragma unroll
      for (int j = 0; j < 16; ++j) qz[j] = *(const unsigned*)(sb + (size_t)j * 2048 + rlo);
      const bf16_t* vp = IT + (size_t)(h * 128 + 16 * wave + c16) * T + (size_t)b * SEQ + t0 + 4 * g;
#pragma unroll
      for (int i = 0; i < 4; ++i) vfn[i] = *(const u32x2*)(vp + 16 * i); }
#pragma unroll 1
    for (int c4 = 0; c4 < 4; ++c4) {
        const int tc = t0 + 64 * c4;
        if (MODE == 1) {
#pragma unroll
            for (int i = 0; i < 2; ++i) { const int r0 = 8 * wave + 4 * i;
                __builtin_amdgcn_global_load_lds((const unsigned*)(PROJ + ((size_t)b * SEQ + tc + r0 + (lane >> 4)) * 2048 + 1024 + h * 128 + 8 * (lane & 15)), (LAS unsigned*)(lds + HG_G + r0 * 256), 16, 0, 0); }
        }
        u32x2 vf[4];
#pragma unroll
        for (int i = 0; i < 4; ++i) vf[i] = vfn[i];
        {
            float cp = 1.f, kdf[16];
#pragma unroll
            for (int j = 0; j < 16; ++j) {
                const float z = bfhi(qz[j]);
                const float s = frcp(1.0f + fexp2(-LOG2E * z));
                const float f = lb + oml * s, kk = oml * (1.0f - s);
                cp *= f; kdf[j] = kk * frcp(cp);
                if (MODE == 1) {
                    const float q = bflo(qz[j]);
                    const unsigned qh = pk2(q * cp, 0.f), kd = pk2(kdf[j], 0.f);
                    *(LAS bf16_t*)(lds + HG_QH + (16 * si + j) * 272 + dk * 2) = (bf16_t)(qh & 0xffffu);
                    *(LAS bf16_t*)(lds + HG_KD + (16 * si + j) * 272 + dk * 2) = (bf16_t)(kd & 0xffffu);
                }
            }
            if (c4 < 3) {
                const bf16_t* sb = PROJ + ((size_t)b * SEQ + tc + 64) * 2048 + h * 256;
#pragma unroll
                for (int j = 0; j < 16; ++j) qz[j] = *(const unsigned*)(sb + (size_t)j * 2048 + rlo);
                const bf16_t* vp = IT + (size_t)(h * 128 + 16 * wave + c16) * T + (size_t)b * SEQ + tc + 64 + 4 * g;
#pragma unroll
                for (int i = 0; i < 4; ++i) vfn[i] = *(const u32x2*)(vp + 16 * i);
            }
            const float dl = cp; lsum *= dl;
            u32x4 w0, w1;
            w0.x = pk2(kdf[0] * dl, kdf[1] * dl); w0.y = pk2(kdf[2] * dl, kdf[3] * dl); w0.z = pk2(kdf[4] * dl, kdf[5] * dl); w0.w = pk2(kdf[6] * dl, kdf[7] * dl);
            w1.x = pk2(kdf[8] * dl, kdf[9] * dl); w1.y = pk2(kdf[10] * dl, kdf[11] * dl); w1.z = pk2(kdf[12] * dl, kdf[13] * dl); w1.w = pk2(kdf[14] * dl, kdf[15] * dl);
            *(LAS u32x4*)(lds + HG_KUT + dk * 144 + si * 32) = w0;
            *(LAS u32x4*)(lds + HG_KUT + dk * 144 + si * 32 + 16) = w1;
            *(LAS float*)(lds + HG_DD + (si * 128 + dk) * 4) = dl;
        }
        LDS_BARRIER();
#pragma unroll
        for (int i = 0; i < 4; ++i) {
            bf16x8 vb; { const s16x4 t4 = __builtin_bit_cast(s16x4, vf[i]); vb = (bf16x8){t4[0], t4[1], t4[2], t4[3], 0, 0, 0, 0}; }
            if (MODE == 1) {
                f32x4 X = (f32x4){0.f, 0.f, 0.f, 0.f};
#pragma unroll
                for (int m = 0; m < 4; ++m) {
                    const bf16x8 a = *(const LAS bf16x8*)(lds + HG_KD + (16 * i + c16) * 272 + (32 * m + 8 * g) * 2);
                    const bf16x8 bq = *(const LAS bf16x8*)(lds + HG_QH + (16 * i + c16) * 272 + (32 * m + 8 * g) * 2);
                    X = __builtin_amdgcn_mfma_f32_16x16x32_bf16(a, bq, X, 0, 0, 0);
                }
#pragma unroll
                for (int r = 0; r < 4; ++r) X[r] = (4 * g + r <= c16) ? X[r] : 0.f;
                bf16x8 xa; { u32x2 p; p.x = pk2(X[0], X[1]); p.y = pk2(X[2], X[3]); const s16x4 t4 = __builtin_bit_cast(s16x4, p); xa = (bf16x8){t4[0], t4[1], t4[2], t4[3], 0, 0, 0, 0}; }
                f32x4 O = (f32x4){0.f, 0.f, 0.f, 0.f};
                O = __builtin_amdgcn_mfma_f32_16x16x32_bf16(xa, vb, O, 0, 0, 0);
#pragma unroll
                for (int m = 0; m < 4; ++m) {
                    u32x4 bs; bs.x = pk2(S[2 * m][0], S[2 * m][1]); bs.y = pk2(S[2 * m][2], S[2 * m][3]); bs.z = pk2(S[2 * m + 1][0], S[2 * m + 1][1]); bs.w = pk2(S[2 * m + 1][2], S[2 * m + 1][3]);
                    const u32x2 q0 = *(const LAS u32x2*)(lds + HG_QH + (16 * i + c16) * 272 + (32 * m + 4 * g) * 2);
                    const u32x2 q1 = *(const LAS u32x2*)(lds + HG_QH + (16 * i + c16) * 272 + (32 * m + 16 + 4 * g) * 2);
                    u32x4 aq; aq.x = q0.x; aq.y = q0.y; aq.z = q1.x; aq.w = q1.y;
                    O = __builtin_amdgcn_mfma_f32_16x16x32_bf16(__builtin_bit_cast(bf16x8, aq), __builtin_bit_cast(bf16x8, bs), O, 0, 0, 0);
                }
#pragma unroll
                for (int r = 0; r < 4; ++r) *(LAS float*)(lds + HG_OB + ((16 * i + 4 * g + r) * 132 + 16 * wave + c16) * 4) = O[r];
            }
#pragma unroll
            for (int tau = 0; tau < 8; ++tau) {
                const f32x4 dd = *(const LAS f32x4*)(lds + HG_DD + (i * 128 + 16 * tau + 4 * g) * 4);
                S[tau] = S[tau] * dd;
                const u32x2 k2 = *(const LAS u32x2*)(lds + HG_KUT + (16 * tau + c16) * 144 + (16 * i + 4 * g) * 2);
                u32x4 ak; ak.x = k2.x; ak.y = k2.y; ak.z = 0u; ak.w = 0u;
                S[tau] = __builtin_amdgcn_mfma_f32_16x16x32_bf16(__builtin_bit_cast(bf16x8, ak), vb, S[tau], 0, 0, 0);
            }
        }
        if (MODE == 1) asm volatile("s_waitcnt vmcnt(0)" ::: "memory");
        LDS_BARRIER();
        if (MODE == 1) {
            const int tl = tid >> 3, part = tid & 7;
            float o[16]; float ssq = 0.f;
#pragma unroll
            for (int q4 = 0; q4 < 4; ++q4) { const f32x4 v = *(const LAS f32x4*)(lds + HG_OB + (tl * 132 + 16 * part + 4 * q4) * 4);
                o[4 * q4] = v.x; o[4 * q4 + 1] = v.y; o[4 * q4 + 2] = v.z; o[4 * q4 + 3] = v.w; ssq += (v.x * v.x + v.y * v.y) + (v.z * v.z + v.w * v.w); }
            ssq += __shfl_xor(ssq, 1); ssq += __shfl_xor(ssq, 2); ssq += __shfl_xor(ssq, 4);
            const float rr = 1.0f / sqrtf(ssq * (1.0f / 128.0f) + RMS_EPS);
            const size_t row = (size_t)b * SEQ + tc + tl;
            const u32x4 g0 = *(const LAS u32x4*)(lds + HG_G + tl * 256 + part * 32), g1 = *(const LAS u32x4*)(lds + HG_G + tl * 256 + part * 32 + 16);
            float gv[16];
            gv[0] = bflo(g0.x); gv[1] = bfhi(g0.x); gv[2] = bflo(g0.y); gv[3] = bfhi(g0.y); gv[4] = bflo(g0.z); gv[5] = bfhi(g0.z); gv[6] = bflo(g0.w); gv[7] = bfhi(g0.w);
            gv[8] = bflo(g1.x); gv[9] = bfhi(g1.x); gv[10] = bflo(g1.y); gv[11] = bfhi(g1.y); gv[12] = bflo(g1.z); gv[13] = bfhi(g1.z); gv[14] = bflo(g1.w); gv[15] = bfhi(g1.w);
            float r16[16];
#pragma unroll
            for (int j = 0; j < 16; ++j) { const float gg = gv[j]; const float sg = gg * frcp(1.0f + fexp2(-LOG2E * gg)); r16[j] = o[j] * rr * anw[16 * part + j] * sg; }
            u32x4 o0, o1;
            o0.x = pk2(r16[0], r16[1]); o0.y = pk2(r16[2], r16[3]); o0.z = pk2(r16[4], r16[5]); o0.w = pk2(r16[6], r16[7]);
            o1.x = pk2(r16[8], r16[9]); o1.y = pk2(r16[10], r16[11]); o1.z = pk2(r16[12], r16[13]); o1.w = pk2(r16[14], r16[15]);
            *(u32x4*)(AO + row * 1024 + h * 128 + 16 * part) = o0; *(u32x4*)(AO + row * 1024 + h * 128 + 16 * part + 8) = o1;
        }
    }
    if (MODE == 0) {
#pragma unroll
        for (int tau = 0; tau < 8; ++tau)
#pragma unroll
            for (int r = 0; r < 4; ++r) SLOC[(size_t)unit * 16384 + (16 * tau + 4 * g + r) * 128 + 16 * wave + c16] = S[tau][r];
        *(LAS float*)(lds + HG_RED + (si * 128 + dk) * 4) = lsum;
        __syncthreads();
        if (tid < 128) { const float tot = (*(LAS float*)(lds + HG_RED + tid * 4) * *(LAS float*)(lds + HG_RED + (128 + tid) * 4)) * (*(LAS float*)(lds + HG_RED + (256 + tid) * 4) * *(LAS float*)(lds + HG_RED + (384 + tid) * 4));
            DTOT[(size_t)unit * 128 + tid] = tot; }
    }
    __syncthreads();
}

template <int W>
__device__ __forceinline__ void pool_lane(int b, int tb, int ch, const bf16_t* PROJ, bf16_t* AO) {
    const bf16_t* xp = PROJ + (size_t)b * SEQ * 2048 + 1536 + ch;
    u32x4 cur[8], prev[W - 1];
#pragma unroll
    for (int j = 0; j < 8; ++j) cur[j] = *(const u32x4*)(xp + (size_t)(tb + j) * 2048);
#pragma unroll
    for (int r = 1; r < W; ++r) { prev[r - 1] = (u32x4){0u, 0u, 0u, 0u}; if (tb - r >= 0) prev[r - 1] = *(const u32x4*)(xp + (size_t)(tb - r) * 2048); }
#define POOL_ACC(op_, v_) do { s[0] op_ bflo((v_).x); s[1] op_ bfhi((v_).x); s[2] op_ bflo((v_).y); s[3] op_ bfhi((v_).y); s[4] op_ bflo((v_).z); s[5] op_ bfhi((v_).z); s[6] op_ bflo((v_).w); s[7] op_ bfhi((v_).w); } while (0)
    float s[8];
#pragma unroll
    for (int c = 0; c < 8; ++c) s[c] = 0.f;
#pragma unroll
    for (int r = 1; r < W; ++r) POOL_ACC(+=, prev[r - 1]);
#pragma unroll
    for (int j = 0; j < 8; ++j) {
        const int t = tb + j; const u32x4 v = cur[j];
        float x[8]; x[0] = bflo(v.x); x[1] = bfhi(v.x); x[2] = bflo(v.y); x[3] = bfhi(v.y); x[4] = bflo(v.z); x[5] = bfhi(v.z); x[6] = bflo(v.w); x[7] = bfhi(v.w);
        const float cnt = (float)((t + 1) < W ? (t + 1) : W);
        float o[8];
#pragma unroll
        for (int c = 0; c < 8; ++c) { s[c] += x[c]; o[c] = s[c] / cnt - x[c]; }
        u32x4 w; w.x = pk2(o[0], o[1]); w.y = pk2(o[2], o[3]); w.z = pk2(o[4], o[5]); w.w = pk2(o[6], o[7]);
        *(u32x4*)(AO + ((size_t)b * SEQ + t) * 1024 + 512 + ch) = w;
        if (j - W + 1 >= 0) POOL_ACC(-=, cur[j - W + 1 >= 0 ? j - W + 1 : 0]); else POOL_ACC(-=, prev[W - 2 - j >= 0 ? W - 2 - j : 0]);
    }
#undef POOL_ACC
}
__device__ __forceinline__ void pool_task(int task, const bf16_t* PROJ, bf16_t* AO, int wave, int lane) {
    const int b = task >> 6, blk = task & 63;
    const int grp = wave & 3, ch = grp * 128 + (lane & 15) * 8;
#pragma unroll 1
    for (int p = 0; p < 2; ++p) { const int tb = blk * 128 + (wave >> 2) * 64 + p * 32 + (lane >> 4) * 8;
        if (grp == 0) pool_lane<2>(b, tb, ch, PROJ, AO); else if (grp == 1) pool_lane<4>(b, tb, ch, PROJ, AO); else if (grp == 2) pool_lane<8>(b, tb, ch, PROJ, AO); else pool_lane<16>(b, tb, ch, PROJ, AO); }
}

constexpr int RT_YS = 1028;
constexpr int RT_Y = 0, RT_PART = 66048, RT_LOG = 82432, RT_SELE = 99328, RT_SELG = 101376, RT_SELR = 103424, RT_HIST = 105472, RT_BASE = 105600, RT_LNW = 105728;
__device__ __forceinline__ void wave_sum4(float& a, float& b, float& c, float& d) {
#pragma unroll
    for (int o = 1; o < 64; o <<= 1) { const float ta = __shfl_xor(a, o), tb = __shfl_xor(b, o), tc = __shfl_xor(c, o), td = __shfl_xor(d, o); a += ta; b += tb; c += tc; d += td; }
}
__device__ __forceinline__ void split_hl(const float (&x)[8], u32x4& hi, u32x4& lo) {
    unsigned h[4], l[4];
#pragma unroll
    for (int i = 0; i < 4; ++i) { h[i] = pk2(x[2 * i], x[2 * i + 1]); l[i] = pk2(x[2 * i] - bflo(h[i]), x[2 * i + 1] - bfhi(h[i])); }
    hi = (u32x4){h[0], h[1], h[2], h[3]}; lo = (u32x4){l[0], l[1], l[2], l[3]};
}
__device__ __forceinline__ void router_load_w(const float* wr, u32x4 (&wreg)[16], int wave, int lane) {
    const float* wp = wr + (size_t)(128 * wave + 8 * (lane >> 4)) * 32 + (lane & 15);
#pragma unroll
    for (int kk = 0; kk < 4; ++kk)
#pragma unroll
        for (int tl = 0; tl < 2; ++tl) { float x[8];
#pragma unroll
            for (int j = 0; j < 8; ++j) x[j] = wp[(32 * kk + j) * 32 + 16 * tl];
            split_hl(x, wreg[(kk * 2 + tl) * 2], wreg[(kk * 2 + tl) * 2 + 1]); }
}
template <bool XF32>
__device__ __forceinline__ void router_block(LAS unsigned char* lds, int blk, const float* X32, const bf16_t* XB, bf16_t* XBo, unsigned char* XB8, const bf16_t* H, const float* lnw, const float* lnb,
                                             const u32x4 (&wreg)[16], const float* br, unsigned* cnt, int* tokl, float* gatel, int* tinfo, int tid, int wave, int lane) {
    const int c16 = lane & 15, g = lane >> 4;
    if (tid < 32) *(LAS unsigned*)(lds + RT_HIST + tid * 4) = 0u;
    u32x2 hq[2][4]; f32x4 xq[2][4]; u32x2 xh[2][4];
#pragma unroll
    for (int j = 0; j < 4; ++j) {
#pragma unroll
        for (int k = 0; k < 2; ++k) { hq[k][j] = (u32x2){0u, 0u}; xh[k][j] = (u32x2){0u, 0u}; xq[k][j] = (f32x4){0.f, 0.f, 0.f, 0.f}; } }
    const unsigned lo4 = 4u * (unsigned)lane;
#define RT_LOAD(bt_) do { _Pragma("unroll") for (int k = 0; k < 2; ++k) { const size_t t_ = (size_t)blk * 128 + 16 * (bt_) + 2 * wave + k; \
        const bf16_t* hb_ = H + t_ * 1024 + lo4; const float* xb_ = X32 + t_ * 1024 + lo4; const bf16_t* xh_ = XB + t_ * 1024 + lo4; _Pragma("unroll") for (int j = 0; j < 4; ++j) { \
        LDPIN8(hq[k][j], hb_ + 256 * j); \
        if constexpr (XF32) LDPIN16(xq[k][j], xb_ + 256 * j); else LDPIN8(xh[k][j], xh_ + 256 * j); } } } while (0)
#define RT_PINROWS "+v"(hq[0][0]), "+v"(hq[0][1]), "+v"(hq[0][2]), "+v"(hq[0][3]), "+v"(hq[1][0]), "+v"(hq[1][1]), "+v"(hq[1][2]), "+v"(hq[1][3])
    { const f32x4 w4 = *(const f32x4*)(lnw + 4 * (tid & 255)), b4 = *(const f32x4*)(lnb + 4 * (tid & 255)); if (tid < 256) *(LAS f32x4*)(lds + RT_LNW + 16 * tid) = w4; else *(LAS f32x4*)(lds + RT_LNW + 4096 + 16 * (tid - 256)) = b4; }
    RT_LOAD(0);
    LDS_BARRIER();
#pragma unroll 1
    for (int bt = 0; bt < 8; ++bt) {
        if constexpr (XF32) asm volatile("s_waitcnt vmcnt(0)" : RT_PINROWS, "+v"(xq[0][0]), "+v"(xq[0][1]), "+v"(xq[0][2]), "+v"(xq[0][3]), "+v"(xq[1][0]), "+v"(xq[1][1]), "+v"(xq[1][2]), "+v"(xq[1][3]) :: "memory");
        else asm volatile("s_waitcnt vmcnt(0)" : RT_PINROWS, "+v"(xh[0][0]), "+v"(xh[0][1]), "+v"(xh[0][2]), "+v"(xh[0][3]), "+v"(xh[1][0]), "+v"(xh[1][1]), "+v"(xh[1][2]), "+v"(xh[1][3]) :: "memory");
#define RT_V(k_, j_) ((XF32 ? xq[k_][j_] : (f32x4){bflo(xh[k_][j_].x), bfhi(xh[k_][j_].x), bflo(xh[k_][j_].y), bfhi(xh[k_][j_].y)}) * ALPHA + (f32x4){bflo(hq[k_][j_].x), bfhi(hq[k_][j_].x), bflo(hq[k_][j_].y), bfhi(hq[k_][j_].y)})
        float s1[2], s2[2];
#pragma unroll
        for (int k = 0; k < 2; ++k) { s1[k] = 0.f; s2[k] = 0.f;
#pragma unroll
            for (int j = 0; j < 4; ++j) { const f32x4 t4 = RT_V(k, j); s1[k] += (t4.x + t4.y) + (t4.z + t4.w); s2[k] += (t4.x * t4.x + t4.y * t4.y) + (t4.z * t4.z + t4.w * t4.w); } }
        wave_sum4(s1[0], s2[0], s1[1], s2[1]);
#pragma unroll
        for (int k = 0; k < 2; ++k) {
            const int tl = 2 * wave + k; const size_t t = (size_t)blk * 128 + 16 * bt + tl;
            const float mean = s1[k] * (1.f / D); const float var = fmaxf(s2[k] * (1.f / D) - mean * mean, 0.f); const float rstd = 1.f / sqrtf(var + LN_EPS);
            bf16_t* xo_ = XBo + t * 1024; unsigned char* x8_ = XB8 + t * 1024;
#pragma unroll
            for (int j = 0; j < 4; ++j) { const f32x4 ww = *(const LAS f32x4*)(lds + RT_LNW + (256 * j + lo4) * 4), bb = *(const LAS f32x4*)(lds + RT_LNW + 4096 + (256 * j + lo4) * 4);
                const f32x4 y = (RT_V(k, j) - mean) * rstd * ww + bb;
                u32x2 o; o.x = pk2(y.x, y.y); o.y = pk2(y.z, y.w); *(u32x2*)(xo_ + 256 * j + lo4) = o;
                *(unsigned*)(x8_ + 256 * j + lo4) = pk4_fp8(y.x, y.y, y.z, y.w);
                *(LAS f32x4*)(lds + RT_Y + (tl * RT_YS + 4 * lane + 256 * j) * 4) = y; }
        }
#undef RT_V
        if constexpr (XF32) asm volatile("" : RT_PINROWS, "+v"(xq[0][0]), "+v"(xq[0][1]), "+v"(xq[0][2]), "+v"(xq[0][3]), "+v"(xq[1][0]), "+v"(xq[1][1]), "+v"(xq[1][2]), "+v"(xq[1][3]) :: "memory");
        else asm volatile("" : RT_PINROWS, "+v"(xh[0][0]), "+v"(xh[0][1]), "+v"(xh[0][2]), "+v"(xh[0][3]), "+v"(xh[1][0]), "+v"(xh[1][1]), "+v"(xh[1][2]), "+v"(xh[1][3]) :: "memory");
        if (bt < 7) RT_LOAD(bt + 1);
        LDS_BARRIER();
        {
            f32x4 a0 = (f32x4){0.f, 0.f, 0.f, 0.f}, a1 = a0;
            const LAS float* yp = (const LAS float*)(lds + RT_Y) + c16 * RT_YS + 128 * wave + 8 * g; asm volatile("" : "+v"(yp));
#pragma unroll
            for (int kk = 0; kk < 4; ++kk) {
                const f32x4 ya = *(const LAS f32x4*)(yp + 32 * kk), yb = *(const LAS f32x4*)(yp + 32 * kk + 4);
                const float x[8] = {ya.x, ya.y, ya.z, ya.w, yb.x, yb.y, yb.z, yb.w};
                u32x4 yh, yl; split_hl(x, yh, yl);
                const bf16x8 ah = __builtin_bit_cast(bf16x8, yh), al = __builtin_bit_cast(bf16x8, yl);
#pragma unroll
                for (int tl = 0; tl < 2; ++tl) { const bf16x8 wh = __builtin_bit_cast(bf16x8, wreg[(kk * 2 + tl) * 2]), wl = __builtin_bit_cast(bf16x8, wreg[(kk * 2 + tl) * 2 + 1]);
                    f32x4 acc = tl ? a1 : a0;
                    acc = __builtin_amdgcn_mfma_f32_16x16x32_bf16(al, wh, acc, 0, 0, 0); acc = __builtin_amdgcn_mfma_f32_16x16x32_bf16(ah, wl, acc, 0, 0, 0); acc = __builtin_amdgcn_mfma_f32_16x16x32_bf16(ah, wh, acc, 0, 0, 0);
                    if (tl) a1 = acc; else a0 = acc; }
            }
            LAS float* pp = (LAS float*)(lds + RT_PART) + (wave * 16 + 4 * g) * 32 + c16;
#pragma unroll
            for (int r = 0; r < 4; ++r) { pp[r * 32] = a0[r]; pp[r * 32 + 16] = a1[r]; }
        }
        LDS_BARRIER();
        {
            const int tk = tid >> 5, e = tid & 31;
            float lg = br[e];
            const LAS float* pp = (const LAS float*)(lds + RT_PART) + tk * 32 + e; asm volatile("" : "+v"(pp));
#pragma unroll
            for (int w = 0; w < 8; ++w) lg += pp[w * 512];
            *(LAS float*)(lds + RT_LOG + ((16 * bt + tk) * 33 + e) * 4) = lg;
        }
    }
#undef RT_LOAD
#undef RT_PINROWS
    LDS_BARRIER();
    if (tid < 128) {
        const LAS float* lp = (const LAS float*)(lds + RT_LOG) + tid * 33;
        float v0 = -INFINITY, v1 = -INFINITY, v2 = -INFINITY, v3 = -INFINITY; int i0 = 0, i1 = 0, i2 = 0, i3 = 0;
#pragma unroll
        for (int e = 0; e < 32; ++e) { const float x = lp[e];
            const bool g0 = x > v0, g1 = x > v1, g2 = x > v2, g3 = x > v3;
            v3 = g2 ? v2 : (g3 ? x : v3); i3 = g2 ? i2 : (g3 ? e : i3);
            v2 = g1 ? v1 : (g2 ? x : v2); i2 = g1 ? i1 : (g2 ? e : i2);
            v1 = g0 ? v0 : (g1 ? x : v1); i1 = g0 ? i0 : (g1 ? e : i1);
            v0 = g0 ? x : v0; i0 = g0 ? e : i0; }
        const float e1 = __expf(v1 - v0), e2 = __expf(v2 - v0), e3 = __expf(v3 - v0);
        const float inv = 1.0f / (1.0f + e1 + e2 + e3);
        const int mi[4] = {i0, i1, i2, i3}; const float gt[4] = {inv, e1 * inv, e2 * inv, e3 * inv};
#pragma unroll
        for (int k = 0; k < 4; ++k) {
            const unsigned lr = __hip_atomic_fetch_add((LAS unsigned*)(lds + RT_HIST + mi[k] * 4), 1u, __ATOMIC_RELAXED, __HIP_MEMORY_SCOPE_WORKGROUP);
            const int sidx = tid * 4 + k;
            *(LAS int*)(lds + RT_SELE + sidx * 4) = mi[k]; *(LAS float*)(lds + RT_SELG + sidx * 4) = gt[k]; *(LAS unsigned*)(lds + RT_SELR + sidx * 4) = lr;
        }
    }
    LDS_BARRIER();
    if (tid < 32) { const unsigned hc = *(LAS unsigned*)(lds + RT_HIST + tid * 4);
        *(LAS unsigned*)(lds + RT_BASE + tid * 4) = __hip_atomic_fetch_add(cnt + tid, hc, __ATOMIC_RELAXED, __HIP_MEMORY_SCOPE_AGENT); }
    __syncthreads();
    {
        const int me = *(LAS int*)(lds + RT_SELE + tid * 4); const float gt = *(LAS float*)(lds + RT_SELG + tid * 4);
        const unsigned rank = *(LAS unsigned*)(lds + RT_BASE + me * 4) + *(LAS unsigned*)(lds + RT_SELR + tid * 4);
        const int tok = blk * 128 + (tid >> 2);
        tokl[(size_t)me * T + rank] = tok; gatel[(size_t)me * T + rank] = gt; tinfo[(size_t)tok * 4 + (tid & 3)] = (me << 16) | (int)rank;
    }
    __syncthreads();
}

__device__ __forceinline__ void combine_rows2(size_t t0, size_t t1, const unsigned char* Y, const int* tinfo, const LAS int* tab, const bf16_t* XB, bf16_t* XBo, float* OUT32, const f32x4 (&lw)[4], const f32x4 (&lb)[4], int lane) {
    f32x4 v[2][4]; float s1[2], s2[2];
#pragma unroll
    for (int k2 = 0; k2 < 2; ++k2) {
        const size_t t = k2 ? t1 : t0;
        const u32x4 x0 = *(const u32x4*)(XB + t * 1024 + 16 * lane), x1 = *(const u32x4*)(XB + t * 1024 + 16 * lane + 8);
        const u32x4 inf4 = *(const u32x4*)(tinfo + t * 4);
        v[k2][0] = (f32x4){bflo(x0.x), bfhi(x0.x), bflo(x0.y), bfhi(x0.y)} * ALPHA; v[k2][1] = (f32x4){bflo(x0.z), bfhi(x0.z), bflo(x0.w), bfhi(x0.w)} * ALPHA;
        v[k2][2] = (f32x4){bflo(x1.x), bfhi(x1.x), bflo(x1.y), bfhi(x1.y)} * ALPHA; v[k2][3] = (f32x4){bflo(x1.z), bfhi(x1.z), bflo(x1.w), bfhi(x1.w)} * ALPHA;
        u32x4 yy[4];
#pragma unroll
        for (int k = 0; k < 4; ++k) { const unsigned inf = k == 0 ? inf4.x : k == 1 ? inf4.y : k == 2 ? inf4.z : inf4.w; const int ee = (int)(inf >> 16), rk = (int)(inf & 0xffffu);
            const size_t slot = (size_t)tab[ee] * 256 + rk; yy[k] = *(const u32x4*)(Y + slot * 1024 + 16 * lane); }
#pragma unroll
        for (int k = 0; k < 4; ++k) {
#pragma unroll
            for (int j = 0; j < 4; ++j) { const int w = (int)(j == 0 ? yy[k].x : j == 1 ? yy[k].y : j == 2 ? yy[k].z : yy[k].w);
                const f32x2 lo2 = __builtin_amdgcn_cvt_pk_f32_fp8(w, false), hi2 = __builtin_amdgcn_cvt_pk_f32_fp8(w, true);
                v[k2][j] = v[k2][j] + (f32x4){lo2.x, lo2.y, hi2.x, hi2.y} * 0.0625f; } }
        float a = 0.f, q = 0.f;
#pragma unroll
        for (int j = 0; j < 4; ++j) { const f32x4 u = v[k2][j]; a += (u.x + u.y) + (u.z + u.w); q += (u.x * u.x + u.y * u.y) + (u.z * u.z + u.w * u.w); }
        s1[k2] = a; s2[k2] = q;
    }
    wave_sum4(s1[0], s2[0], s1[1], s2[1]);
#pragma unroll
    for (int k2 = 0; k2 < 2; ++k2) {
        const size_t t = k2 ? t1 : t0;
        const float mean = s1[k2] * (1.f / D); const float var = fmaxf(s2[k2] * (1.f / D) - mean * mean, 0.f); const float rstd = 1.f / sqrtf(var + LN_EPS);
        f32x4 y[4];
#pragma unroll
        for (int j = 0; j < 4; ++j) y[j] = (v[k2][j] - mean) * rstd * lw[j] + lb[j];
        if (OUT32) {
#pragma unroll
            for (int j = 0; j < 4; ++j) *(f32x4*)(OUT32 + t * 1024 + 16 * lane + 4 * j) = y[j];
        } else {
            u32x4 o0, o1; o0.x = pk2(y[0].x, y[0].y); o0.y = pk2(y[0].z, y[0].w); o0.z = pk2(y[1].x, y[1].y); o0.w = pk2(y[1].z, y[1].w);
            o1.x = pk2(y[2].x, y[2].y); o1.y = pk2(y[2].z, y[2].w); o1.z = pk2(y[3].x, y[3].y); o1.w = pk2(y[3].z, y[3].w);
            *(u32x4*)(XBo + t * 1024 + 16 * lane) = o0; *(u32x4*)(XBo + t * 1024 + 16 * lane + 8) = o1;
        }
    }
}

__device__ __forceinline__ int crow(int r, int hi) { return (r & 3) + 8 * (r >> 2) + 4 * hi; }
__device__ __forceinline__ void attn_phase(const bf16_t* QB, const bf16_t* KB, const bf16_t* VT, bf16_t* AO, int gw, int ngw, int lane) {
    const int r32 = lane & 31, hi = lane >> 5;
    for (int task = gw; task < BATCH * 16 * (SEQ / 32); task += ngw) {
        const int qt = task & 255, bh = task >> 8, b = bh >> 4, h = bh & 15;
        const size_t rowb = (size_t)b * SEQ; const int q0 = qt * 32;
        bf16x8 qf[4];
        { const bf16_t* qp = QB + (rowb + q0 + r32) * 1024 + h * 64 + hi * 8;
#pragma unroll
          for (int s = 0; s < 4; ++s) qf[s] = *(const bf16x8*)(qp + 16 * s); }
        f32x16 o0, o1;
#pragma unroll
        for (int r = 0; r < 16; ++r) { o0[r] = 0.f; o1[r] = 0.f; }
        float carry = 1.f;
        const bf16_t* kbase = KB + (size_t)bh * 256 * 4 * 64 * 8 + lane * 8;
        const bf16_t* vbase = VT + (size_t)bh * 256 * 4 * 64 * 8 + lane * 8;
        bf16x8 kn[4];
#pragma unroll
        for (int s = 0; s < 4; ++s) kn[s] = *(const bf16x8*)(kbase + (size_t)qt * 2048 + s * 512);
        for (int kt = qt; kt >= 0; --kt) {
            bf16x8 kf[4];
#pragma unroll
            for (int s = 0; s < 4; ++s) kf[s] = kn[s];
            bf16x8 va[2][2];
#pragma unroll
            for (int dt = 0; dt < 2; ++dt)
#pragma unroll
                for (int sp = 0; sp < 2; ++sp) va[dt][sp] = *(const bf16x8*)(vbase + (size_t)kt * 2048 + (dt * 2 + sp) * 512);
            { const int kp = kt > 0 ? kt - 1 : 0;
#pragma unroll
              for (int s = 0; s < 4; ++s) kn[s] = *(const bf16x8*)(kbase + (size_t)kp * 2048 + s * 512); }
            f32x16 st;
#pragma unroll
            for (int r = 0; r < 16; ++r) st[r] = 0.f;
#pragma unroll
            for (int s = 0; s < 4; ++s) st = __builtin_amdgcn_mfma_f32_32x32x16_bf16(kf[s], qf[s], st, 0, 0, 0);
            const bool diag = (kt == qt);
            float R[16], Bt[16];
#pragma unroll
            for (int r = 0; r < 16; r += 2) {
                const f32x2 e = (f32x2){fexp2(st[r]), fexp2(st[r + 1])};
                const f32x2 d = e + 1.0f;
                f32x2 rr = (f32x2){frcp(d.x), frcp(d.y)};
                if (diag) { rr.x = (crow(r, hi) < r32) ? rr.x : 1.0f; rr.y = (crow(r + 1, hi) < r32) ? rr.y : 1.0f; }
                const f32x2 bt = 1.0f - rr;
                R[r] = rr.x; R[r + 1] = rr.y; Bt[r] = bt.x; Bt[r + 1] = bt.y;
            }
            float own[4], pg[4];
#pragma unroll
            for (int rg = 0; rg < 4; ++rg) { own[rg] = (R[4 * rg] * R[4 * rg + 1]) * (R[4 * rg + 2] * R[4 * rg + 3]); pg[rg] = __shfl_xor(own[rg], 32); }
            float aft[4];
            { float run = 1.f;
#pragma unroll
              for (int rg = 3; rg >= 0; --rg) { aft[rg] = (hi == 0) ? run * pg[rg] : run; run *= own[rg] * pg[rg]; }
              float w[16];
#pragma unroll
              for (int rg = 0; rg < 4; ++rg) { float lat = carry * aft[rg];
#pragma unroll
                  for (int p = 3; p >= 0; --p) { w[4 * rg + p] = Bt[4 * rg + p] * lat; lat *= R[4 * rg + p]; } }
              carry *= run;
              u32x4 p0, p1;
              p0.x = pk2(w[0], w[1]); p0.y = pk2(w[2], w[3]); p0.z = pk2(w[4], w[5]); p0.w = pk2(w[6], w[7]);
              p1.x = pk2(w[8], w[9]); p1.y = pk2(w[10], w[11]); p1.z = pk2(w[12], w[13]); p1.w = pk2(w[14], w[15]);
              const bf16x8 pf0 = __builtin_bit_cast(bf16x8, p0), pf1 = __builtin_bit_cast(bf16x8, p1);
              o0 = __builtin_amdgcn_mfma_f32_32x32x16_bf16(va[0][0], pf0, o0, 0, 0, 0); o0 = __builtin_amdgcn_mfma_f32_32x32x16_bf16(va[0][1], pf1, o0, 0, 0, 0);
              o1 = __builtin_amdgcn_mfma_f32_32x32x16_bf16(va[1][0], pf0, o1, 0, 0, 0); o1 = __builtin_amdgcn_mfma_f32_32x32x16_bf16(va[1][1], pf1, o1, 0, 0, 0);
            }
            if (__all(carry < ATT_THR)) break;
        }
        bf16_t* op = AO + (rowb + q0 + r32) * 1024 + h * 64 + 4 * hi;
#pragma unroll
        for (int rg = 0; rg < 4; ++rg) {
            u32x2 w; w.x = pk2(o0[4 * rg], o0[4 * rg + 1]); w.y = pk2(o0[4 * rg + 2], o0[4 * rg + 3]); *(u32x2*)(op + 8 * rg) = w;
            w.x = pk2(o1[4 * rg], o1[4 * rg + 1]); w.y = pk2(o1[4 * rg + 2], o1[4 * rg + 3]); *(u32x2*)(op + 32 + 8 * rg) = w;
        }
    }
}

constexpr int NWAVES = 8;
constexpr int NPHASE = 17;
struct Args { const float* in[29]; float* out; unsigned char* ws; int ph_lo, ph_hi; };

#ifndef PH_MASK
#define PH_MASK 0xfff
#endif
#define EN(b) ((PH_MASK >> (b)) & 1)
#ifndef REP_MASK
#define REP_MASK 0
#endif
#define RP(b) ((REP_MASK >> (b)) & 1)
#define PHASE(b, k, ...) if (EN(b) && IN(k)) { PH_IDS; { __VA_ARGS__ } if (RP(b)) { __VA_ARGS__ } }
#define IN(k) (lo <= (k) && (k) < hi)
#if MK_PER_PHASE
#define SEAM(k) do { } while (0)
#else
#define SEAM(k) do { if (IN(k) && IN((k) + 1)) xcd_barrier(bar); } while (0)
#endif
#define PH_IDS const int lane = lane_id_asm(); const int wave = wave0; const int tid = wave * 64 + lane; const int G = gridDim.x, bx = blockIdx.x; const int gw = bx * NWAVES + wave, NGW = G * NWAVES; (void)tid; (void)lane; (void)gw; (void)NGW; (void)G; (void)bx
#define WSP(T_, off) ((T_*)(args.ws + (off)))

template <int LAYER>
__device__ __forceinline__ void layer_tail(const Args& args, LAS unsigned char* lds, const XcdBarrier& bar, int lo, int hi, const int wave0) {
    constexpr int PB = LAYER == 0 ? 5 : 12;
    LAS int* moetab = (LAS int*)(lds + MOETAB_OFF);
    LAS unsigned* rowtab = (LAS unsigned*)(lds + ROWTAB_OFF);
    PHASE(5, PB,
        pg8::Gemm g{WSP(bf16_t, WS_SB), WSP(bf16_t, LAYER ? WS_WO1T : WS_WO0T), 1024, 0}; pg8::StaticOrder S; S.init(T, 1024, G, bx); pg8::EpiPlain E{WSP(bf16_t, WS_SB + 64 * MiB), 1024, 0, 0, 1.f};
        pg8::gemm_phase<pg8::EpiPlain, pg8::StaticOrder, 0>(lds, g, S, E, nullptr, rowtab, tid);)
    SEAM(PB);
    if (RP(6) && EN(6) && IN(PB + 1)) { PH_IDS;
        unsigned* cnt = WSP(unsigned, WS_CTL) + CW_CNT + 128 + LAYER * 64;
        u32x4 wreg[16]; router_load_w(args.in[LAYER ? 21 : 9], wreg, wave, lane);
        for (int blk = bx; blk < T / 128; blk += G)
            router_block<LAYER == 0>(lds, blk, LAYER ? nullptr : args.in[0], WSP(bf16_t, WS_XB), WSP(bf16_t, WS_END), WSP(unsigned char, WS_END + 64 * MiB), WSP(bf16_t, WS_SB + 64 * MiB), args.in[LAYER ? 19 : 7], args.in[LAYER ? 20 : 8], wreg, args.in[LAYER ? 22 : 10],
                         cnt, WSP(int, WS_END + 96 * MiB), WSP(float, WS_END + 100 * MiB), WSP(int, WS_END + 104 * MiB), tid, wave, lane); }
    if (EN(6) && IN(PB + 1)) { PH_IDS;
        unsigned* cnt = WSP(unsigned, WS_CTL) + CW_CNT + LAYER * 64;
        u32x4 wreg[16]; router_load_w(args.in[LAYER ? 21 : 9], wreg, wave, lane);
        for (int blk = bx; blk < T / 128; blk += G)
            router_block<LAYER == 0>(lds, blk, LAYER ? nullptr : args.in[0], WSP(bf16_t, WS_XB), WSP(bf16_t, WS_XB), WSP(unsigned char, WS_XB8), WSP(bf16_t, WS_SB + 64 * MiB), args.in[LAYER ? 19 : 7], args.in[LAYER ? 20 : 8], wreg, args.in[LAYER ? 22 : 10],
                         cnt, WSP(int, WS_TOKL), WSP(float, WS_GATEL), WSP(int, WS_TINFO), tid, wave, lane); }
    SEAM(PB + 1);
    PHASE(7, PB + 2,
        moe_table(WSP(unsigned, WS_CTL) + CW_CNT + LAYER * 64, moetab, tid);
        pg8::Gemm g{WSP(bf16_t, WS_XB8), WSP(bf16_t, WS_W1T), 512, 2048}; pg8::MoeOrder S; S.init(moetab, 8, G, bx); pg8::EpiSwiglu8 E{WSP(unsigned char, WS_SA), args.in[LAYER ? 24 : 12]};
        pg8::gemm_phase<pg8::EpiSwiglu8, pg8::MoeOrder, 1, 127 - W1_SH>(lds, g, S, E, WSP(int, WS_TOKL), rowtab, tid);)
    SEAM(PB + 2);
    PHASE(8, PB + 3,
        moe_table(WSP(unsigned, WS_CTL) + CW_CNT + LAYER * 64, moetab, tid);
        pg8::Gemm g{WSP(bf16_t, WS_SA), WSP(bf16_t, WS_W2T), 512, 1024}; pg8::MoeOrder S; S.init(moetab, 4, G, bx); pg8::EpiDown8 E{WSP(unsigned char, WS_SB), args.in[LAYER ? 26 : 14], WSP(float, WS_GATEL)};
        pg8::gemm_phase<pg8::EpiDown8, pg8::MoeOrder, 2, 127 - W2_SH>(lds, g, S, E, nullptr, rowtab, tid);)
    SEAM(PB + 3);
    if (EN(9) && IN(PB + 4)) { PH_IDS;
        moe_table(WSP(unsigned, WS_CTL) + CW_CNT + LAYER * 64, moetab, tid);
        f32x4 lw[4], lb[4];
#pragma unroll
        for (int j = 0; j < 4; ++j) { lw[j] = *(const f32x4*)(args.in[LAYER ? 27 : 15] + 16 * lane + 4 * j); lb[j] = *(const f32x4*)(args.in[LAYER ? 28 : 16] + 16 * lane + 4 * j); }
        if (RP(9)) { for (int t = gw; t < T; t += 2 * NGW) combine_rows2((size_t)t, (size_t)(t + NGW), WSP(unsigned char, WS_SB), WSP(int, WS_TINFO), moetab, WSP(bf16_t, WS_XB), WSP(bf16_t, WS_END), LAYER ? (float*)WSP(float, WS_END) : nullptr, lw, lb, lane); }
        for (int t = gw; t < T; t += 2 * NGW) combine_rows2((size_t)t, (size_t)(t + NGW), WSP(unsigned char, WS_SB), WSP(int, WS_TINFO), moetab, WSP(bf16_t, WS_XB), WSP(bf16_t, WS_XB), LAYER ? args.out : nullptr, lw, lb, lane);
    }
    if (LAYER == 0) SEAM(PB + 4);
}

__global__ void __launch_bounds__(NWAVES * 64, 2) mk_fwd(Args args) {
    extern __shared__ __attribute__((aligned(16))) unsigned char lds_raw[];
    LAS unsigned char* lds = (LAS unsigned char*)lds_raw;
    volatile LAS unsigned* MISC = (volatile LAS unsigned*)(lds + MISC_OFF);
    LAS unsigned* rowtab = (LAS unsigned*)(lds + ROWTAB_OFF);
    if (threadIdx.x < 32) MISC[threadIdx.x] = 0u;
    __syncthreads();
    const int wave0 = __builtin_amdgcn_readfirstlane(threadIdx.x >> 6);
    XcdBarrier bar; bar.bar = WSP(unsigned, WS_CTL) + CW_BAR; bar.x = 0; bar.st = nullptr; bar.wave = wave0;
#if !MK_PER_PHASE
    bar = xcd_barrier_post(WSP(unsigned, WS_CTL) + CW_BAR, MISC + 8);
#endif
    const int lo = args.ph_lo, hi = args.ph_hi;

    PHASE(0, 0,
        const float* x_in = args.in[0]; const float* w_in0 = args.in[2]; const float* wpool = args.in[4]; const float* pscale = args.in[5]; const float* w_o0 = args.in[6];
        const float* w_in1 = args.in[17]; const float* w_o1 = args.in[18];
        bf16_t* WIN0T = WSP(bf16_t, WS_WIN0T); bf16_t* WO0T = WSP(bf16_t, WS_WO0T); bf16_t* WIN1T = WSP(bf16_t, WS_WIN1T); bf16_t* WO1T = WSP(bf16_t, WS_WO1T); bf16_t* XB = WSP(bf16_t, WS_XB);
        LAS float* scr = (LAS float*)(lds + wave * 16384);
        constexpr int I_IN0 = 16 * 80, I_O0 = 8 * 32, I_IN1 = 16 * 96, I_O1 = 16 * 32, NIT = I_IN0 + I_O0 + I_IN1 + I_O1;
        for (int it = gw; it < NIT; it += NGW) {
            int r = it;
            if (r < I_IN0) { const int kb = r / 80, nb = r % 80, n0 = 32 * nb;
                const int dr = n0 < 512 ? 2 * n0 : (n0 < 1024 ? 2 * (n0 - 512) + 1 : (n0 < 1536 ? n0 + 1024 : n0 - 512));
                transpose_item(w_in0, 2560, WIN0T, 1024, 64 * kb, n0, dr, scr, lane, n0 < 1024 ? 2 : 1); continue; } r -= I_IN0;
            if (r < I_O0) { const int kb = r / 32, nb = r % 32; transpose_item(w_o0, 1024, WO0T, 1024, 64 * kb, 32 * nb, 32 * nb, scr, lane); continue; } r -= I_O0;
            if (r < I_IN1) { const int kb = r / 96, nb = r % 96; transpose_item(w_in1, 3072, WIN1T, 1024, 64 * kb, 32 * nb, 32 * nb, scr, lane); continue; } r -= I_IN1;
            { const int kb = r / 32, nb = r % 32; transpose_item(w_o1, 1024, WO1T, 1024, 64 * kb, 32 * nb, 32 * nb, scr, lane); }
        }
        for (int idx = bx * 512 + tid; idx < 512 * 1024; idx += G * 512) {
            const int n = idx & 1023, gc = idx >> 10, gg = gc >> 7;
            const float* wp = wpool + (size_t)gc * 128; const float* ps = pscale + 128 * gg; const float* wo = w_o0 + (size_t)(512 + 128 * gg) * 1024 + n;
            float a = 0.f;
_Pragma("unroll 8")
            for (int d = 0; d < 128; ++d) a += wp[d] * ps[d] * wo[(size_t)d * 1024];
            WO0T[(size_t)n * 1024 + 512 + gc] = (bf16_t)(pk2(a, 0.f) & 0xffffu);
        }
        { const size_t nv = (size_t)T * D / 8, st = (size_t)G * 512;
          size_t i = (size_t)bx * 512 + tid;
          for (; i + 3 * st < nv; i += 4 * st) {
              f32x4 a[4], c[4];
_Pragma("unroll")
              for (int q = 0; q < 4; ++q) { a[q] = __builtin_nontemporal_load((const f32x4*)(x_in + (i + q * st) * 8)); c[q] = __builtin_nontemporal_load((const f32x4*)(x_in + (i + q * st) * 8 + 4)); }
_Pragma("unroll")
              for (int q = 0; q < 4; ++q) { u32x4 o; o.x = pk2(a[q].x, a[q].y); o.y = pk2(a[q].z, a[q].w); o.z = pk2(c[q].x, c[q].y); o.w = pk2(c[q].z, c[q].w); *(u32x4*)(XB + (i + q * st) * 8) = o; }
          }
          for (; i < nv; i += st) { const f32x4 a = *(const f32x4*)(x_in + i * 8), c = *(const f32x4*)(x_in + i * 8 + 4);
              u32x4 o; o.x = pk2(a.x, a.y); o.y = pk2(a.z, a.w); o.z = pk2(c.x, c.y); o.w = pk2(c.z, c.w); *(u32x4*)(XB + i * 8) = o; }
        })
    SEAM(0);
    PHASE(1, 1,
        { pg8::Gemm g{WSP(bf16_t, WS_XB), WSP(bf16_t, WS_WIN0T), 1024, 0}; pg8::StaticOrder S; S.init(T, 2048, G, bx); pg8::EpiPlain E{WSP(bf16_t, WS_SA), 2048, 0, 0, 1.f};
          pg8::gemm_phase<pg8::EpiPlain, pg8::StaticOrder, 0>(lds, g, S, E, nullptr, rowtab, tid); }
        { pg8::Gemm g{WSP(bf16_t, WS_WIN0T) + (size_t)2048 * 1024, WSP(bf16_t, WS_XB), 1024, 0}; pg8::StaticOrder S; S.init(512, T, G, bx); pg8::EpiPlain E{WSP(bf16_t, WS_SA + 128 * MiB), T, 0, 0, 1.f};
          pg8::gemm_phase<pg8::EpiPlain, pg8::StaticOrder, 0>(lds, g, S, E, nullptr, rowtab, tid); })
    SEAM(1);
#define HG_UNIT0(u_) hgrn_unit<0>(lds, u_, WSP(bf16_t, WS_SA), WSP(bf16_t, WS_SA + 128 * MiB), WSP(float, WS_SB + 128 * MiB), WSP(float, WS_SB + 160 * MiB), args.in[1], args.in[3], WSP(bf16_t, WS_SB), tid, wave, lane)
#define HG_UNIT1(u_) hgrn_unit<1>(lds, u_, WSP(bf16_t, WS_SA), WSP(bf16_t, WS_SA + 128 * MiB), WSP(float, WS_SB + 128 * MiB), WSP(float, WS_SB + 160 * MiB), args.in[1], args.in[3], WSP(bf16_t, WS_SB), tid, wave, lane)
#define CONV0(q0_, q1_) conv_moe_wg(args.in[11], args.in[13], WSP(unsigned char, WS_W1T), WSP(unsigned char, WS_W2T), (LAS float*)lds, bx, G, tid, (q0_) * cq, (q1_) * cq)
    PHASE(2, 2,
        const bool cfirst = (bx & 1) != 0; const int cq = ((NE * 192 + G - 1) / G + 3) / 4;
        if (cfirst) CONV0(0, 1);
        if (bx < 512) HG_UNIT0(bx);
        if (cfirst) CONV0(1, 2); else CONV0(0, 1);
        for (int u = bx + G; u < 512; u += G) HG_UNIT0(u);
        if (!cfirst) CONV0(1, 2);
        for (int task = bx; task < 256; task += G) pool_task(task, WSP(bf16_t, WS_SA), WSP(bf16_t, WS_SB), wave, lane);)
    SEAM(2);
    PHASE(3, 3,
        float* SLOC = WSP(float, WS_SB + 128 * MiB); const float* DTOT = WSP(float, WS_SB + 160 * MiB);
        for (int ch = bx * 512 + tid; ch < 16 * 16384; ch += G * 512) {
            const int bh = ch >> 14, el = ch & 16383, dk = el >> 7;
            float* sp = SLOC + (size_t)bh * 32 * 16384 + el; const float* dp = DTOT + (size_t)bh * 32 * 128 + dk;
            float loc[32], dd[32];
_Pragma("unroll")
            for (int sc = 0; sc < 32; ++sc) { loc[sc] = sp[(size_t)sc * 16384]; dd[sc] = dp[sc * 128]; }
            float S = 0.f;
_Pragma("unroll")
            for (int sc = 0; sc < 32; ++sc) { sp[(size_t)sc * 16384] = S; S = dd[sc] * S + loc[sc]; }
        })
    SEAM(3);
    PHASE(4, 4,
        const bool cfirst = (bx & 1) != 0; const int cq = ((NE * 192 + G - 1) / G + 3) / 4;
        if (cfirst) CONV0(2, 3);
        if (bx < 512) HG_UNIT1(bx);
        if (cfirst) CONV0(3, 4); else CONV0(2, 3);
        for (int u = bx + G; u < 512; u += G) HG_UNIT1(u);
        if (!cfirst) CONV0(3, 4);
        )
#undef CONV0
#undef HG_UNIT0
#undef HG_UNIT1
    SEAM(4);
    layer_tail<0>(args, lds, bar, lo, hi, wave0);
    PHASE(10, 10,
        { pg8::Gemm g{WSP(bf16_t, WS_XB), WSP(bf16_t, WS_WIN1T), 1024, 0}; pg8::StaticOrder S; S.init(T, 2048, G, bx); pg8::EpiQK E{WSP(bf16_t, WS_SA), WSP(bf16_t, WS_SA + 64 * MiB), QSCALE};
          pg8::gemm_phase<pg8::EpiQK, pg8::StaticOrder, 0>(lds, g, S, E, nullptr, rowtab, tid); }
        { pg8::Gemm g{WSP(bf16_t, WS_WIN1T) + (size_t)2048 * 1024, WSP(bf16_t, WS_XB), 1024, 0}; pg8::StaticOrder S; S.init(1024, T, G, bx); pg8::EpiVF E{WSP(bf16_t, WS_SA + 128 * MiB)};
          pg8::gemm_phase<pg8::EpiVF, pg8::StaticOrder, 0>(lds, g, S, E, nullptr, rowtab, tid); })
    SEAM(10);
    PHASE(11, 11,
        const bool cfirst = (bx & 1) != 0;
        if (cfirst) conv_moe_wg(args.in[23], args.in[25], WSP(unsigned char, WS_W1T), WSP(unsigned char, WS_W2T), (LAS float*)lds, bx, G, tid, 0, (NE * 192 + G - 1) / G);
        attn_phase(WSP(bf16_t, WS_SA), WSP(bf16_t, WS_SA + 64 * MiB), WSP(bf16_t, WS_SA + 128 * MiB), WSP(bf16_t, WS_SB), gw, NGW, lane);
        if (!cfirst) conv_moe_wg(args.in[23], args.in[25], WSP(unsigned char, WS_W1T), WSP(unsigned char, WS_W2T), (LAS float*)lds, bx, G, tid, 0, (NE * 192 + G - 1) / G);)
    SEAM(11);
    layer_tail<1>(args, lds, bar, lo, hi, wave0);
}
#undef IN
#undef SEAM

extern "C" void kernel_launch(void* const* d_in, const int* in_sizes, int n_in, void* d_out, int out_size, void* d_ws, size_t ws_size, hipStream_t stream) {
    static int grid = 0;
    if (grid == 0) {
        if (n_in != 29 || in_sizes[0] != T * D || out_size != T * D || ws_size < WS_END) { fprintf(stderr, "kernel_launch: unexpected shapes (n_in %d, in0 %d, out %d, ws %zu)\n", n_in, n_in > 0 ? in_sizes[0] : -1, out_size, ws_size); grid = -1; return; }
        int dev = 0, cus = 0, per_cu = 0;
        if (hipGetDevice(&dev) != hipSuccess || hipDeviceGetAttribute(&cus, hipDeviceAttributeMultiprocessorCount, dev) != hipSuccess) { grid = -1; return; }
        if (hipFuncSetAttribute((const void*)mk_fwd, hipFuncAttributeMaxDynamicSharedMemorySize, LDS_BYTES) != hipSuccess) { fprintf(stderr, "kernel_launch: hipFuncSetAttribute failed\n"); grid = -1; return; }
        if (hipOccupancyMaxActiveBlocksPerMultiprocessor(&per_cu, (const void*)mk_fwd, NWAVES * 64, LDS_BYTES) != hipSuccess || per_cu < 1) { fprintf(stderr, "kernel_launch: occupancy query says %d\n", per_cu); }
        (void)hipGetLastError();
        grid = cus;
    }
    if (grid < 0) return;
    if (hipMemsetAsync((char*)d_ws + WS_CTL, 0, CTL_ZERO_BYTES, stream) != hipSuccess) return;
    Args a{};
    for (int i = 0; i < 29; ++i) a.in[i] = (const float*)d_in[i];
    a.out = (float*)d_out; a.ws = (unsigned char*)d_ws;
#if MK_PER_PHASE
    for (int p = 0; p < NPHASE; ++p) { a.ph_lo = p; a.ph_hi = p + 1; hipLaunchKernelGGL(mk_fwd, dim3(grid), dim3(NWAVES * 64), LDS_BYTES, stream, a); }
#else
    a.ph_lo = 0; a.ph_hi = NPHASE;
    hipLaunchKernelGGL(mk_fwd, dim3(grid), dim3(NWAVES * 64), LDS_BYTES, stream, a);
#endif
}
```

```cpp
#include <hip/hip_runtime.h>
#include <cstdio>
#include <cstdint>

#ifndef MK_PER_PHASE
#define MK_PER_PHASE 0
#endif

#define LAS __attribute__((address_space(3)))
#define GAS __attribute__((address_space(1)))
typedef unsigned short bf16_t;
typedef short bf16x8 __attribute__((ext_vector_type(8)));
typedef short s16x4 __attribute__((ext_vector_type(4)));
typedef float f32x2 __attribute__((ext_vector_type(2)));
typedef float f32x4 __attribute__((ext_vector_type(4)));
typedef float f32x16 __attribute__((ext_vector_type(16)));
typedef unsigned u32x2 __attribute__((ext_vector_type(2)));
typedef unsigned u32x4 __attribute__((ext_vector_type(4)));
typedef __bf16 bf16x2_t __attribute__((ext_vector_type(2)));
typedef int i32x4 __attribute__((ext_vector_type(4)));
typedef int i32x8 __attribute__((ext_vector_type(8)));

constexpr int BATCH = 4, SEQ = 8192, T = BATCH * SEQ, D = 1024;
constexpr int NE = 32;
constexpr float ALPHA = 1.41421356237309515f;
constexpr float LN_EPS = 1e-5f, RMS_EPS = 1e-6f;
constexpr float LOG2E = 1.4426950408889634f;
constexpr float QSCALE = 0.125f * LOG2E;
constexpr float ATT_THR = 7.5231638e-37f;

__device__ __forceinline__ unsigned pk2(float lo, float hi) { f32x2 v = {lo, hi}; bf16x2_t b = __builtin_convertvector(v, bf16x2_t); return __builtin_bit_cast(unsigned, b); }
__device__ __forceinline__ float bflo(unsigned u) { return __uint_as_float(u << 16); }
__device__ __forceinline__ float bfhi(unsigned u) { return __uint_as_float(u & 0xffff0000u); }
__device__ __forceinline__ float bf2f(bf16_t h) { return __uint_as_float(((unsigned)h) << 16); }
__device__ __forceinline__ float clamp448(float x) { return __builtin_amdgcn_fmed3f(x, -448.0f, 448.0f); }
__device__ __forceinline__ unsigned pk4_fp8_nc(float a, float b, float c, float d) { int p = 0; p = __builtin_amdgcn_cvt_pk_fp8_f32(a, b, p, false); p = __builtin_amdgcn_cvt_pk_fp8_f32(c, d, p, true); return (unsigned)p; }
__device__ __forceinline__ unsigned pk4_fp8(float a, float b, float c, float d) { int p = 0; p = __builtin_amdgcn_cvt_pk_fp8_f32(clamp448(a), clamp448(b), p, false); p = __builtin_amdgcn_cvt_pk_fp8_f32(clamp448(c), clamp448(d), p, true); return (unsigned)p; }
__device__ __forceinline__ float fexp2(float x) { return __builtin_amdgcn_exp2f(x); }
__device__ __forceinline__ float flog2(float x) { return __builtin_amdgcn_logf(x); }
__device__ __forceinline__ float frcp(float x) { return __builtin_amdgcn_rcpf(x); }

__device__ __forceinline__ int lane_id_asm() { int l; asm volatile("v_mbcnt_lo_u32_b32 %0, -1, 0\n\tv_mbcnt_hi_u32_b32 %0, -1, %0" : "=v"(l)); return l; }

#define LDPIN16(dst_, p_) asm volatile("global_load_dwordx4 %0, %1, off" : "+v"(dst_) : "v"(p_) : "memory")
#define LDPIN8(dst_, p_)  asm volatile("global_load_dwordx2 %0, %1, off" : "+v"(dst_) : "v"(p_) : "memory")

namespace pg8 {
constexpr int BM = 256, BK = 64, HALF = 128, HTB = HALF * BK * 2, STAGE_BYTES = 8 * HTB, NXCD = 8, WGM = 4;
constexpr int AUX_OFF = STAGE_BYTES + 2048 + 512 + 256;
__host__ __device__ __forceinline__ int lds_byte(int r, int c) { const int st = (r >> 4) * 2 + (c >> 5), rr = r & 15, cc = c & 31, ob = rr * 64 + cc * 2; return st * 1024 + (ob ^ (((ob >> 9) & 1) << 5)); }
__host__ __device__ __forceinline__ void stage_rc(int b, int& R, int& C) { const int st = b / 1024, sb = b % 1024, swz = sb ^ (((sb >> 9) & 1) << 5); R = (st >> 1) * 16 + swz / 64; C = (st & 1) * 32 + (swz % 64) / 2; }
__host__ __device__ __forceinline__ int perm32(int rho) { const int n = rho >> 4, i = rho & 15; return 8 * (i >> 2) + 4 * n + (i & 3); }

struct Unit { int pm, pn, e, mt, valid; };
struct Gemm { const bf16_t* A; const bf16_t* Bt; int K; int brows; };

__device__ __forceinline__ void tile_of(int L, int nM, int nN, int& pm, int& pn) {
    const int nwg = nM * nN;
    int wgid = L; { const int q = nwg / NXCD, r = nwg % NXCD, xcd = wgid % NXCD, off = wgid / NXCD; wgid = (xcd < r ? xcd * (q + 1) : r * (q + 1) + (xcd - r) * q) + off; }
    const int nig = WGM * nN, gid = wgid / nig, fm = gid * WGM, gsz = (nM - fm) < WGM ? (nM - fm) : WGM;
    pm = fm + ((wgid % nig) % gsz); pn = (wgid % nig) / gsz;
}
struct StaticOrder {
    int nM, nN, nwg, G, c;
    __device__ __forceinline__ void init(int M, int N, int G_, int c_) { nM = M / BM; nN = N / BM; nwg = nM * nN; G = G_; c = c_; }
    __device__ __forceinline__ bool next(int i, Unit& u) const {
        const long L = (long)i * G + c; if (L >= nwg) return false;
        tile_of((int)L, nM, nN, u.pm, u.pn); u.e = 0; u.mt = u.pm; u.valid = 256; return true;
    }
};
struct MoeOrder {
    const LAS int* tab; int nM, nN, nwg, G, c;
    __device__ __forceinline__ void init(const LAS int* tab_, int nN_, int G_, int c_) { tab = tab_; nM = tab_[32]; nN = nN_; nwg = nM * nN; G = G_; c = c_; }
    __device__ __forceinline__ bool next(int i, Unit& u) const {
        const long L = (long)i * G + c; if (L >= nwg) return false;
        tile_of((int)L, nM, nN, u.pm, u.pn);
        int e = 0;
#pragma unroll
        for (int j = 1; j < 32; ++j) e += (u.pm >= tab[j]) ? 1 : 0;
        u.e = e; u.mt = u.pm - tab[e]; const int rem = tab[33 + e] - u.mt * 256; u.valid = rem < 256 ? rem : 256; return true;
    }
};

__device__ __forceinline__ unsigned cvt_pk_bf16(float lo, float hi) { return pk2(lo, hi); }

struct EpiPlain {
    static constexpr bool PERM = true; static constexpr int NAUX = 0;
    bf16_t* O; int ldc; int split_cols; size_t split_stride; float scale0;
    __device__ __forceinline__ void operator()(const f32x4 (&acc)[2][2][4][2], const Unit& u, int wr, int wc, int fr, int fq, const LAS float* aux) const {
        asm volatile("" : "+v"(fr), "+v"(fq));
        const int row0 = u.pm * BM + wr * 64 + fr; int colt = u.pn * BM; bf16_t* base = O;
        float sc = 1.f; if (split_cols) { const int t = colt / split_cols; base += (size_t)t * split_stride; colt -= t * split_cols; if (t == 0) sc = scale0; }
        const int col0 = colt + wc * 32 + 8 * fq;
#pragma unroll
        for (int ai = 0; ai < 2; ++ai)
#pragma unroll
            for (int m = 0; m < 4; ++m) { bf16_t* rowp = base + (size_t)(row0 + ai * HALF + m * 16) * ldc + col0;
#pragma unroll
                for (int bj = 0; bj < 2; ++bj) { f32x4 v0 = acc[ai][bj][m][0] * sc, v1 = acc[ai][bj][m][1] * sc;
                    u32x4 w; w.x = cvt_pk_bf16(v0[0], v0[1]); w.y = cvt_pk_bf16(v0[2], v0[3]); w.z = cvt_pk_bf16(v1[0], v1[1]); w.w = cvt_pk_bf16(v1[2], v1[3]);
                    *(u32x4*)(rowp + bj * HALF) = w; } }
    }
};
struct EpiQK {
    static constexpr bool PERM = true; static constexpr int NAUX = 0;
    bf16_t* Q; bf16_t* KF; float scale;
    __device__ __forceinline__ void operator()(const f32x4 (&acc)[2][2][4][2], const Unit& u, int wr, int wc, int fr, int fq, const LAS float* aux) const {
        asm volatile("" : "+v"(fr), "+v"(fq));
        const int row0 = u.pm * BM + wr * 64 + fr; const int colt = u.pn * BM; const bool isk = colt >= 1024;
        const int col0 = (isk ? colt - 1024 : colt) + wc * 32 + 8 * fq;
        const float sc = isk ? 1.f : scale;
#pragma unroll
        for (int ai = 0; ai < 2; ++ai)
#pragma unroll
            for (int m = 0; m < 4; ++m) { const int t = row0 + ai * HALF + m * 16;
#pragma unroll
                for (int bj = 0; bj < 2; ++bj) { const f32x4 v0 = acc[ai][bj][m][0] * sc, v1 = acc[ai][bj][m][1] * sc; const int c = col0 + bj * HALF;
                    u32x4 w; w.x = cvt_pk_bf16(v0[0], v0[1]); w.y = cvt_pk_bf16(v0[2], v0[3]); w.z = cvt_pk_bf16(v1[0], v1[1]); w.w = cvt_pk_bf16(v1[2], v1[3]);
                    bf16_t* p;
                    if (isk) { const int b = t >> 13, tt = t & 8191, h = c >> 6, d8 = (c & 63) >> 3;
                        p = KF + ((((size_t)(b * 16 + h) * 256 + (tt >> 5)) * 4 + (d8 >> 1)) * 64 + (d8 & 1) * 32 + (tt & 31)) * 8; }
                    else p = Q + (size_t)t * 1024 + c;
                    *(u32x4*)p = w; } }
    }
};
struct EpiVF {
    static constexpr bool PERM = true; static constexpr int NAUX = 0;
    bf16_t* VF;
    __device__ __forceinline__ void operator()(const f32x4 (&acc)[2][2][4][2], const Unit& u, int wr, int wc, int fr, int fq, const LAS float* aux) const {
        asm volatile("" : "+v"(fr), "+v"(fq));
        const int row0 = u.pm * BM + wr * 64 + fr; const int col0 = u.pn * BM + wc * 32 + 8 * fq;
#pragma unroll
        for (int ai = 0; ai < 2; ++ai)
#pragma unroll
            for (int m = 0; m < 4; ++m) { const int dg = row0 + ai * HALF + m * 16; const int h = dg >> 6, dd = dg & 63;
#pragma unroll
                for (int bj = 0; bj < 2; ++bj) { const f32x4 v0 = acc[ai][bj][m][0], v1 = acc[ai][bj][m][1]; const int t = col0 + bj * HALF;
                    const int b = t >> 13, tt = t & 8191, t32 = tt & 31;
                    bf16_t* p = VF + (((((size_t)(b * 16 + h) * 256 + (tt >> 5)) * 2 + (dd >> 5)) * 2 + (t32 >> 4)) * 64 + (dd & 31)) * 8 + ((t32 >> 3) & 1) * 4;
                    u32x2 w0, w1; w0.x = cvt_pk_bf16(v0[0], v0[1]); w0.y = cvt_pk_bf16(v0[2], v0[3]); w1.x = cvt_pk_bf16(v1[0], v1[1]); w1.y = cvt_pk_bf16(v1[2], v1[3]);
                    *(u32x2*)p = w0; *(u32x2*)(p + 32 * 8) = w1; } }
    }
};
__device__ __forceinline__ float swiglu1(float xg, float xl) {
    const float g = fminf(xg, 7.0f), l = __builtin_amdgcn_fmed3f(xl, -7.0f, 7.0f);
    const float s = frcp(1.0f + fexp2(-1.702f * LOG2E * g));
    return g * s * (l + 1.0f);
}
struct EpiSwiglu {
    static constexpr bool PERM = true; static constexpr int NAUX = 0;
    bf16_t* O; const float* b1;
    __device__ __forceinline__ void operator()(const f32x4 (&acc)[2][2][4][2], const Unit& u, int wr, int wc, int fr, int fq, const LAS float* aux) const {
        asm volatile("" : "+v"(fr), "+v"(fq));
        const int row0 = u.pm * BM + wr * 64 + fr; const int col0 = u.pn * BM + wc * 32 + 8 * fq;
        const float* bp = b1 + (size_t)u.e * 2048 + col0;
        f32x4 bv[2][2];
#pragma unroll
        for (int bj = 0; bj < 2; ++bj)
#pragma unroll
            for (int n = 0; n < 2; ++n) bv[bj][n] = *(const f32x4*)(bp + bj * HALF + 4 * n);
#pragma unroll
        for (int ai = 0; ai < 2; ++ai)
#pragma unroll
            for (int m = 0; m < 4; ++m) { bf16_t* rowp = O + (size_t)(row0 + ai * HALF + m * 16) * 1024 + (col0 >> 1);
#pragma unroll
                for (int bj = 0; bj < 2; ++bj) { const f32x4 v0 = acc[ai][bj][m][0] + bv[bj][0], v1 = acc[ai][bj][m][1] + bv[bj][1];
                    u32x2 w; w.x = cvt_pk_bf16(swiglu1(v0[0], v0[1]), swiglu1(v0[2], v0[3])); w.y = cvt_pk_bf16(swiglu1(v1[0], v1[1]), swiglu1(v1[2], v1[3]));
                    *(u32x2*)(rowp + bj * (HALF / 2)) = w; } }
    }
};
struct EpiSwiglu8 {
    static constexpr bool PERM = true; static constexpr int NAUX = 1;
    __device__ __forceinline__ const float* aux_src(const Unit& u, int) const { return b1 + (size_t)u.e * 2048 + u.pn * BM; }
    unsigned char* O; const float* b1;
    __device__ __forceinline__ void operator()(const f32x4 (&acc)[2][2][4][2], const Unit& u, int wr, int wc, int fr, int fq, const LAS float* aux) const {
        asm volatile("" : "+v"(fr), "+v"(fq));
        const int row0 = u.pm * BM + wr * 64 + fr; const int col0 = u.pn * BM + wc * 32 + 8 * fq;
        f32x4 bv[2][2];
#pragma unroll
        for (int bj = 0; bj < 2; ++bj)
#pragma unroll
            for (int n = 0; n < 2; ++n) bv[bj][n] = *(const LAS f32x4*)(aux + wc * 32 + 8 * fq + bj * HALF + 4 * n);
#pragma unroll
        for (int ai = 0; ai < 2; ++ai)
#pragma unroll
            for (int m = 0; m < 4; ++m) {
                f32x2 g[4], l[4], t[4];
#pragma unroll
                for (int bj = 0; bj < 2; ++bj)
#pragma unroll
                    for (int n = 0; n < 2; ++n) { const f32x4 v = acc[ai][bj][m][n] + bv[bj][n]; const int o = bj * 2 + n;
                        g[o] = (f32x2){fminf(v[0], 7.0f), fminf(v[2], 7.0f)}; l[o] = (f32x2){__builtin_amdgcn_fmed3f(v[1], -7.0f, 7.0f), __builtin_amdgcn_fmed3f(v[3], -7.0f, 7.0f)} + 1.0f; }
#pragma unroll
                for (int i = 0; i < 4; ++i) { const f32x2 a = g[i] * (-1.702f * LOG2E); t[i] = (f32x2){fexp2(a.x), fexp2(a.y)}; }
                __builtin_amdgcn_sched_barrier(0);
#pragma unroll
                for (int i = 0; i < 4; ++i) { const f32x2 d = t[i] + 1.0f; t[i] = (f32x2){frcp(d.x), frcp(d.y)}; }
                __builtin_amdgcn_sched_barrier(0);
#pragma unroll
                for (int i = 0; i < 4; ++i) t[i] = (g[i] * t[i]) * l[i];
                unsigned char* rowp = O + (size_t)(row0 + ai * HALF + m * 16) * 1024 + (col0 >> 1);
                *(unsigned*)rowp = pk4_fp8_nc(t[0].x, t[0].y, t[1].x, t[1].y); *(unsigned*)(rowp + HALF / 2) = pk4_fp8_nc(t[2].x, t[2].y, t[3].x, t[3].y);
            }
    }
};
struct EpiDown {
    static constexpr bool PERM = true; static constexpr int NAUX = 0;
    bf16_t* O; const float* b2; const float* gatel;
    __device__ __forceinline__ void operator()(const f32x4 (&acc)[2][2][4][2], const Unit& u, int wr, int wc, int fr, int fq, const LAS float* aux) const {
        asm volatile("" : "+v"(fr), "+v"(fq));
        const int rl0 = wr * 64 + fr; const int col0 = u.pn * BM + wc * 32 + 8 * fq;
        const float* bp = b2 + (size_t)u.e * 1024 + col0; const float* gp = gatel + (size_t)u.e * T + u.mt * 256 + rl0;
        f32x4 bv[2][2];
#pragma unroll
        for (int bj = 0; bj < 2; ++bj)
#pragma unroll
            for (int n = 0; n < 2; ++n) bv[bj][n] = *(const f32x4*)(bp + bj * HALF + 4 * n);
#pragma unroll
        for (int ai = 0; ai < 2; ++ai)
#pragma unroll
            for (int m = 0; m < 4; ++m) { const float gt = gp[ai * HALF + m * 16]; bf16_t* rowp = O + (size_t)(u.pm * BM + rl0 + ai * HALF + m * 16) * 1024 + col0;
#pragma unroll
                for (int bj = 0; bj < 2; ++bj) { const f32x4 v0 = (acc[ai][bj][m][0] + bv[bj][0]) * gt, v1 = (acc[ai][bj][m][1] + bv[bj][1]) * gt;
                    u32x4 w; w.x = cvt_pk_bf16(v0[0], v0[1]); w.y = cvt_pk_bf16(v0[2], v0[3]); w.z = cvt_pk_bf16(v1[0], v1[1]); w.w = cvt_pk_bf16(v1[2], v1[3]);
                    *(u32x4*)(rowp + bj * HALF) = w; } }
    }
};

struct EpiDown8 {
    static constexpr bool PERM = true; static constexpr int NAUX = 2;
    __device__ __forceinline__ const float* aux_src(const Unit& u, int k) const { return k == 0 ? b2 + (size_t)u.e * 1024 + u.pn * BM : gatel + (size_t)u.e * T + u.mt * 256; }
    unsigned char* O; const float* b2; const float* gatel;
    __device__ __forceinline__ void operator()(const f32x4 (&acc)[2][2][4][2], const Unit& u, int wr, int wc, int fr, int fq, const LAS float* aux) const {
        asm volatile("" : "+v"(fr), "+v"(fq));
        const int rl0 = wr * 64 + fr; const int col0 = u.pn * BM + wc * 32 + 8 * fq;
        const LAS float* gp = aux + 256 + rl0;
        f32x4 bv[2][2];
#pragma unroll
        for (int bj = 0; bj < 2; ++bj)
#pragma unroll
            for (int n = 0; n < 2; ++n) bv[bj][n] = *(const LAS f32x4*)(aux + wc * 32 + 8 * fq + bj * HALF + 4 * n);
#pragma unroll
        for (int ai = 0; ai < 2; ++ai)
#pragma unroll
            for (int m = 0; m < 4; ++m) { const float gt = gp[ai * HALF + m * 16] * 16.0f; unsigned char* rowp = O + (size_t)(u.pm * BM + rl0 + ai * HALF + m * 16) * 1024 + col0;
#pragma unroll
                for (int bj = 0; bj < 2; ++bj) { const f32x4 v0 = (acc[ai][bj][m][0] + bv[bj][0]) * gt, v1 = (acc[ai][bj][m][1] + bv[bj][1]) * gt;
                    u32x2 w; w.x = pk4_fp8(v0[0], v0[1], v0[2], v0[3]); w.y = pk4_fp8(v1[0], v1[1], v1[2], v1[3]);
                    *(u32x2*)(rowp + bj * HALF) = w; } }
    }
};

template <class Epi, class Sched, int GATHER, int F8 = 0>
__device__ __forceinline__ void gemm_phase(LAS unsigned char* lds, const Gemm g, const Sched& S, const Epi& E, const int* tokl, LAS unsigned* rowtab, const int tid) {
    const int wid = __builtin_amdgcn_readfirstlane(tid >> 6), lane = tid & 63, wr = wid >> 2, wc = wid & 3, fr = lane & 15, fq = lane >> 4;
    const int K = g.K, nt = K / BK;
    unsigned voffA[2], voffB[2];
#pragma unroll
    for (int i = 0; i < 2; ++i) { int R, C; stage_rc(tid * 16 + i * 8192, R, C); const int Rb = Epi::PERM ? ((R & ~31) + perm32(R & 31)) : R;
        voffA[i] = (unsigned)(R * K + C) * 2u; voffB[i] = (unsigned)(Rb * K + C) * 2u; }
    const size_t kstep = (size_t)(BK * 2);
    const size_t hstep = (size_t)HALF * K * 2;
    const size_t tstep = 2 * hstep;
    const unsigned ldsw = (unsigned)wid * 1024u;
    const int aoff = lds_byte(wr * 64 + fr, fq * 8), boff = lds_byte(wc * 32 + fr, fq * 8);
    unsigned vC[2][2];
#define PG8_SA(b, h) (((b) * 2 + (h)) * HTB)
#define PG8_SB(b, h) ((4 + (b) * 2 + (h)) * HTB)
#define PG8_GLDS(gp, bufoff, i_) __builtin_amdgcn_global_load_lds((const unsigned*)(gp), (LAS unsigned*)(lds + (bufoff) + ldsw + (i_) * 8192), 16, 0, 0)
#define PG8_STAGE_B(bufoff, gbase) do { _Pragma("unroll") for (int _i = 0; _i < 2; ++_i) PG8_GLDS((const char*)(gbase) + voffB[_i], bufoff, _i); } while (0)
#define PG8_STAGE_A(bufoff, gbase, h, nx) do { _Pragma("unroll") for (int _i = 0; _i < 2; ++_i) { \
        if constexpr (GATHER) { PG8_GLDS((const char*)(gbase) + vC[h][_i], bufoff, _i); } \
        else PG8_GLDS((const char*)(gbase) + (h) * hstep + voffA[_i], bufoff, _i); } } while (0)
#define PG8_LDA(dst, b, h) do { _Pragma("unroll") for (int m = 0; m < 4; ++m) _Pragma("unroll") for (int k = 0; k < 2; ++k) dst[m][k] = *(const LAS bf16x8*)(lds + PG8_SA(b, h) + aoff + m * 2048 + k * 1024); } while (0)
#define PG8_LDB(dst, b, h) do { _Pragma("unroll") for (int n = 0; n < 2; ++n) _Pragma("unroll") for (int k = 0; k < 2; ++k) dst[n][k] = *(const LAS bf16x8*)(lds + PG8_SB(b, h) + boff + n * 2048 + k * 1024); } while (0)
#define PG8_MMA(ai, bj, At, Bt) do { __builtin_amdgcn_s_setprio(1); _Pragma("unroll") for (int m = 0; m < 4; ++m) _Pragma("unroll") for (int n = 0; n < 2; ++n) { \
        if constexpr (F8 != 0) {   \
            const i32x4 _b0 = __builtin_bit_cast(i32x4, Bt[n][0]), _b1 = __builtin_bit_cast(i32x4, Bt[n][1]), _a0 = __builtin_bit_cast(i32x4, At[m][0]), _a1 = __builtin_bit_cast(i32x4, At[m][1]); \
            const i32x8 _bb = __builtin_shufflevector(_b0, _b1, 0, 1, 2, 3, 4, 5, 6, 7), _aa = __builtin_shufflevector(_a0, _a1, 0, 1, 2, 3, 4, 5, 6, 7); \
            acc[ai][bj][m][n] = __builtin_amdgcn_mfma_scale_f32_16x16x128_f8f6f4(_bb, _aa, acc[ai][bj][m][n], 0, 0, 0, (int)(F8 * 0x01010101u), 0, 0x7f7f7f7f); \
        } else { _Pragma("unroll") for (int k = 0; k < 2; ++k) acc[ai][bj][m][n] = __builtin_amdgcn_mfma_f32_16x16x32_bf16(Bt[n][k], At[m][k], acc[ai][bj][m][n], 0, 0, 0); } } \
        __builtin_amdgcn_s_setprio(0); } while (0)
#define PG8_WAIT_V(n) asm volatile("s_waitcnt vmcnt(" #n ")" ::: "memory")
#define PG8_WAIT_L(n) asm volatile("s_waitcnt lgkmcnt(" #n ")" ::: "memory")
#define PG8_BAR __builtin_amdgcn_s_barrier()
#define PG8_SCHED __builtin_amdgcn_sched_barrier(0)
#define PG8_ROWDMA(u_, slot_) do { if (GATHER == 1 && wid < 4) __builtin_amdgcn_global_load_lds((const unsigned*)(tokl + (size_t)(u_).e * T + (u_).mt * 256 + wid * 64 + lane), (LAS unsigned*)(rowtab + (slot_) * 256 + wid * 64), 4, 0, 0); } while (0)
#define PG8_ROWOFF(dst, u_, slot_) do { _Pragma("unroll") for (int _i = 0; _i < 2; ++_i) { int _R, _C; stage_rc(tid * 16 + _i * 8192, _R, _C); _Pragma("unroll") for (int _h = 0; _h < 2; ++_h) { const int _r = _h * HALF + _R; \
        unsigned _t; if constexpr (GATHER == 1) { _t = rowtab[(slot_) * 256 + _r]; _t = (_r < (u_).valid) ? _t : 0u; } else _t = (unsigned)((u_).pm * 256 + _r); \
        dst[_h][_i] = _t * (unsigned)(K * 2) + (unsigned)_C * 2u; } } } while (0)
    Unit cur, nxt; int ui = 0;
    if (!S.next(0, cur)) return;
    f32x4 acc[2][2][4][2];
#pragma unroll
    for (int a = 0; a < 2; ++a)
#pragma unroll
        for (int b = 0; b < 2; ++b)
#pragma unroll
            for (int m = 0; m < 4; ++m)
#pragma unroll
                for (int n = 0; n < 2; ++n) acc[a][b][m][n] = (f32x4){0.f, 0.f, 0.f, 0.f};
    bf16x8 At[4][2], B0[2][2], B1[2][2];
    const char* cA = GATHER ? (const char*)g.A : (const char*)g.A + (size_t)cur.pm * tstep;
    const char* cB = (const char*)g.Bt + ((size_t)cur.e * g.brows + (size_t)cur.pn * BM) * K * 2;
    if constexpr (GATHER != 0) {
        PG8_ROWDMA(cur, 0); PG8_WAIT_V(0); __syncthreads();
        PG8_ROWOFF(vC, cur, 0);
        PG8_WAIT_L(0);
    }
    PG8_STAGE_B(PG8_SB(0, 0), cB); PG8_STAGE_B(PG8_SB(0, 1), cB + hstep); PG8_STAGE_A(PG8_SA(0, 0), cA, 0, false); PG8_STAGE_A(PG8_SA(0, 1), cA, 1, false);
    if (wr == 1) PG8_BAR;
    PG8_WAIT_V(2); PG8_BAR;
    PG8_STAGE_B(PG8_SB(1, 0), cB + kstep); PG8_STAGE_A(PG8_SA(1, 0), cA + kstep, 0, false); PG8_STAGE_B(PG8_SB(1, 1), cB + hstep + kstep);
    PG8_WAIT_V(6); PG8_BAR;
    for (;;) {
        if constexpr (Epi::NAUX > 0) { if (wid < Epi::NAUX) __builtin_amdgcn_global_load_lds((const unsigned*)(E.aux_src(cur, wid) + lane * 4), (LAS unsigned*)(lds + AUX_OFF + (ui & 1) * 2048 + wid * 1024), 16, 0, 0); }
        const bool has_next = S.next(ui + 1, nxt);
        if constexpr (GATHER) { if (has_next) PG8_ROWDMA(nxt, (ui + 1) & 1); }
        const char* nA = has_next ? (GATHER ? (const char*)g.A : (const char*)g.A + (size_t)nxt.pm * tstep) : cA;
        const char* nB = has_next ? (const char*)g.Bt + ((size_t)nxt.e * g.brows + (size_t)nxt.pn * BM) * K * 2 : cB;
#pragma unroll 1
        for (int t = 0; t < nt; t += 2) {
            const bool last = (t == nt - 2);
            const char* a1 = cA + (size_t)(t + 1) * kstep;
            const char* a2 = last ? nA : cA + (size_t)(t + 2) * kstep; const char* b2 = last ? nB : cB + (size_t)(t + 2) * kstep;
            const char* a3 = a2 + kstep; const char* b3 = b2 + kstep;
            PG8_LDB(B0, 0, 0); PG8_LDB(B1, 0, 1); PG8_SCHED; PG8_LDA(At, 0, 0); PG8_STAGE_A(PG8_SA(1, 1), a1, 1, false);
            if constexpr (GATHER) { if (last && has_next) { PG8_ROWOFF(vC, nxt, (ui + 1) & 1); } }
            PG8_WAIT_V(8); PG8_WAIT_L(0); PG8_BAR; PG8_MMA(0, 0, At, B0); PG8_MMA(0, 1, At, B1); PG8_BAR; PG8_SCHED;
            PG8_LDA(At, 0, 1); PG8_STAGE_B(PG8_SB(0, 0), b2); PG8_STAGE_B(PG8_SB(0, 1), b2 + hstep); PG8_STAGE_A(PG8_SA(0, 0), a2, 0, last);
            PG8_WAIT_V(8); PG8_WAIT_L(0); PG8_BAR; PG8_MMA(1, 0, At, B0); PG8_MMA(1, 1, At, B1); PG8_BAR; PG8_SCHED;
            PG8_LDB(B0, 1, 0); PG8_LDB(B1, 1, 1); PG8_SCHED; PG8_LDA(At, 1, 0); PG8_STAGE_A(PG8_SA(0, 1), a2, 1, last);
            PG8_WAIT_V(8); PG8_WAIT_L(0); PG8_BAR; PG8_MMA(0, 0, At, B0); PG8_MMA(0, 1, At, B1); PG8_BAR; PG8_SCHED;
            PG8_LDA(At, 1, 1); PG8_STAGE_B(PG8_SB(1, 0), b3); PG8_STAGE_B(PG8_SB(1, 1), b3 + hstep); PG8_STAGE_A(PG8_SA(1, 0), a3, 0, last);
            PG8_WAIT_V(8); PG8_WAIT_L(0); PG8_BAR; PG8_MMA(1, 0, At, B0); PG8_MMA(1, 1, At, B1); PG8_BAR; PG8_SCHED;
        }
        if (wr == 0) PG8_BAR;
        E(acc, cur, wr, wc, fr, fq, (const LAS float*)(lds + AUX_OFF + (ui & 1) * 2048));
#if defined(PROBE_EPI2)
        E(acc, cur, wr, wc, fr, fq, (const LAS float*)(lds + AUX_OFF + (ui & 1) * 2048));
#endif
        if (!has_next) break;
#pragma unroll
        for (int a = 0; a < 2; ++a)
#pragma unroll
            for (int b = 0; b < 2; ++b)
#pragma unroll
                for (int m = 0; m < 4; ++m)
#pragma unroll
                    for (int n = 0; n < 2; ++n) acc[a][b][m][n] = (f32x4){0.f, 0.f, 0.f, 0.f};
        cur = nxt; cA = nA; cB = nB; ++ui;
        if (wr == 1) PG8_BAR;
    }
    PG8_WAIT_V(0);
    PG8_BAR;
#undef PG8_SA
#undef PG8_SB
#undef PG8_GLDS
#undef PG8_STAGE_A
#undef PG8_STAGE_B
#undef PG8_LDA
#undef PG8_LDB
#undef PG8_MMA
#undef PG8_WAIT_V
#undef PG8_WAIT_L
#undef PG8_BAR
#undef PG8_SCHED
#undef PG8_ROWDMA
#undef PG8_ROWOFF
}
}

constexpr size_t MiB = 1u << 20;
constexpr size_t WS_CTL = 0, CTL_ZERO_BYTES = 128 * 1024;
constexpr size_t WS_TOKL = 1 * MiB, WS_GATEL = 5 * MiB, WS_TINFO = 9 * MiB;
constexpr size_t WS_WIN0T = 10 * MiB, WS_WO0T = 15 * MiB, WS_WIN1T = 17 * MiB, WS_WO1T = 23 * MiB;
constexpr size_t WS_W1T = 26 * MiB, WS_W2T = 154 * MiB, WS_XB = 218 * MiB;
constexpr size_t WS_SA = 282 * MiB, WS_SB = 554 * MiB, WS_XB8 = 826 * MiB, WS_END = 858 * MiB;
constexpr int CW_BAR = 4096, CW_CNT = 16384;

constexpr int RING_BYTES = 131072;
constexpr int ROWTAB_OFF = RING_BYTES;
constexpr int MOETAB_OFF = ROWTAB_OFF + 2048;
constexpr int MISC_OFF = MOETAB_OFF + 512;
constexpr int LDS_BYTES = 147456;
static_assert(pg8::AUX_OFF == MISC_OFF + 256 && pg8::AUX_OFF + 4096 <= LDS_BYTES, "LDS map");

#define XB_TMO      128
#define XB_XCNT(j)  (256  + 64 * (j))
#define XB_XSUB(j)  (1280 + 64 * (j))
#define XB_XGEN(j)  (2304 + 64 * (j))
#define XB_TOP      3328
#define XB_TOPGEN   3392
#define XCD_BAR_WORDS 3456
#define XB_SPIN_CAP (1u << 20)
__device__ __forceinline__ unsigned xb_ld(unsigned* p)              { return __hip_atomic_load(p, __ATOMIC_RELAXED, __HIP_MEMORY_SCOPE_AGENT); }
__device__ __forceinline__ unsigned xb_add(unsigned* p, unsigned v) { return __hip_atomic_fetch_add(p, v, __ATOMIC_RELAXED, __HIP_MEMORY_SCOPE_AGENT); }
__device__ __forceinline__ unsigned xb_xcc_id() { return (unsigned)__builtin_amdgcn_s_getreg((3 << 11) | 20) & 0xFu; }
#define XB_SPIN(cond, bar) do { unsigned _sp = 0; while (cond) { __builtin_amdgcn_s_sleep(1); \
    if ((++_sp & 255u) == 0u) { if (xb_ld(&(bar)[XB_TMO])) break; if (_sp > XB_SPIN_CAP) { atomicAdd(&(bar)[XB_TMO], 1u); break; } } } } while (0)
struct XcdBarrier { unsigned* bar; unsigned x; volatile LAS unsigned* st; int wave; };
__device__ __forceinline__ XcdBarrier xcd_barrier_post(unsigned* bar, volatile LAS unsigned* st) {
    XcdBarrier b; b.bar = bar; b.x = xb_xcc_id(); b.st = st; b.wave = __builtin_amdgcn_readfirstlane(threadIdx.x >> 6);
    if (threadIdx.x == 0) (void)xb_add(&bar[XB_XCNT(b.x)], 1u);
    return b;
}
__device__ __forceinline__ void xcd_barrier_complete(unsigned* bar, unsigned x, unsigned& nloc, unsigned& nx) {
    const unsigned G = gridDim.x * gridDim.y * gridDim.z;
    unsigned sum, cnt, mine, sp = 0u;
    for (;;) {
        sum = 0u; cnt = 0u; mine = 0u;
#pragma unroll
        for (unsigned j = 0; j < 16; ++j) { const unsigned c = xb_ld(&bar[XB_XCNT(j)]); sum += c; cnt += (c > 0u) ? 1u : 0u; mine = (j == x) ? c : mine; }
        if (sum == G) break;
        __builtin_amdgcn_s_sleep(1);
        if ((++sp & 255u) == 0u) { if (xb_ld(&bar[XB_TMO])) break; if (sp > XB_SPIN_CAP) { atomicAdd(&bar[XB_TMO], 1u); break; } }
    }
    nloc = mine > 0u ? mine : 1u; nx = cnt > 0u ? cnt : 1u;
}
__device__ __forceinline__ void xcd_barrier(const XcdBarrier& b) {
    asm volatile("s_waitcnt vmcnt(0)" ::: "memory");
    __syncthreads();
    if (b.wave == 0 && lane_id_asm() == 0) {
        unsigned* bar = b.bar;
        __builtin_amdgcn_s_waitcnt(0);
        unsigned nloc = b.st[0], nx = b.st[1];
        if (nloc == 0u) { xcd_barrier_complete(bar, b.x, nloc, nx); b.st[0] = nloc; b.st[1] = nx; }
        const unsigned old = xb_add(&bar[XB_XSUB(b.x)], 1u);
        const unsigned gen = old / nloc;
        if (old + 1u == (gen + 1u) * nloc) {
            __builtin_amdgcn_fence(__ATOMIC_RELEASE, "agent");
            asm volatile("s_waitcnt vmcnt(0)" ::: "memory");
            const unsigned og = xb_add(&bar[XB_TOP], 1u);
            const unsigned tg = og / nx;
            if (og + 1u == (tg + 1u) * nx) xb_add(&bar[XB_TOPGEN], 1u);
            else XB_SPIN(xb_ld(&bar[XB_TOPGEN]) == tg, bar);
            __builtin_amdgcn_fence(__ATOMIC_ACQUIRE, "agent");
            xb_add(&bar[XB_XGEN(b.x)], 1u);
            asm volatile("s_waitcnt vmcnt(0)" ::: "memory");
        } else {
            XB_SPIN(xb_ld(&bar[XB_XGEN(b.x)]) == gen, bar);
            __builtin_amdgcn_fence(__ATOMIC_ACQUIRE, "agent");
            asm volatile("s_waitcnt vmcnt(0)" ::: "memory");
        }
    }
    __syncthreads();
}

#define LDS_WAIT() asm volatile("s_waitcnt lgkmcnt(0)" ::: "memory")
#define LDS_BARRIER() do { asm volatile("s_waitcnt lgkmcnt(0)" ::: "memory"); __builtin_amdgcn_s_barrier(); asm volatile("" ::: "memory"); } while (0)
__device__ __forceinline__ float wave_sum(float v) {
#pragma unroll
    for (int o = 1; o < 64; o <<= 1) v += __shfl_xor(v, o);
    return v;
}
__device__ __forceinline__ void transpose_item(const float* W, int ldw, bf16_t* WT, int ldt, int k0, int n0, int dst_row0, LAS float* scr, int lane, int rstride = 1) {
#pragma unroll 8
    for (int i = 0; i < 32; ++i) { const int kk = 2 * i + (lane >> 5); scr[kk * 33 + (lane & 31)] = W[(size_t)(k0 + kk) * ldw + n0 + (lane & 31)]; }
    LDS_WAIT(); asm volatile("" ::: "memory");
    const int c = lane & 7;
#pragma unroll
    for (int j = 0; j < 4; ++j) { const int n = (lane >> 3) + 8 * j; const LAS float* s = scr + (8 * c) * 33 + n;
        u32x4 o; o.x = pk2(s[0 * 33], s[1 * 33]); o.y = pk2(s[2 * 33], s[3 * 33]); o.z = pk2(s[4 * 33], s[5 * 33]); o.w = pk2(s[6 * 33], s[7 * 33]);
        *(u32x4*)(WT + (size_t)(dst_row0 + n * rstride) * ldt + k0 + 8 * c) = o; }
    LDS_WAIT(); asm volatile("" ::: "memory");
}
constexpr int W1_SH = 6, W2_SH = 7;
__device__ __forceinline__ void conv_moe_wg(const float* w1, const float* w2, unsigned char* W1T, unsigned char* W2T, LAS float* buf, int bx, int G, int tid, int j0, int j1) {
    constexpr int I1 = 8 * 16, I2 = 8 * 8, NIT = NE * (I1 + I2);
    const int lrow = tid >> 5, lcol = (tid & 31) * 4;
    f32x4 ra[8], rb[8];
#define CM_SRC(it_, src_, ldw_) const float* src_; int ldw_; { if ((it_) < NE * I1) { const int e_ = (it_) >> 7, q_ = (it_) & 127, kb_ = q_ >> 4, nb_ = q_ & 15; ldw_ = 2048; src_ = w1 + (size_t)e_ * 1024 * 2048 + (size_t)(128 * kb_) * 2048 + 128 * nb_; } \
        else { const int j_ = (it_) - NE * I1, e_ = j_ >> 6, q_ = j_ & 63, kb_ = q_ >> 3, nb_ = q_ & 7; ldw_ = 1024; src_ = w2 + (size_t)e_ * 1024 * 1024 + (size_t)(128 * kb_) * 1024 + 128 * nb_; } }
#define CM_LOAD(R_, it_) do { CM_SRC(it_, sp_, lw_); _Pragma("unroll") for (int i = 0; i < 8; ++i) R_[i] = __builtin_nontemporal_load((const f32x4*)(sp_ + (size_t)(lrow + 16 * i) * lw_ + lcol)); } while (0)
#define CM_ITEM(R_, it_) do { \
        _Pragma("unroll") for (int i = 0; i < 8; ++i) *(LAS f32x4*)(buf + (lrow + 16 * i) * 132 + (lcol ^ (8 * (i & 3)))) = R_[i];     \
        __syncthreads(); \
        if ((it_) + 2 * G < itend) CM_LOAD(R_, (it_) + 2 * G); \
        unsigned char* dst; float sc; \
        if ((it_) < NE * I1) { const int e = (it_) >> 7, q = (it_) & 127, kb = q >> 4, nb = q & 15; dst = W1T + (size_t)e * 2048 * 1024 + (size_t)(128 * nb) * 1024 + 128 * kb; sc = (float)(1 << W1_SH); } \
        else { const int j = (it_) - NE * I1, e = j >> 6, q = j & 63, kb = q >> 3, nb = q & 7; dst = W2T + (size_t)e * 1024 * 1024 + (size_t)(128 * nb) * 1024 + 128 * kb; sc = (float)(1 << W2_SH); } \
        const int c = tid & 7; \
        _Pragma("unroll") for (int p = 0; p < 2; ++p) { const int nn = (tid >> 3) + 64 * p; const LAS float* sp = buf + (16 * c) * 132 + (nn ^ (8 * (c & 3))); \
            u32x4 o; \
            o.x = pk4_fp8(sp[0 * 132] * sc, sp[1 * 132] * sc, sp[2 * 132] * sc, sp[3 * 132] * sc); o.y = pk4_fp8(sp[4 * 132] * sc, sp[5 * 132] * sc, sp[6 * 132] * sc, sp[7 * 132] * sc); \
            o.z = pk4_fp8(sp[8 * 132] * sc, sp[9 * 132] * sc, sp[10 * 132] * sc, sp[11 * 132] * sc); o.w = pk4_fp8(sp[12 * 132] * sc, sp[13 * 132] * sc, sp[14 * 132] * sc, sp[15 * 132] * sc); \
            *(u32x4*)(dst + (size_t)nn * 1024 + 16 * c) = o; } \
        __syncthreads(); } while (0)
    int it = bx + j0 * G; const int itend = (bx + j1 * G) < NIT ? (bx + j1 * G) : NIT;
    __syncthreads();
    if (it < itend) CM_LOAD(ra, it);
    if (it + G < itend) CM_LOAD(rb, it + G);
    for (; it < itend; it += 2 * G) {
        CM_ITEM(ra, it);
        if (it + G < itend) CM_ITEM(rb, it + G);
    }
#undef CM_ITEM
#undef CM_SRC
#undef CM_LOAD
}
__device__ __forceinline__ void ln_row(f32x4 (&v)[4], const float* w, const float* b, int lane) {
    float s = 0.f;
#pragma unroll
    for (int j = 0; j < 4; ++j) s += (v[j].x + v[j].y) + (v[j].z + v[j].w);
    const float mean = wave_sum(s) * (1.f / D); float s2 = 0.f;
#pragma unroll
    for (int j = 0; j < 4; ++j) { v[j] = v[j] - mean; s2 += (v[j].x * v[j].x + v[j].y * v[j].y) + (v[j].z * v[j].z + v[j].w * v[j].w); }
    const float rstd = 1.f / sqrtf(wave_sum(s2) * (1.f / D) + LN_EPS);
#pragma unroll
    for (int j = 0; j < 4; ++j) { const f32x4 ww = *(const f32x4*)(w + 4 * lane + 256 * j), bb = *(const f32x4*)(b + 4 * lane + 256 * j); v[j] = v[j] * rstd * ww + bb; }
}
__device__ __forceinline__ void moe_table(const unsigned* cnt, LAS int* tab, int tid) {
    if (tid < 32) tab[33 + tid] = (int)__hip_atomic_load(cnt + tid, __ATOMIC_RELAXED, __HIP_MEMORY_SCOPE_AGENT);
    __syncthreads();
    if (tid == 0) { int p = 0; for (int e = 0; e < 32; ++e) { tab[e] = p; p += (tab[33 + e] + 255) >> 8; } tab[32] = p; }
    __syncthreads();
}

constexpr int HG_KUT = 0, HG_DD = 18432, HG_QH = 20480, HG_KD = 37888, HG_OB = 55296, HG_RED = 89088, HG_G = 91136;
template <int MODE>
__device__ __forceinline__ void hgrn_unit(LAS unsigned char* lds, int unit, const bf16_t* PROJ, const bf16_t* IT, float* SLOC, float* DTOT, const float* lbl, const float* anw, bf16_t* AO, int tid, int wave, int lane) {
    const int bh = unit >> 5, sc = unit & 31, b = bh >> 2, h = bh & 3;
    const int t0 = sc * 256;
    const int si = tid >> 7, dk = tid & 127;
    const int g = lane >> 4, c16 = lane & 15;
    float lb;
    { const float l0 = lbl[h * 128 + dk], l1 = lbl[512 + h * 128 + dk], l2 = lbl[1024 + h * 128 + dk]; const float m = fmaxf(l0, fmaxf(l1, l2));
      const float e0 = __expf(l0 - m), e1 = __expf(l1 - m), e2 = __expf(l2 - m); lb = e0 / (e0 + e1 + e2); }
    const float oml = 1.0f - lb;
    f32x4 S[8];
#pragma unroll
    for (int tau = 0; tau < 8; ++tau) {
        if (MODE == 1) {
#pragma unroll
            for (int r = 0; r < 4; ++r) S[tau][r] = SLOC[(size_t)unit * 16384 + (16 * tau + 4 * g + r) * 128 + 16 * wave + c16];
        } else S[tau] = (f32x4){0.f, 0.f, 0.f, 0.f};
    }
    float lsum = 1.f;
    unsigned qz[16]; u32x2 vfn[4];
    const unsigned rlo = (unsigned)(16 * si * 2048 + 2 * dk);
    { const bf16_t* sb = PROJ + ((size_t)b * SEQ + t0) * 2048 + h * 256;
#pragma unroll
      for (int j = 0; j < 16; ++j) qz[j] = *(const unsigned*)(sb + (size_t)j * 2048 + rlo);
      const bf16_t* vp = IT + (size_t)(h * 128 + 16 * wave + c16) * T + (size_t)b * SEQ + t0 + 4 * g;
#pragma unroll
      for (int i = 0; i < 4; ++i) vfn[i] = *(const u32x2*)(vp + 16 * i); }
#pragma unroll 1
    for (int c4 = 0; c4 < 4; ++c4) {
        const int tc = t0 + 64 * c4;
        if (MODE == 1) {
#pragma unroll
            for (int i = 0; i < 2; ++i) { const int r0 = 8 * wave + 4 * i;
                __builtin_amdgcn_global_load_lds((const unsigned*)(PROJ + ((size_t)b * SEQ + tc + r0 + (lane >> 4)) * 2048 + 1024 + h * 128 + 8 * (lane & 15)), (LAS unsigned*)(lds + HG_G + r0 * 256), 16, 0, 0); }
        }
        u32x2 vf[4];
#pragma unroll
        for (int i = 0; i < 4; ++i) vf[i] = vfn[i];
        {
            float cp = 1.f, kdf[16];
#pragma unroll
            for (int j = 0; j < 16; ++j) {
                const float z = bfhi(qz[j]);
                const float s = frcp(1.0f + fexp2(-LOG2E * z));
                const float f = lb + oml * s, kk = oml * (1.0f - s);
                cp *= f; kdf[j] = kk * frcp(cp);
                if (MODE == 1) {
                    const float q = bflo(qz[j]);
                    const unsigned qh = pk2(q * cp, 0.f), kd = pk2(kdf[j], 0.f);
                    *(LAS bf16_t*)(lds + HG_QH + (16 * si + j) * 272 + dk * 2) = (bf16_t)(qh & 0xffffu);
                    *(LAS bf16_t*)(lds + HG_KD + (16 * si + j) * 272 + dk * 2) = (bf16_t)(kd & 0xffffu);
                }
            }
            if (c4 < 3) {
                const bf16_t* sb = PROJ + ((size_t)b * SEQ + tc + 64) * 2048 + h * 256;
#pragma unroll
                for (int j = 0; j < 16; ++j) qz[j] = *(const unsigned*)(sb + (size_t)j * 2048 + rlo);
                const bf16_t* vp = IT + (size_t)(h * 128 + 16 * wave + c16) * T + (size_t)b * SEQ + tc + 64 + 4 * g;
#pragma unroll
                for (int i = 0; i < 4; ++i) vfn[i] = *(const u32x2*)(vp + 16 * i);
            }
            const float dl = cp; lsum *= dl;
            u32x4 w0, w1;
            w0.x = pk2(kdf[0] * dl, kdf[1] * dl); w0.y = pk2(kdf[2] * dl, kdf[3] * dl); w0.z = pk2(kdf[4] * dl, kdf[5] * dl); w0.w = pk2(kdf[6] * dl, kdf[7] * dl);
            w1.x = pk2(kdf[8] * dl, kdf[9] * dl); w1.y = pk2(kdf[10] * dl, kdf[11] * dl); w1.z = pk2(kdf[12] * dl, kdf[13] * dl); w1.w = pk2(kdf[14] * dl, kdf[15] * dl);
            *(LAS u32x4*)(lds + HG_KUT + dk * 144 + si * 32) = w0;
            *(LAS u32x4*)(lds + HG_KUT + dk * 144 + si * 32 + 16) = w1;
            *(LAS float*)(lds + HG_DD + (si * 128 + dk) * 4) = dl;
        }
        LDS_BARRIER();
#pragma unroll
        for (int i = 0; i < 4; ++i) {
            bf16x8 vb; { const s16x4 t4 = __builtin_bit_cast(s16x4, vf[i]); vb = (bf16x8){t4[0], t4[1], t4[2], t4[3], 0, 0, 0, 0}; }
            if (MODE == 1) {
                f32x4 X = (f32x4){0.f, 0.f, 0.f, 0.f};
#pragma unroll
                for (int m = 0; m < 4; ++m) {
                    const bf16x8 a = *(const LAS bf16x8*)(lds + HG_KD + (16 * i + c16) * 272 + (32 * m + 8 * g) * 2);
                    const bf16x8 bq = *(const LAS bf16x8*)(lds + HG_QH + (16 * i + c16) * 272 + (32 * m + 8 * g) * 2);
                    X = __builtin_amdgcn_mfma_f32_16x16x32_bf16(a, bq, X, 0, 0, 0);
                }
#pragma unroll
                for (int r = 0; r < 4; ++r) X[r] = (4 * g + r <= c16) ? X[r] : 0.f;
                bf16x8 xa; { u32x2 p; p.x = pk2(X[0], X[1]); p.y = pk2(X[2], X[3]); const s16x4 t4 = __builtin_bit_cast(s16x4, p); xa = (bf16x8){t4[0], t4[1], t4[2], t4[3], 0, 0, 0, 0}; }
                f32x4 O = (f32x4){0.f, 0.f, 0.f, 0.f};
                O = __builtin_amdgcn_mfma_f32_16x16x32_bf16(xa, vb, O, 0, 0, 0);
#pragma unroll
                for (int m = 0; m < 4; ++m) {
                    u32x4 bs; bs.x = pk2(S[2 * m][0], S[2 * m][1]); bs.y = pk2(S[2 * m][2], S[2 * m][3]); bs.z = pk2(S[2 * m + 1][0], S[2 * m + 1][1]); bs.w = pk2(S[2 * m + 1][2], S[2 * m + 1][3]);
                    const u32x2 q0 = *(const LAS u32x2*)(lds + HG_QH + (16 * i + c16) * 272 + (32 * m + 4 * g) * 2);
                    const u32x2 q1 = *(const LAS u32x2*)(lds + HG_QH + (16 * i + c16) * 272 + (32 * m + 16 + 4 * g) * 2);
                    u32x4 aq; aq.x = q0.x; aq.y = q0.y; aq.z = q1.x; aq.w = q1.y;
                    O = __builtin_amdgcn_mfma_f32_16x16x32_bf16(__builtin_bit_cast(bf16x8, aq), __builtin_bit_cast(bf16x8, bs), O, 0, 0, 0);
                }
#pragma unroll
                for (int r = 0; r < 4; ++r) *(LAS float*)(lds + HG_OB + ((16 * i + 4 * g + r) * 132 + 16 * wave + c16) * 4) = O[r];
            }
#pragma unroll
            for (int tau = 0; tau < 8; ++tau) {
                const f32x4 dd = *(const LAS f32x4*)(lds + HG_DD + (i * 128 + 16 * tau + 4 * g) * 4);
                S[tau] = S[tau] * dd;
                const u32x2 k2 = *(const LAS u32x2*)(lds + HG_KUT + (16 * tau + c16) * 144 + (16 * i + 4 * g) * 2);
                u32x4 ak; ak.x = k2.x; ak.y = k2.y; ak.z = 0u; ak.w = 0u;
                S[tau] = __builtin_amdgcn_mfma_f32_16x16x32_bf16(__builtin_bit_cast(bf16x8, ak), vb, S[tau], 0, 0, 0);
            }
        }
        if (MODE == 1) asm volatile("s_waitcnt vmcnt(0)" ::: "memory");
        LDS_BARRIER();
        if (MODE == 1) {
            const int tl = tid >> 3, part = tid & 7;
            float o[16]; float ssq = 0.f;
#pragma unroll
            for (int q4 = 0; q4 < 4; ++q4) { const f32x4 v = *(const LAS f32x4*)(lds + HG_OB + (tl * 132 + 16 * part + 4 * q4) * 4);
                o[4 * q4] = v.x; o[4 * q4 + 1] = v.y; o[4 * q4 + 2] = v.z; o[4 * q4 + 3] = v.w; ssq += (v.x * v.x + v.y * v.y) + (v.z * v.z + v.w * v.w); }
            ssq += __shfl_xor(ssq, 1); ssq += __shfl_xor(ssq, 2); ssq += __shfl_xor(ssq, 4);
            const float rr = 1.0f / sqrtf(ssq * (1.0f / 128.0f) + RMS_EPS);
            const size_t row = (size_t)b * SEQ + tc + tl;
            const u32x4 g0 = *(const LAS u32x4*)(lds + HG_G + tl * 256 + part * 32), g1 = *(const LAS u32x4*)(lds + HG_G + tl * 256 + part * 32 + 16);
            float gv[16];
            gv[0] = bflo(g0.x); gv[1] = bfhi(g0.x); gv[2] = bflo(g0.y); gv[3] = bfhi(g0.y); gv[4] = bflo(g0.z); gv[5] = bfhi(g0.z); gv[6] = bflo(g0.w); gv[7] = bfhi(g0.w);
            gv[8] = bflo(g1.x); gv[9] = bfhi(g1.x); gv[10] = bflo(g1.y); gv[11] = bfhi(g1.y); gv[12] = bflo(g1.z); gv[13] = bfhi(g1.z); gv[14] = bflo(g1.w); gv[15] = bfhi(g1.w);
            float r16[16];
#pragma unroll
            for (int j = 0; j < 16; ++j) { const float gg = gv[j]; const float sg = gg * frcp(1.0f + fexp2(-LOG2E * gg)); r16[j] = o[j] * rr * anw[16 * part + j] * sg; }
            u32x4 o0, o1;
            o0.x = pk2(r16[0], r16[1]); o0.y = pk2(r16[2], r16[3]); o0.z = pk2(r16[4], r16[5]); o0.w = pk2(r16[6], r16[7]);
            o1.x = pk2(r16[8], r16[9]); o1.y = pk2(r16[10], r16[11]); o1.z = pk2(r16[12], r16[13]); o1.w = pk2(r16[14], r16[15]);
            *(u32x4*)(AO + row * 1024 + h * 128 + 16 * part) = o0; *(u32x4*)(AO + row * 1024 + h * 128 + 16 * part + 8) = o1;
        }
    }
    if (MODE == 0) {
#pragma unroll
        for (int tau = 0; tau < 8; ++tau)
#pragma unroll
            for (int r = 0; r < 4; ++r) SLOC[(size_t)unit * 16384 + (16 * tau + 4 * g + r) * 128 + 16 * wave + c16] = S[tau][r];
        *(LAS float*)(lds + HG_RED + (si * 128 + dk) * 4) = lsum;
        __syncthreads();
        if (tid < 128) { const float tot = (*(LAS float*)(lds + HG_RED + tid * 4) * *(LAS float*)(lds + HG_RED + (128 + tid) * 4)) * (*(LAS float*)(lds + HG_RED + (256 + tid) * 4) * *(LAS float*)(lds + HG_RED + (384 + tid) * 4));
            DTOT[(size_t)unit * 128 + tid] = tot; }
    }
    __syncthreads();
}

template <int W>
__device__ __forceinline__ void pool_lane(int b, int tb, int ch, const bf16_t* PROJ, bf16_t* AO) {
    const bf16_t* xp = PROJ + (size_t)b * SEQ * 2048 + 1536 + ch;
    u32x4 cur[8], prev[W - 1];
#pragma unroll
    for (int j = 0; j < 8; ++j) cur[j] = *(const u32x4*)(xp + (size_t)(tb + j) * 2048);
#pragma unroll
    for (int r = 1; r < W; ++r) { prev[r - 1] = (u32x4){0u, 0u, 0u, 0u}; if (tb - r >= 0) prev[r - 1] = *(const u32x4*)(xp + (size_t)(tb - r) * 2048); }
#define POOL_ACC(op_, v_) do { s[0] op_ bflo((v_).x); s[1] op_ bfhi((v_).x); s[2] op_ bflo((v_).y); s[3] op_ bfhi((v_).y); s[4] op_ bflo((v_).z); s[5] op_ bfhi((v_).z); s[6] op_ bflo((v_).w); s[7] op_ bfhi((v_).w); } while (0)
    float s[8];
#pragma unroll
    for (int c = 0; c < 8; ++c) s[c] = 0.f;
#pragma unroll
    for (int r = 1; r < W; ++r) POOL_ACC(+=, prev[r - 1]);
#pragma unroll
    for (int j = 0; j < 8; ++j) {
        const int t = tb + j; const u32x4 v = cur[j];
        float x[8]; x[0] = bflo(v.x); x[1] = bfhi(v.x); x[2] = bflo(v.y); x[3] = bfhi(v.y); x[4] = bflo(v.z); x[5] = bfhi(v.z); x[6] = bflo(v.w); x[7] = bfhi(v.w);
        const float cnt = (float)((t + 1) < W ? (t + 1) : W);
        float o[8];
#pragma unroll
        for (int c = 0; c < 8; ++c) { s[c] += x[c]; o[c] = s[c] / cnt - x[c]; }
        u32x4 w; w.x = pk2(o[0], o[1]); w.y = pk2(o[2], o[3]); w.z = pk2(o[4], o[5]); w.w = pk2(o[6], o[7]);
        *(u32x4*)(AO + ((size_t)b * SEQ + t) * 1024 + 512 + ch) = w;
        if (j - W + 1 >= 0) POOL_ACC(-=, cur[j - W + 1 >= 0 ? j - W + 1 : 0]); else POOL_ACC(-=, prev[W - 2 - j >= 0 ? W - 2 - j : 0]);
    }
#undef POOL_ACC
}
__device__ __forceinline__ void pool_task(int task, const bf16_t* PROJ, bf16_t* AO, int wave, int lane) {
    const int b = task >> 6, blk = task & 63;
    const int grp = wave & 3, ch = grp * 128 + (lane & 15) * 8;
#pragma unroll 1
    for (int p = 0; p < 2; ++p) { const int tb = blk * 128 + (wave >> 2) * 64 + p * 32 + (lane >> 4) * 8;
        if (grp == 0) pool_lane<2>(b, tb, ch, PROJ, AO); else if (grp == 1) pool_lane<4>(b, tb, ch, PROJ, AO); else if (grp == 2) pool_lane<8>(b, tb, ch, PROJ, AO); else pool_lane<16>(b, tb, ch, PROJ, AO); }
}

constexpr int RT_YS = 1028;
constexpr int RT_Y = 0, RT_PART = 66048, RT_LOG = 82432, RT_SELE = 99328, RT_SELG = 101376, RT_SELR = 103424, RT_HIST = 105472, RT_BASE = 105600, RT_LNW = 105728;
__device__ __forceinline__ void wave_sum4(float& a, float& b, float& c, float& d) {
#pragma unroll
    for (int o = 1; o < 64; o <<= 1) { const float ta = __shfl_xor(a, o), tb = __shfl_xor(b, o), tc = __shfl_xor(c, o), td = __shfl_xor(d, o); a += ta; b += tb; c += tc; d += td; }
}
__device__ __forceinline__ void split_hl(const float (&x)[8], u32x4& hi, u32x4& lo) {
    unsigned h[4], l[4];
#pragma unroll
    for (int i = 0; i < 4; ++i) { h[i] = pk2(x[2 * i], x[2 * i + 1]); l[i] = pk2(x[2 * i] - bflo(h[i]), x[2 * i + 1] - bfhi(h[i])); }
    hi = (u32x4){h[0], h[1], h[2], h[3]}; lo = (u32x4){l[0], l[1], l[2], l[3]};
}
__device__ __forceinline__ void router_load_w(const float* wr, u32x4 (&wreg)[16], int wave, int lane) {
    const float* wp = wr + (size_t)(128 * wave + 8 * (lane >> 4)) * 32 + (lane & 15);
#pragma unroll
    for (int kk = 0; kk < 4; ++kk)
#pragma unroll
        for (int tl = 0; tl < 2; ++tl) { float x[8];
#pragma unroll
            for (int j = 0; j < 8; ++j) x[j] = wp[(32 * kk + j) * 32 + 16 * tl];
            split_hl(x, wreg[(kk * 2 + tl) * 2], wreg[(kk * 2 + tl) * 2 + 1]); }
}
template <bool XF32>
__device__ __forceinline__ void router_block(LAS unsigned char* lds, int blk, const float* X32, const bf16_t* XB, bf16_t* XBo, unsigned char* XB8, const bf16_t* H, const float* lnw, const float* lnb,
                                             const u32x4 (&wreg)[16], const float* br, unsigned* cnt, int* tokl, float* gatel, int* tinfo, int tid, int wave, int lane) {
    const int c16 = lane & 15, g = lane >> 4;
    if (tid < 32) *(LAS unsigned*)(lds + RT_HIST + tid * 4) = 0u;
    u32x2 hq[2][4]; f32x4 xq[2][4]; u32x2 xh[2][4];
#pragma unroll
    for (int j = 0; j < 4; ++j) {
#pragma unroll
        for (int k = 0; k < 2; ++k) { hq[k][j] = (u32x2){0u, 0u}; xh[k][j] = (u32x2){0u, 0u}; xq[k][j] = (f32x4){0.f, 0.f, 0.f, 0.f}; } }
    const unsigned lo4 = 4u * (unsigned)lane;
#define RT_LOAD(bt_) do { _Pragma("unroll") for (int k = 0; k < 2; ++k) { const size_t t_ = (size_t)blk * 128 + 16 * (bt_) + 2 * wave + k; \
        const bf16_t* hb_ = H + t_ * 1024 + lo4; const float* xb_ = X32 + t_ * 1024 + lo4; const bf16_t* xh_ = XB + t_ * 1024 + lo4; _Pragma("unroll") for (int j = 0; j < 4; ++j) { \
        LDPIN8(hq[k][j], hb_ + 256 * j); \
        if constexpr (XF32) LDPIN16(xq[k][j], xb_ + 256 * j); else LDPIN8(xh[k][j], xh_ + 256 * j); } } } while (0)
#define RT_PINROWS "+v"(hq[0][0]), "+v"(hq[0][1]), "+v"(hq[0][2]), "+v"(hq[0][3]), "+v"(hq[1][0]), "+v"(hq[1][1]), "+v"(hq[1][2]), "+v"(hq[1][3])
    { const f32x4 w4 = *(const f32x4*)(lnw + 4 * (tid & 255)), b4 = *(const f32x4*)(lnb + 4 * (tid & 255)); if (tid < 256) *(LAS f32x4*)(lds + RT_LNW + 16 * tid) = w4; else *(LAS f32x4*)(lds + RT_LNW + 4096 + 16 * (tid - 256)) = b4; }
    RT_LOAD(0);
    LDS_BARRIER();
#pragma unroll 1
    for (int bt = 0; bt < 8; ++bt) {
        if constexpr (XF32) asm volatile("s_waitcnt vmcnt(0)" : RT_PINROWS, "+v"(xq[0][0]), "+v"(xq[0][1]), "+v"(xq[0][2]), "+v"(xq[0][3]), "+v"(xq[1][0]), "+v"(xq[1][1]), "+v"(xq[1][2]), "+v"(xq[1][3]) :: "memory");
        else asm volatile("s_waitcnt vmcnt(0)" : RT_PINROWS, "+v"(xh[0][0]), "+v"(xh[0][1]), "+v"(xh[0][2]), "+v"(xh[0][3]), "+v"(xh[1][0]), "+v"(xh[1][1]), "+v"(xh[1][2]), "+v"(xh[1][3]) :: "memory");
#define RT_V(k_, j_) ((XF32 ? xq[k_][j_] : (f32x4){bflo(xh[k_][j_].x), bfhi(xh[k_][j_].x), bflo(xh[k_][j_].y), bfhi(xh[k_][j_].y)}) * ALPHA + (f32x4){bflo(hq[k_][j_].x), bfhi(hq[k_][j_].x), bflo(hq[k_][j_].y), bfhi(hq[k_][j_].y)})
        float s1[2], s2[2];
#pragma unroll
        for (int k = 0; k < 2; ++k) { s1[k] = 0.f; s2[k] = 0.f;
#pragma unroll
            for (int j = 0; j < 4; ++j) { const f32x4 t4 = RT_V(k, j); s1[k] += (t4.x + t4.y) + (t4.z + t4.w); s2[k] += (t4.x * t4.x + t4.y * t4.y) + (t4.z * t4.z + t4.w * t4.w); } }
        wave_sum4(s1[0], s2[0], s1[1], s2[1]);
#pragma unroll
        for (int k = 0; k < 2; ++k) {
            const int tl = 2 * wave + k; const size_t t = (size_t)blk * 128 + 16 * bt + tl;
            const float mean = s1[k] * (1.f / D); const float var = fmaxf(s2[k] * (1.f / D) - mean * mean, 0.f); const float rstd = 1.f / sqrtf(var + LN_EPS);
            bf16_t* xo_ = XBo + t * 1024; unsigned char* x8_ = XB8 + t * 1024;
#pragma unroll
            for (int j = 0; j < 4; ++j) { const f32x4 ww = *(const LAS f32x4*)(lds + RT_LNW + (256 * j + lo4) * 4), bb = *(const LAS f32x4*)(lds + RT_LNW + 4096 + (256 * j + lo4) * 4);
                const f32x4 y = (RT_V(k, j) - mean) * rstd * ww + bb;
                u32x2 o; o.x = pk2(y.x, y.y); o.y = pk2(y.z, y.w); *(u32x2*)(xo_ + 256 * j + lo4) = o;
                *(unsigned*)(x8_ + 256 * j + lo4) = pk4_fp8(y.x, y.y, y.z, y.w);
                *(LAS f32x4*)(lds + RT_Y + (tl * RT_YS + 4 * lane + 256 * j) * 4) = y; }
        }
#undef RT_V
        if constexpr (XF32) asm volatile("" : RT_PINROWS, "+v"(xq[0][0]), "+v"(xq[0][1]), "+v"(xq[0][2]), "+v"(xq[0][3]), "+v"(xq[1][0]), "+v"(xq[1][1]), "+v"(xq[1][2]), "+v"(xq[1][3]) :: "memory");
        else asm volatile("" : RT_PINROWS, "+v"(xh[0][0]), "+v"(xh[0][1]), "+v"(xh[0][2]), "+v"(xh[0][3]), "+v"(xh[1][0]), "+v"(xh[1][1]), "+v"(xh[1][2]), "+v"(xh[1][3]) :: "memory");
        if (bt < 7) RT_LOAD(bt + 1);
        LDS_BARRIER();
        {
            f32x4 a0 = (f32x4){0.f, 0.f, 0.f, 0.f}, a1 = a0;
            const LAS float* yp = (const LAS float*)(lds + RT_Y) + c16 * RT_YS + 128 * wave + 8 * g; asm volatile("" : "+v"(yp));
#pragma unroll
            for (int kk = 0; kk < 4; ++kk) {
                const f32x4 ya = *(const LAS f32x4*)(yp + 32 * kk), yb = *(const LAS f32x4*)(yp + 32 * kk + 4);
                const float x[8] = {ya.x, ya.y, ya.z, ya.w, yb.x, yb.y, yb.z, yb.w};
                u32x4 yh, yl; split_hl(x, yh, yl);
                const bf16x8 ah = __builtin_bit_cast(bf16x8, yh), al = __builtin_bit_cast(bf16x8, yl);
#pragma unroll
                for (int tl = 0; tl < 2; ++tl) { const bf16x8 wh = __builtin_bit_cast(bf16x8, wreg[(kk * 2 + tl) * 2]), wl = __builtin_bit_cast(bf16x8, wreg[(kk * 2 + tl) * 2 + 1]);
                    f32x4 acc = tl ? a1 : a0;
                    acc = __builtin_amdgcn_mfma_f32_16x16x32_bf16(al, wh, acc, 0, 0, 0); acc = __builtin_amdgcn_mfma_f32_16x16x32_bf16(ah, wl, acc, 0, 0, 0); acc = __builtin_amdgcn_mfma_f32_16x16x32_bf16(ah, wh, acc, 0, 0, 0);
                    if (tl) a1 = acc; else a0 = acc; }
            }
            LAS float* pp = (LAS float*)(lds + RT_PART) + (wave * 16 + 4 * g) * 32 + c16;
#pragma unroll
            for (int r = 0; r < 4; ++r) { pp[r * 32] = a0[r]; pp[r * 32 + 16] = a1[r]; }
        }
        LDS_BARRIER();
        {
            const int tk = tid >> 5, e = tid & 31;
            float lg = br[e];
            const LAS float* pp = (const LAS float*)(lds + RT_PART) + tk * 32 + e; asm volatile("" : "+v"(pp));
#pragma unroll
            for (int w = 0; w < 8; ++w) lg += pp[w * 512];
            *(LAS float*)(lds + RT_LOG + ((16 * bt + tk) * 33 + e) * 4) = lg;
        }
    }
#undef RT_LOAD
#undef RT_PINROWS
    LDS_BARRIER();
    if (tid < 128) {
        const LAS float* lp = (const LAS float*)(lds + RT_LOG) + tid * 33;
        float v0 = -INFINITY, v1 = -INFINITY, v2 = -INFINITY, v3 = -INFINITY; int i0 = 0, i1 = 0, i2 = 0, i3 = 0;
#pragma unroll
        for (int e = 0; e < 32; ++e) { const float x = lp[e];
            const bool g0 = x > v0, g1 = x > v1, g2 = x > v2, g3 = x > v3;
            v3 = g2 ? v2 : (g3 ? x : v3); i3 = g2 ? i2 : (g3 ? e : i3);
            v2 = g1 ? v1 : (g2 ? x : v2); i2 = g1 ? i1 : (g2 ? e : i2);
            v1 = g0 ? v0 : (g1 ? x : v1); i1 = g0 ? i0 : (g1 ? e : i1);
            v0 = g0 ? x : v0; i0 = g0 ? e : i0; }
        const float e1 = __expf(v1 - v0), e2 = __expf(v2 - v0), e3 = __expf(v3 - v0);
        const float inv = 1.0f / (1.0f + e1 + e2 + e3);
        const int mi[4] = {i0, i1, i2, i3}; const float gt[4] = {inv, e1 * inv, e2 * inv, e3 * inv};
#pragma unroll
        for (int k = 0; k < 4; ++k) {
            const unsigned lr = __hip_atomic_fetch_add((LAS unsigned*)(lds + RT_HIST + mi[k] * 4), 1u, __ATOMIC_RELAXED, __HIP_MEMORY_SCOPE_WORKGROUP);
            const int sidx = tid * 4 + k;
            *(LAS int*)(lds + RT_SELE + sidx * 4) = mi[k]; *(LAS float*)(lds + RT_SELG + sidx * 4) = gt[k]; *(LAS unsigned*)(lds + RT_SELR + sidx * 4) = lr;
        }
    }
    LDS_BARRIER();
    if (tid < 32) { const unsigned hc = *(LAS unsigned*)(lds + RT_HIST + tid * 4);
        *(LAS unsigned*)(lds + RT_BASE + tid * 4) = __hip_atomic_fetch_add(cnt + tid, hc, __ATOMIC_RELAXED, __HIP_MEMORY_SCOPE_AGENT); }
    __syncthreads();
    {
        const int me = *(LAS int*)(lds + RT_SELE + tid * 4); const float gt = *(LAS float*)(lds + RT_SELG + tid * 4);
        const unsigned rank = *(LAS unsigned*)(lds + RT_BASE + me * 4) + *(LAS unsigned*)(lds + RT_SELR + tid * 4);
        const int tok = blk * 128 + (tid >> 2);
        tokl[(size_t)me * T + rank] = tok; gatel[(size_t)me * T + rank] = gt; tinfo[(size_t)tok * 4 + (tid & 3)] = (me << 16) | (int)rank;
    }
    __syncthreads();
}

__device__ __forceinline__ void combine_rows2(size_t t0, size_t t1, const unsigned char* Y, const int* tinfo, const LAS int* tab, const bf16_t* XB, bf16_t* XBo, float* OUT32, const f32x4 (&lw)[4], const f32x4 (&lb)[4], int lane) {
    f32x4 v[2][4]; float s1[2], s2[2];
#pragma unroll
    for (int k2 = 0; k2 < 2; ++k2) {
        const size_t t = k2 ? t1 : t0;
        const u32x4 x0 = *(const u32x4*)(XB + t * 1024 + 16 * lane), x1 = *(const u32x4*)(XB + t * 1024 + 16 * lane + 8);
        const u32x4 inf4 = *(const u32x4*)(tinfo + t * 4);
        v[k2][0] = (f32x4){bflo(x0.x), bfhi(x0.x), bflo(x0.y), bfhi(x0.y)} * ALPHA; v[k2][1] = (f32x4){bflo(x0.z), bfhi(x0.z), bflo(x0.w), bfhi(x0.w)} * ALPHA;
        v[k2][2] = (f32x4){bflo(x1.x), bfhi(x1.x), bflo(x1.y), bfhi(x1.y)} * ALPHA; v[k2][3] = (f32x4){bflo(x1.z), bfhi(x1.z), bflo(x1.w), bfhi(x1.w)} * ALPHA;
        u32x4 yy[4];
#pragma unroll
        for (int k = 0; k < 4; ++k) { const unsigned inf = k == 0 ? inf4.x : k == 1 ? inf4.y : k == 2 ? inf4.z : inf4.w; const int ee = (int)(inf >> 16), rk = (int)(inf & 0xffffu);
            const size_t slot = (size_t)tab[ee] * 256 + rk; yy[k] = *(const u32x4*)(Y + slot * 1024 + 16 * lane); }
#pragma unroll
        for (int k = 0; k < 4; ++k) {
#pragma unroll
            for (int j = 0; j < 4; ++j) { const int w = (int)(j == 0 ? yy[k].x : j == 1 ? yy[k].y : j == 2 ? yy[k].z : yy[k].w);
                const f32x2 lo2 = __builtin_amdgcn_cvt_pk_f32_fp8(w, false), hi2 = __builtin_amdgcn_cvt_pk_f32_fp8(w, true);
                v[k2][j] = v[k2][j] + (f32x4){lo2.x, lo2.y, hi2.x, hi2.y} * 0.0625f; } }
        float a = 0.f, q = 0.f;
#pragma unroll
        for (int j = 0; j < 4; ++j) { const f32x4 u = v[k2][j]; a += (u.x + u.y) + (u.z + u.w); q += (u.x * u.x + u.y * u.y) + (u.z * u.z + u.w * u.w); }
        s1[k2] = a; s2[k2] = q;
    }
    wave_sum4(s1[0], s2[0], s1[1], s2[1]);
#pragma unroll
    for (int k2 = 0; k2 < 2; ++k2) {
        const size_t t = k2 ? t1 : t0;
        const float mean = s1[k2] * (1.f / D); const float var = fmaxf(s2[k2] * (1.f / D) - mean * mean, 0.f); const float rstd = 1.f / sqrtf(var + LN_EPS);
        f32x4 y[4];
#pragma unroll
        for (int j = 0; j < 4; ++j) y[j] = (v[k2][j] - mean) * rstd * lw[j] + lb[j];
        if (OUT32) {
#pragma unroll
            for (int j = 0; j < 4; ++j) *(f32x4*)(OUT32 + t * 1024 + 16 * lane + 4 * j) = y[j];
        } else {
            u32x4 o0, o1; o0.x = pk2(y[0].x, y[0].y); o0.y = pk2(y[0].z, y[0].w); o0.z = pk2(y[1].x, y[1].y); o0.w = pk2(y[1].z, y[1].w);
            o1.x = pk2(y[2].x, y[2].y); o1.y = pk2(y[2].z, y[2].w); o1.z = pk2(y[3].x, y[3].y); o1.w = pk2(y[3].z, y[3].w);
            *(u32x4*)(XBo + t * 1024 + 16 * lane) = o0; *(u32x4*)(XBo + t * 1024 + 16 * lane + 8) = o1;
        }
    }
}

__device__ __forceinline__ int crow(int r, int hi) { return (r & 3) + 8 * (r >> 2) + 4 * hi; }
__device__ __forceinline__ void attn_phase(const bf16_t* QB, const bf16_t* KB, const bf16_t* VT, bf16_t* AO, int gw, int ngw, int lane) {
    const int r32 = lane & 31, hi = lane >> 5;
    for (int task = gw; task < BATCH * 16 * (SEQ / 32); task += ngw) {
        const int qt = task & 255, bh = task >> 8, b = bh >> 4, h = bh & 15;
        const size_t rowb = (size_t)b * SEQ; const int q0 = qt * 32;
        bf16x8 qf[4];
        { const bf16_t* qp = QB + (rowb + q0 + r32) * 1024 + h * 64 + hi * 8;
#pragma unroll
          for (int s = 0; s < 4; ++s) qf[s] = *(const bf16x8*)(qp + 16 * s); }
        f32x16 o0, o1;
#pragma unroll
        for (int r = 0; r < 16; ++r) { o0[r] = 0.f; o1[r] = 0.f; }
        float carry = 1.f;
        const bf16_t* kbase = KB + (size_t)bh * 256 * 4 * 64 * 8 + lane * 8;
        const bf16_t* vbase = VT + (size_t)bh * 256 * 4 * 64 * 8 + lane * 8;
        bf16x8 kn[4];
#pragma unroll
        for (int s = 0; s < 4; ++s) kn[s] = *(const bf16x8*)(kbase + (size_t)qt * 2048 + s * 512);
        for (int kt = qt; kt >= 0; --kt) {
            bf16x8 kf[4];
#pragma unroll
            for (int s = 0; s < 4; ++s) kf[s] = kn[s];
            bf16x8 va[2][2];
#pragma unroll
            for (int dt = 0; dt < 2; ++dt)
#pragma unroll
                for (int sp = 0; sp < 2; ++sp) va[dt][sp] = *(const bf16x8*)(vbase + (size_t)kt * 2048 + (dt * 2 + sp) * 512);
            { const int kp = kt > 0 ? kt - 1 : 0;
#pragma unroll
              for (int s = 0; s < 4; ++s) kn[s] = *(const bf16x8*)(kbase + (size_t)kp * 2048 + s * 512); }
            f32x16 st;
#pragma unroll
            for (int r = 0; r < 16; ++r) st[r] = 0.f;
#pragma unroll
            for (int s = 0; s < 4; ++s) st = __builtin_amdgcn_mfma_f32_32x32x16_bf16(kf[s], qf[s], st, 0, 0, 0);
            const bool diag = (kt == qt);
            float R[16], Bt[16];
#pragma unroll
            for (int r = 0; r < 16; r += 2) {
                const f32x2 e = (f32x2){fexp2(st[r]), fexp2(st[r + 1])};
                const f32x2 d = e + 1.0f;
                f32x2 rr = (f32x2){frcp(d.x), frcp(d.y)};
                if (diag) { rr.x = (crow(r, hi) < r32) ? rr.x : 1.0f; rr.y = (crow(r + 1, hi) < r32) ? rr.y : 1.0f; }
                const f32x2 bt = 1.0f - rr;
                R[r] = rr.x; R[r + 1] = rr.y; Bt[r] = bt.x; Bt[r + 1] = bt.y;
            }
            float own[4], pg[4];
#pragma unroll
            for (int rg = 0; rg < 4; ++rg) { own[rg] = (R[4 * rg] * R[4 * rg + 1]) * (R[4 * rg + 2] * R[4 * rg + 3]); pg[rg] = __shfl_xor(own[rg], 32); }
            float aft[4];
            { float run = 1.f;
#pragma unroll
              for (int rg = 3; rg >= 0; --rg) { aft[rg] = (hi == 0) ? run * pg[rg] : run; run *= own[rg] * pg[rg]; }
              float w[16];
#pragma unroll
              for (int rg = 0; rg < 4; ++rg) { float lat = carry * aft[rg];
#pragma unroll
                  for (int p = 3; p >= 0; --p) { w[4 * rg + p] = Bt[4 * rg + p] * lat; lat *= R[4 * rg + p]; } }
              carry *= run;
              u32x4 p0, p1;
              p0.x = pk2(w[0], w[1]); p0.y = pk2(w[2], w[3]); p0.z = pk2(w[4], w[5]); p0.w = pk2(w[6], w[7]);
              p1.x = pk2(w[8], w[9]); p1.y = pk2(w[10], w[11]); p1.z = pk2(w[12], w[13]); p1.w = pk2(w[14], w[15]);
              const bf16x8 pf0 = __builtin_bit_cast(bf16x8, p0), pf1 = __builtin_bit_cast(bf16x8, p1);
              o0 = __builtin_amdgcn_mfma_f32_32x32x16_bf16(va[0][0], pf0, o0, 0, 0, 0); o0 = __builtin_amdgcn_mfma_f32_32x32x16_bf16(va[0][1], pf1, o0, 0, 0, 0);
              o1 = __builtin_amdgcn_mfma_f32_32x32x16_bf16(va[1][0], pf0, o1, 0, 0, 0); o1 = __builtin_amdgcn_mfma_f32_32x32x16_bf16(va[1][1], pf1, o1, 0, 0, 0);
            }
            if (__all(carry < ATT_THR)) break;
        }
        bf16_t* op = AO + (rowb + q0 + r32) * 1024 + h * 64 + 4 * hi;
#pragma unroll
        for (int rg = 0; rg < 4; ++rg) {
            u32x2 w; w.x = pk2(o0[4 * rg], o0[4 * rg + 1]); w.y = pk2(o0[4 * rg + 2], o0[4 * rg + 3]); *(u32x2*)(op + 8 * rg) = w;
            w.x = pk2(o1[4 * rg], o1[4 * rg + 1]); w.y = pk2(o1[4 * rg + 2], o1[4 * rg + 3]); *(u32x2*)(op + 32 + 8 * rg) = w;
        }
    }
}

constexpr int NWAVES = 8;
constexpr int NPHASE = 17;
struct Args { const float* in[29]; float* out; unsigned char* ws; int ph_lo, ph_hi; };

#ifndef PH_MASK
#define PH_MASK 0xfff
#endif
#define EN(b) ((PH_MASK >> (b)) & 1)
#ifndef REP_MASK
#define REP_MASK 0
#endif
#define RP(b) ((REP_MASK >> (b)) & 1)
#define PHASE(b, k, ...) if (EN(b) && IN(k)) { PH_IDS; { __VA_ARGS__ } if (RP(b)) { __VA_ARGS__ } }
#define IN(k) (lo <= (k) && (k) < hi)
#if MK_PER_PHASE
#define SEAM(k) do { } while (0)
#else
#define SEAM(k) do { if (IN(k) && IN((k) + 1)) xcd_barrier(bar); } while (0)
#endif
#define PH_IDS const int lane = lane_id_asm(); const int wave = wave0; const int tid = wave * 64 + lane; const int G = gridDim.x, bx = blockIdx.x; const int gw = bx * NWAVES + wave, NGW = G * NWAVES; (void)tid; (void)lane; (void)gw; (void)NGW; (void)G; (void)bx
#define WSP(T_, off) ((T_*)(args.ws + (off)))

template <int LAYER>
__device__ __forceinline__ void layer_tail(const Args& args, LAS unsigned char* lds, const XcdBarrier& bar, int lo, int hi, const int wave0) {
    constexpr int PB = LAYER == 0 ? 5 : 12;
    LAS int* moetab = (LAS int*)(lds + MOETAB_OFF);
    LAS unsigned* rowtab = (LAS unsigned*)(lds + ROWTAB_OFF);
    PHASE(5, PB,
        pg8::Gemm g{WSP(bf16_t, WS_SB), WSP(bf16_t, LAYER ? WS_WO1T : WS_WO0T), 1024, 0}; pg8::StaticOrder S; S.init(T, 1024, G, bx); pg8::EpiPlain E{WSP(bf16_t, WS_SB + 64 * MiB), 1024, 0, 0, 1.f};
        pg8::gemm_phase<pg8::EpiPlain, pg8::StaticOrder, 0>(lds, g, S, E, nullptr, rowtab, tid);)
    SEAM(PB);
    if (RP(6) && EN(6) && IN(PB + 1)) { PH_IDS;
        unsigned* cnt = WSP(unsigned, WS_CTL) + CW_CNT + 128 + LAYER * 64;
        u32x4 wreg[16]; router_load_w(args.in[LAYER ? 21 : 9], wreg, wave, lane);
        for (int blk = bx; blk < T / 128; blk += G)
            router_block<LAYER == 0>(lds, blk, LAYER ? nullptr : args.in[0], WSP(bf16_t, WS_XB), WSP(bf16_t, WS_END), WSP(unsigned char, WS_END + 64 * MiB), WSP(bf16_t, WS_SB + 64 * MiB), args.in[LAYER ? 19 : 7], args.in[LAYER ? 20 : 8], wreg, args.in[LAYER ? 22 : 10],
                         cnt, WSP(int, WS_END + 96 * MiB), WSP(float, WS_END + 100 * MiB), WSP(int, WS_END + 104 * MiB), tid, wave, lane); }
    if (EN(6) && IN(PB + 1)) { PH_IDS;
        unsigned* cnt = WSP(unsigned, WS_CTL) + CW_CNT + LAYER * 64;
        u32x4 wreg[16]; router_load_w(args.in[LAYER ? 21 : 9], wreg, wave, lane);
        for (int blk = bx; blk < T / 128; blk += G)
            router_block<LAYER == 0>(lds, blk, LAYER ? nullptr : args.in[0], WSP(bf16_t, WS_XB), WSP(bf16_t, WS_XB), WSP(unsigned char, WS_XB8), WSP(bf16_t, WS_SB + 64 * MiB), args.in[LAYER ? 19 : 7], args.in[LAYER ? 20 : 8], wreg, args.in[LAYER ? 22 : 10],
                         cnt, WSP(int, WS_TOKL), WSP(float, WS_GATEL), WSP(int, WS_TINFO), tid, wave, lane); }
    SEAM(PB + 1);
    PHASE(7, PB + 2,
        moe_table(WSP(unsigned, WS_CTL) + CW_CNT + LAYER * 64, moetab, tid);
        pg8::Gemm g{WSP(bf16_t, WS_XB8), WSP(bf16_t, WS_W1T), 512, 2048}; pg8::MoeOrder S; S.init(moetab, 8, G, bx); pg8::EpiSwiglu8 E{WSP(unsigned char, WS_SA), args.in[LAYER ? 24 : 12]};
        pg8::gemm_phase<pg8::EpiSwiglu8, pg8::MoeOrder, 1, 127 - W1_SH>(lds, g, S, E, WSP(int, WS_TOKL), rowtab, tid);)
    SEAM(PB + 2);
    PHASE(8, PB + 3,
        moe_table(WSP(unsigned, WS_CTL) + CW_CNT + LAYER * 64, moetab, tid);
        pg8::Gemm g{WSP(bf16_t, WS_SA), WSP(bf16_t, WS_W2T), 512, 1024}; pg8::MoeOrder S; S.init(moetab, 4, G, bx); pg8::EpiDown8 E{WSP(unsigned char, WS_SB), args.in[LAYER ? 26 : 14], WSP(float, WS_GATEL)};
        pg8::gemm_phase<pg8::EpiDown8, pg8::MoeOrder, 2, 127 - W2_SH>(lds, g, S, E, nullptr, rowtab, tid);)
    SEAM(PB + 3);
    if (EN(9) && IN(PB + 4)) { PH_IDS;
        moe_table(WSP(unsigned, WS_CTL) + CW_CNT + LAYER * 64, moetab, tid);
        f32x4 lw[4], lb[4];
#pragma unroll
        for (int j = 0; j < 4; ++j) { lw[j] = *(const f32x4*)(args.in[LAYER ? 27 : 15] + 16 * lane + 4 * j); lb[j] = *(const f32x4*)(args.in[LAYER ? 28 : 16] + 16 * lane + 4 * j); }
        if (RP(9)) { for (int t = gw; t < T; t += 2 * NGW) combine_rows2((size_t)t, (size_t)(t + NGW), WSP(unsigned char, WS_SB), WSP(int, WS_TINFO), moetab, WSP(bf16_t, WS_XB), WSP(bf16_t, WS_END), LAYER ? (float*)WSP(float, WS_END) : nullptr, lw, lb, lane); }
        for (int t = gw; t < T; t += 2 * NGW) combine_rows2((size_t)t, (size_t)(t + NGW), WSP(unsigned char, WS_SB), WSP(int, WS_TINFO), moetab, WSP(bf16_t, WS_XB), WSP(bf16_t, WS_XB), LAYER ? args.out : nullptr, lw, lb, lane);
    }
    if (LAYER == 0) SEAM(PB + 4);
}

__global__ void __launch_bounds__(NWAVES * 64, 2) mk_fwd(Args args) {
    extern __shared__ __attribute__((aligned(16))) unsigned char lds_raw[];
    LAS unsigned char* lds = (LAS unsigned char*)lds_raw;
    volatile LAS unsigned* MISC = (volatile LAS unsigned*)(lds + MISC_OFF);
    LAS unsigned* rowtab = (LAS unsigned*)(lds + ROWTAB_OFF);
    if (threadIdx.x < 32) MISC[threadIdx.x] = 0u;
    __syncthreads();
    const int wave0 = __builtin_amdgcn_readfirstlane(threadIdx.x >> 6);
    XcdBarrier bar; bar.bar = WSP(unsigned, WS_CTL) + CW_BAR; bar.x = 0; bar.st = nullptr; bar.wave = wave0;
#if !MK_PER_PHASE
    bar = xcd_barrier_post(WSP(unsigned, WS_CTL) + CW_BAR, MISC + 8);
#endif
    const int lo = args.ph_lo, hi = args.ph_hi;

    PHASE(0, 0,
        const float* x_in = args.in[0]; const float* w_in0 = args.in[2]; const float* wpool = args.in[4]; const float* pscale = args.in[5]; const float* w_o0 = args.in[6];
        const float* w_in1 = args.in[17]; const float* w_o1 = args.in[18];
        bf16_t* WIN0T = WSP(bf16_t, WS_WIN0T); bf16_t* WO0T = WSP(bf16_t, WS_WO0T); bf16_t* WIN1T = WSP(bf16_t, WS_WIN1T); bf16_t* WO1T = WSP(bf16_t, WS_WO1T); bf16_t* XB = WSP(bf16_t, WS_XB);
        LAS float* scr = (LAS float*)(lds + wave * 16384);
        constexpr int I_IN0 = 16 * 80, I_O0 = 8 * 32, I_IN1 = 16 * 96, I_O1 = 16 * 32, NIT = I_IN0 + I_O0 + I_IN1 + I_O1;
        for (int it = gw; it < NIT; it += NGW) {
            int r = it;
            if (r < I_IN0) { const int kb = r / 80, nb = r % 80, n0 = 32 * nb;
                const int dr = n0 < 512 ? 2 * n0 : (n0 < 1024 ? 2 * (n0 - 512) + 1 : (n0 < 1536 ? n0 + 1024 : n0 - 512));
                transpose_item(w_in0, 2560, WIN0T, 1024, 64 * kb, n0, dr, scr, lane, n0 < 1024 ? 2 : 1); continue; } r -= I_IN0;
            if (r < I_O0) { const int kb = r / 32, nb = r % 32; transpose_item(w_o0, 1024, WO0T, 1024, 64 * kb, 32 * nb, 32 * nb, scr, lane); continue; } r -= I_O0;
            if (r < I_IN1) { const int kb = r / 96, nb = r % 96; transpose_item(w_in1, 3072, WIN1T, 1024, 64 * kb, 32 * nb, 32 * nb, scr, lane); continue; } r -= I_IN1;
            { const int kb = r / 32, nb = r % 32; transpose_item(w_o1, 1024, WO1T, 1024, 64 * kb, 32 * nb, 32 * nb, scr, lane); }
        }
        for (int idx = bx * 512 + tid; idx < 512 * 1024; idx += G * 512) {
            const int n = idx & 1023, gc = idx >> 10, gg = gc >> 7;
            const float* wp = wpool + (size_t)gc * 128; const float* ps = pscale + 128 * gg; const float* wo = w_o0 + (size_t)(512 + 128 * gg) * 1024 + n;
            float a = 0.f;
_Pragma("unroll 8")
            for (int d = 0; d < 128; ++d) a += wp[d] * ps[d] * wo[(size_t)d * 1024];
            WO0T[(size_t)n * 1024 + 512 + gc] = (bf16_t)(pk2(a, 0.f) & 0xffffu);
        }
        { const size_t nv = (size_t)T * D / 8, st = (size_t)G * 512;
          size_t i = (size_t)bx * 512 + tid;
          for (; i + 3 * st < nv; i += 4 * st) {
              f32x4 a[4], c[4];
_Pragma("unroll")
              for (int q = 0; q < 4; ++q) { a[q] = __builtin_nontemporal_load((const f32x4*)(x_in + (i + q * st) * 8)); c[q] = __builtin_nontemporal_load((const f32x4*)(x_in + (i + q * st) * 8 + 4)); }
_Pragma("unroll")
              for (int q = 0; q < 4; ++q) { u32x4 o; o.x = pk2(a[q].x, a[q].y); o.y = pk2(a[q].z, a[q].w); o.z = pk2(c[q].x, c[q].y); o.w = pk2(c[q].z, c[q].w); *(u32x4*)(XB + (i + q * st) * 8) = o; }
          }
          for (; i < nv; i += st) { const f32x4 a = *(const f32x4*)(x_in + i * 8), c = *(const f32x4*)(x_in + i * 8 + 4);
              u32x4 o; o.x = pk2(a.x, a.y); o.y = pk2(a.z, a.w); o.z = pk2(c.x, c.y); o.w = pk2(c.z, c.w); *(u32x4*)(XB + i * 8) = o; }
        })
    SEAM(0);
    PHASE(1, 1,
        { pg8::Gemm g{WSP(bf16_t, WS_XB), WSP(bf16_t, WS_WIN0T), 1024, 0}; pg8::StaticOrder S; S.init(T, 2048, G, bx); pg8::EpiPlain E{WSP(bf16_t, WS_SA), 2048, 0, 0, 1.f};
          pg8::gemm_phase<pg8::EpiPlain, pg8::StaticOrder, 0>(lds, g, S, E, nullptr, rowtab, tid); }
        { pg8::Gemm g{WSP(bf16_t, WS_WIN0T) + (size_t)2048 * 1024, WSP(bf16_t, WS_XB), 1024, 0}; pg8::StaticOrder S; S.init(512, T, G, bx); pg8::EpiPlain E{WSP(bf16_t, WS_SA + 128 * MiB), T, 0, 0, 1.f};
          pg8::gemm_phase<pg8::EpiPlain, pg8::StaticOrder, 0>(lds, g, S, E, nullptr, rowtab, tid); })
    SEAM(1);
#define HG_UNIT0(u_) hgrn_unit<0>(lds, u_, WSP(bf16_t, WS_SA), WSP(bf16_t, WS_SA + 128 * MiB), WSP(float, WS_SB + 128 * MiB), WSP(float, WS_SB + 160 * MiB), args.in[1], args.in[3], WSP(bf16_t, WS_SB), tid, wave, lane)
#define HG_UNIT1(u_) hgrn_unit<1>(lds, u_, WSP(bf16_t, WS_SA), WSP(bf16_t, WS_SA + 128 * MiB), WSP(float, WS_SB + 128 * MiB), WSP(float, WS_SB + 160 * MiB), args.in[1], args.in[3], WSP(bf16_t, WS_SB), tid, wave, lane)
#define CONV0(q0_, q1_) conv_moe_wg(args.in[11], args.in[13], WSP(unsigned char, WS_W1T), WSP(unsigned char, WS_W2T), (LAS float*)lds, bx, G, tid, (q0_) * cq, (q1_) * cq)
    PHASE(2, 2,
        const bool cfirst = (bx & 1) != 0; const int cq = ((NE * 192 + G - 1) / G + 3) / 4;
        if (cfirst) CONV0(0, 1);
        if (bx < 512) HG_UNIT0(bx);
        if (cfirst) CONV0(1, 2); else CONV0(0, 1);
        for (int u = bx + G; u < 512; u += G) HG_UNIT0(u);
        if (!cfirst) CONV0(1, 2);
        for (int task = bx; task < 256; task += G) pool_task(task, WSP(bf16_t, WS_SA), WSP(bf16_t, WS_SB), wave, lane);)
    SEAM(2);
    PHASE(3, 3,
        float* SLOC = WSP(float, WS_SB + 128 * MiB); const float* DTOT = WSP(float, WS_SB + 160 * MiB);
        for (int ch = bx * 512 + tid; ch < 16 * 16384; ch += G * 512) {
            const int bh = ch >> 14, el = ch & 16383, dk = el >> 7;
            float* sp = SLOC + (size_t)bh * 32 * 16384 + el; const float* dp = DTOT + (size_t)bh * 32 * 128 + dk;
            float loc[32], dd[32];
_Pragma("unroll")
            for (int sc = 0; sc < 32; ++sc) { loc[sc] = sp[(size_t)sc * 16384]; dd[sc] = dp[sc * 128]; }
            float S = 0.f;
_Pragma("unroll")
            for (int sc = 0; sc < 32; ++sc) { sp[(size_t)sc * 16384] = S; S = dd[sc] * S + loc[sc]; }
        })
    SEAM(3);
    PHASE(4, 4,
        const bool cfirst = (bx & 1) != 0; const int cq = ((NE * 192 + G - 1) / G + 3) / 4;
        if (cfirst) CONV0(2, 3);
        if (bx < 512) HG_UNIT1(bx);
        if (cfirst) CONV0(3, 4); else CONV0(2, 3);
        for (int u = bx + G; u < 512; u += G) HG_UNIT1(u);
        if (!cfirst) CONV0(3, 4);
        )
#undef CONV0
#undef HG_UNIT0
#undef HG_UNIT1
    SEAM(4);
    layer_tail<0>(args, lds, bar, lo, hi, wave0);
    PHASE(10, 10,
        { pg8::Gemm g{WSP(bf16_t, WS_XB), WSP(bf16_t, WS_WIN1T), 1024, 0}; pg8::StaticOrder S; S.init(T, 2048, G, bx); pg8::EpiQK E{WSP(bf16_t, WS_SA), WSP(bf16_t, WS_SA + 64 * MiB), QSCALE};
          pg8::gemm_phase<pg8::EpiQK, pg8::StaticOrder, 0>(lds, g, S, E, nullptr, rowtab, tid); }
        { pg8::Gemm g{WSP(bf16_t, WS_WIN1T) + (size_t)2048 * 1024, WSP(bf16_t, WS_XB), 1024, 0}; pg8::StaticOrder S; S.init(1024, T, G, bx); pg8::EpiVF E{WSP(bf16_t, WS_SA + 128 * MiB)};
          pg8::gemm_phase<pg8::EpiVF, pg8::StaticOrder, 0>(lds, g, S, E, nullptr, rowtab, tid); })
    SEAM(10);
    PHASE(11, 11,
        const bool cfirst = (bx & 1) != 0;
        if (cfirst) conv_moe_wg(args.in[23], args.in[25], WSP(unsigned char, WS_W1T), WSP(unsigned char, WS_W2T), (LAS float*)lds, bx, G, tid, 0, (NE * 192 + G - 1) / G);
        attn_phase(WSP(bf16_t, WS_SA), WSP(bf16_t, WS_SA + 64 * MiB), WSP(bf16_t, WS_SA + 128 * MiB), WSP(bf16_t, WS_SB), gw, NGW, lane);
        if (!cfirst) conv_moe_wg(args.in[23], args.in[25], WSP(unsigned char, WS_W1T), WSP(unsigned char, WS_W2T), (LAS float*)lds, bx, G, tid, 0, (NE * 192 + G - 1) / G);)
    SEAM(11);
    layer_tail<1>(args, lds, bar, lo, hi, wave0);
}
#undef IN
#undef SEAM

extern "C" void kernel_launch(void* const* d_in, const int* in_sizes, int n_in, void* d_out, int out_size, void* d_ws, size_t ws_size, hipStream_t stream) {
    static int grid = 0;
    if (grid == 0) {
        if (n_in != 29 || in_sizes[0] != T * D || out_size != T * D || ws_size < WS_END) { fprintf(stderr, "kernel_launch: unexpected shapes (n_in %d, in0 %d, out %d, ws %zu)\n", n_in, n_in > 0 ? in_sizes[0] : -1, out_size, ws_size); grid = -1; return; }
        int dev = 0, cus = 0, per_cu = 0;
        if (hipGetDevice(&dev) != hipSuccess || hipDeviceGetAttribute(&cus, hipDeviceAttributeMultiprocessorCount, dev) != hipSuccess) { grid = -1; return; }
        if (hipFuncSetAttribute((const void*)mk_fwd, hipFuncAttributeMaxDynamicSharedMemorySize, LDS_BYTES) != hipSuccess) { fprintf(stderr, "kernel_launch: hipFuncSetAttribute failed\n"); grid = -1; return; }
        if (hipOccupancyMaxActiveBlocksPerMultiprocessor(&per_cu, (const void*)mk_fwd, NWAVES * 64, LDS_BYTES) != hipSuccess || per_cu < 1) { fprintf(stderr, "kernel_launch: occupancy query says %d\n", per_cu); }
        (void)hipGetLastError();
        grid = cus;
    }
    if (grid < 0) return;
    if (hipMemsetAsync((char*)d_ws + WS_CTL, 0, CTL_ZERO_BYTES, stream) != hipSuccess) return;
    Args a{};
    for (int i = 0; i < 29; ++i) a.in[i] = (const float*)d_in[i];
    a.out = (float*)d_out; a.ws = (unsigned char*)d_ws;
#if MK_PER_PHASE
    for (int p = 0; p < NPHASE; ++p) { a.ph_lo = p; a.ph_hi = p + 1; hipLaunchKernelGGL(mk_fwd, dim3(grid), dim3(NWAVES * 64), LDS_BYTES, stream, a); }
#else
    a.ph_lo = 0; a.ph_hi = NPHASE;
    hipLaunchKernelGGL(mk_fwd, dim3(grid), dim3(NWAVES * 64), LDS_BYTES, stream, a);
#endif
}
```
